# Optimizing an MI355X kernel written in HIP

```python
import jax, jax.numpy as jnp
from jax import lax
import numpy as np

D_MODEL = 2048
BATCH = 2
SEQ = 16384
DEPTH = 2

HEAD_DIM = 128
N_HEADS_A = 4
D_A = N_HEADS_A * HEAD_DIM
CHUNK = 128
N_HEADS_B = 12
D_B = N_HEADS_B * HEAD_DIM
DILATED_PATTERNS = ((128, 1), (512, 4), (2048, 16))
ATTN_BLOCK = 128
ROPE_THETA = 10000.0
D_MIX = D_A + D_B
D_IN_EVEN = 2 * D_A + 3 * D_B
D_RNN = 2560
N_LRU_BLOCKS = 10
LRU_BLOCK = D_RNN // N_LRU_BLOCKS
CONV_WIDTH = 4
LRU_C = 8.0
D_FF = 5632
N_EXPERTS = 8
TOP_K = 2
D_FF_EXPERT = 2816
RMS_EPS = 1e-6
LN_EPS = 1e-5
N_EVEN = (DEPTH + 1) // 2
N_ODD = DEPTH // 2

kernel_name = "hybrid_gmlp_dilated_rglru_moe"


def rmsnorm(x, g):
    xf = x.astype(jnp.float32)
    y = xf * lax.rsqrt(jnp.mean(xf * xf, axis=-1, keepdims=True) + RMS_EPS)
    return (y * g.astype(jnp.float32)).astype(x.dtype)


def layernorm(x, g, b):
    xf = x.astype(jnp.float32)
    mu = jnp.mean(xf, axis=-1, keepdims=True)
    var = jnp.mean(jnp.square(xf - mu), axis=-1, keepdims=True)
    y = (xf - mu) * lax.rsqrt(var + LN_EPS)
    return (y * g.astype(jnp.float32) + b.astype(jnp.float32)).astype(x.dtype)


def rope(x, pos):
    half = x.shape[-1] // 2
    inv_freq = jnp.exp(-jnp.log(ROPE_THETA) * jnp.arange(half, dtype=jnp.float32) / half)
    ang = pos[:, None] * inv_freq[None, :]
    cos = jnp.cos(ang)[None, :, None, :]
    sin = jnp.sin(ang)[None, :, None, :]
    xf = x.astype(jnp.float32)
    x1, x2 = xf[..., :half], xf[..., half:]
    return jnp.concatenate([x1 * cos - x2 * sin, x2 * cos + x1 * sin], axis=-1).astype(x.dtype)


def swiglu(h, w_gate, w_up, w_down):
    return (jax.nn.silu(h @ w_gate) * (h @ w_up)) @ w_down


def chunked_spatial_gating(u, v, w_s, b_s, ln_g, ln_b):
    B, S, _ = v.shape
    u = jax.nn.gelu(u)
    v = layernorm(jax.nn.gelu(v), ln_g, ln_b)
    vc = v.reshape(B, S // CHUNK, CHUNK, N_HEADS_A, HEAD_DIM)
    causal = jnp.tril(jnp.ones((CHUNK, CHUNK), dtype=bool))
    w = jnp.where(causal[None], w_s, 0.0).astype(v.dtype)
    mixed = jnp.einsum('gts,bcsgd->bctgd', w, vc) + b_s.T.astype(v.dtype)[None, None, :, :, None]
    return u * mixed.reshape(B, S, D_A)


def banded_causal_attention(q, k, v, steps):
    N, L, H, dh = q.shape
    blk = ATTN_BLOCK
    nb = -(-L // blk)
    Lp = nb * blk
    pad = ((0, 0), (0, Lp - L), (0, 0), (0, 0))
    qb = jnp.pad(q, pad).reshape(N, nb, blk, H, dh)
    kb = jnp.pad(k, pad).reshape(N, nb, blk, H, dh)
    vb = jnp.pad(v, pad).reshape(N, nb, blk, H, dh)
    zk = jnp.zeros_like(kb[:, :1])
    k_win = jnp.concatenate([jnp.concatenate([zk, kb[:, :-1]], axis=1), kb], axis=2)
    v_win = jnp.concatenate([jnp.concatenate([zk, vb[:, :-1]], axis=1), vb], axis=2)
    s = jnp.einsum('nbqhd,nbkhd->nbhqk', qb, k_win).astype(jnp.float32) * (dh ** -0.5)
    qi = jnp.arange(nb)[:, None, None] * blk + jnp.arange(blk)[None, :, None]
    ki = jnp.arange(nb)[:, None, None] * blk - blk + jnp.arange(2 * blk)[None, None, :]
    dist = qi - ki
    valid = (dist >= 0) & (dist <= steps) & (ki >= 0)
    s = jnp.where(valid[None, :, None], s, -jnp.inf)
    m = jnp.max(s, axis=-1, keepdims=True)
    p = jnp.exp(s - m)
    denom = jnp.sum(p, axis=-1, keepdims=True)
    o = jnp.einsum('nbhqk,nbkhd->nbqhd', (p / denom).astype(v.dtype), v_win)
    lse = (m + jnp.log(denom))[..., 0]
    o = o.reshape(N, Lp, H, dh)[:, :L]
    lse = lse.transpose(0, 1, 3, 2).reshape(N, Lp, H)[:, :L]
    return o, lse


def dilated_attention(q, k, v):
    B, S, H, dh = q.shape
    outs, lses = [], []
    for window, dil in DILATED_PATTERNS:
        L = S // dil

        def fold(t):
            return t.reshape(B, L, dil, H, dh).transpose(0, 2, 1, 3, 4).reshape(B * dil, L, H, dh)

        o, lse = banded_causal_attention(fold(q), fold(k), fold(v), window // dil)
        outs.append(o.reshape(B, dil, L, H, dh).transpose(0, 2, 1, 3, 4).reshape(B, S, H, dh))
        lses.append(lse.reshape(B, dil, L, H).transpose(0, 2, 1, 3).reshape(B, S, H))
    w = jax.nn.softmax(jnp.stack(lses, axis=0), axis=0)
    return jnp.einsum('pbsh,pbshd->bshd', w.astype(q.dtype), jnp.stack(outs, axis=0))


def even_mixer(h, pos, w_in, ln_g, ln_b, w_s, b_s, w_out):
    B, S, _ = h.shape
    proj = h @ w_in
    u, va, q, k, vb = jnp.split(proj, [D_A, 2 * D_A, 2 * D_A + D_B, 2 * D_A + 2 * D_B], axis=-1)
    a_out = chunked_spatial_gating(u, va, w_s, b_s, ln_g, ln_b)
    q = rope(q.reshape(B, S, N_HEADS_B, HEAD_DIM), pos)
    k = rope(k.reshape(B, S, N_HEADS_B, HEAD_DIM), pos)
    vb = vb.reshape(B, S, N_HEADS_B, HEAD_DIM)
    b_out = dilated_attention(q, k, vb).reshape(B, S, D_B)
    return jnp.concatenate([a_out, b_out], axis=-1) @ w_out


def causal_depthwise_conv(x, w, b):
    S = x.shape[1]
    xp = jnp.pad(x, ((0, 0), (CONV_WIDTH - 1, 0), (0, 0)))
    y = b[None, None, :] + xp[:, 0:S] * w[0]
    for tap in range(1, CONV_WIDTH):
        y = y + xp[:, tap:tap + S] * w[tap]
    return y


def rg_lru(x, w_a, b_a, w_x, b_x, lam):
    B, S, _ = x.shape
    xf = x.astype(jnp.float32)
    xb = xf.reshape(B, S, N_LRU_BLOCKS, LRU_BLOCK)
    r = jax.nn.sigmoid(jnp.einsum('bsnc,ncd->bsnd', xb, w_a.astype(jnp.float32)).reshape(B, S, D_RNN) + b_a.astype(jnp.float32))
    i = jax.nn.sigmoid(jnp.einsum('bsnc,ncd->bsnd', xb, w_x.astype(jnp.float32)).reshape(B, S, D_RNN) + b_x.astype(jnp.float32))
    log_a = -LRU_C * r * jax.nn.softplus(-lam.astype(jnp.float32))
    a = jnp.exp(log_a)
    bterm = jnp.sqrt(-jnp.expm1(2.0 * log_a)) * (i * xf)

    def combine(left, right):
        a1, b1 = left
        a2, b2 = right
        return a1 * a2, a2 * b1 + b2

    _, hseq = lax.associative_scan(combine, (a, bterm), axis=1)
    return hseq.astype(x.dtype)


def odd_mixer(h, w_in, conv_w, conv_b, w_a, b_a, w_x, b_x, lam, w_out):
    proj = h @ w_in
    gate, xr = jnp.split(proj, [D_RNN], axis=-1)
    xr = causal_depthwise_conv(xr, conv_w, conv_b)
    y = rg_lru(xr, w_a, b_a, w_x, b_x, lam)
    return (jax.nn.gelu(gate) * y) @ w_out


def moe_swiglu(h, w_router, w_gate, w_up, w_down):
    logits = (h @ w_router).astype(jnp.float32)
    top_vals, top_idx = lax.top_k(logits, TOP_K)
    gates = jax.nn.softmax(top_vals, axis=-1)
    dense_gates = jnp.sum(jax.nn.one_hot(top_idx, N_EXPERTS, dtype=jnp.float32) * gates[..., None], axis=-2)
    out = jnp.zeros_like(h)
    for e in range(N_EXPERTS):
        out = out + dense_gates[..., e:e + 1].astype(h.dtype) * swiglu(h, w_gate[e], w_up[e], w_down[e])
    return out


def setup_inputs(seed: int = 0) -> dict:
    key = jax.random.key(seed)
    keys = jax.random.split(key, 32)
    counter = iter(range(32))
    f32 = jnp.float32

    def normal(shape, scale):
        return scale * jax.random.normal(keys[next(counter)], shape, f32)

    def gain(shape):
        return 1.0 + 0.05 * jax.random.normal(keys[next(counter)], shape, f32)

    E, O = N_EVEN, N_ODD
    x = normal((BATCH, SEQ, D_MODEL), 1.0)
    ev_norm_mix = gain((E, D_MODEL))
    ev_w_in = normal((E, D_MODEL, D_IN_EVEN), D_MODEL ** -0.5)
    ev_ln_g = gain((E, D_A))
    ev_ln_b = normal((E, D_A), 0.05)
    ev_w_s = normal((E, N_HEADS_A, CHUNK, CHUNK), CHUNK ** -0.5)
    ev_b_s = 1.0 + normal((E, N_HEADS_A, CHUNK), 0.1)
    ev_w_out = normal((E, D_MIX, D_MODEL), D_MIX ** -0.5)
    ev_norm_ffn = gain((E, D_MODEL))
    ev_ffn_gate = normal((E, D_MODEL, D_FF), D_MODEL ** -0.5)
    ev_ffn_up = normal((E, D_MODEL, D_FF), D_MODEL ** -0.5)
    ev_ffn_down = normal((E, D_FF, D_MODEL), D_FF ** -0.5)
    od_norm_mix = gain((O, D_MODEL))
    od_w_in = normal((O, D_MODEL, 2 * D_RNN), D_MODEL ** -0.5)
    od_conv_w = normal((O, CONV_WIDTH, D_RNN), CONV_WIDTH ** -0.5)
    od_conv_b = normal((O, D_RNN), 0.02)
    od_w_a = normal((O, N_LRU_BLOCKS, LRU_BLOCK, LRU_BLOCK), LRU_BLOCK ** -0.5)
    od_b_a = normal((O, D_RNN), 0.1)
    od_w_x = normal((O, N_LRU_BLOCKS, LRU_BLOCK, LRU_BLOCK), LRU_BLOCK ** -0.5)
    od_b_x = normal((O, D_RNN), 0.1)
    a_pow_c = jax.random.uniform(keys[next(counter)], (O, D_RNN), f32, minval=0.9, maxval=0.999)
    log_a0 = jnp.log(a_pow_c) / LRU_C
    od_lam = log_a0 - jnp.log(-jnp.expm1(log_a0))
    od_w_out = normal((O, D_RNN, D_MODEL), D_RNN ** -0.5)
    od_norm_ffn = gain((O, D_MODEL))
    od_router = normal((O, D_MODEL, N_EXPERTS), D_MODEL ** -0.5)
    od_exp_gate = normal((O, N_EXPERTS, D_MODEL, D_FF_EXPERT), D_MODEL ** -0.5)
    od_exp_up = normal((O, N_EXPERTS, D_MODEL, D_FF_EXPERT), D_MODEL ** -0.5)
    od_exp_down = normal((O, N_EXPERTS, D_FF_EXPERT, D_MODEL), D_FF_EXPERT ** -0.5)
    final_norm = gain((D_MODEL,))
    return {"x": x, "ev_norm_mix": ev_norm_mix, "ev_w_in": ev_w_in, "ev_ln_g": ev_ln_g,
            "ev_ln_b": ev_ln_b, "ev_w_s": ev_w_s, "ev_b_s": ev_b_s, "ev_w_out": ev_w_out,
            "ev_norm_ffn": ev_norm_ffn, "ev_ffn_gate": ev_ffn_gate, "ev_ffn_up": ev_ffn_up,
            "ev_ffn_down": ev_ffn_down, "od_norm_mix": od_norm_mix, "od_w_in": od_w_in,
            "od_conv_w": od_conv_w, "od_conv_b": od_conv_b, "od_w_a": od_w_a, "od_b_a": od_b_a,
            "od_w_x": od_w_x, "od_b_x": od_b_x, "od_lam": od_lam, "od_w_out": od_w_out,
            "od_norm_ffn": od_norm_ffn, "od_router": od_router, "od_exp_gate": od_exp_gate,
            "od_exp_up": od_exp_up, "od_exp_down": od_exp_down, "final_norm": final_norm}


def reference(x, ev_norm_mix, ev_w_in, ev_ln_g, ev_ln_b, ev_w_s, ev_b_s, ev_w_out,
              ev_norm_ffn, ev_ffn_gate, ev_ffn_up, ev_ffn_down, od_norm_mix, od_w_in,
              od_conv_w, od_conv_b, od_w_a, od_b_a, od_w_x, od_b_x, od_lam, od_w_out,
              od_norm_ffn, od_router, od_exp_gate, od_exp_up, od_exp_down, final_norm):
    S = x.shape[1]
    pos = jnp.arange(S, dtype=jnp.float32)
    for layer in range(DEPTH):
        j = layer // 2
        if layer % 2 == 0:
            x = x + even_mixer(rmsnorm(x, ev_norm_mix[j]), pos, ev_w_in[j], ev_ln_g[j], ev_ln_b[j],
                               ev_w_s[j], ev_b_s[j], ev_w_out[j])
            x = x + swiglu(rmsnorm(x, ev_norm_ffn[j]), ev_ffn_gate[j], ev_ffn_up[j], ev_ffn_down[j])
        else:
            x = x + odd_mixer(rmsnorm(x, od_norm_mix[j]), od_w_in[j], od_conv_w[j], od_conv_b[j],
                              od_w_a[j], od_b_a[j], od_w_x[j], od_b_x[j], od_lam[j], od_w_out[j])
            x = x + moe_swiglu(rmsnorm(x, od_norm_ffn[j]), od_router[j], od_exp_gate[j],
                               od_exp_up[j], od_exp_down[j])
    return rmsnorm(x, final_norm)
```

```cpp
#include <hip/hip_runtime.h>
#include <cstdio>
#include <cstdint>

#define GAS __attribute__((address_space(1)))
#define LAS __attribute__((address_space(3)))
typedef unsigned short bf16;
typedef float f32x4 __attribute__((ext_vector_type(4)));
typedef float f32x2 __attribute__((ext_vector_type(2)));
typedef unsigned u32x4 __attribute__((ext_vector_type(4)));
typedef unsigned u32x2 __attribute__((ext_vector_type(2)));

constexpr int M = 32768, S = 16384, D = 2048;
constexpr int DA = 512, DB = 1536, NIN0 = 5632, DFF = 5632, DRNN = 2560, NEXP = 8, DFE = 2816;
constexpr int NWAVES = 8, NTHR = 512;
constexpr float RMS_EPS = 1e-6f, LN_EPS = 1e-5f;
constexpr int RMAX = 2 * M + NEXP * 256;

constexpr size_t MiB = 1u << 20, KiB = 1u << 10;
constexpr size_t WS_CTL = 0, CTL_ZERO_BYTES = 1 * MiB;
constexpr size_t WS_SSQ0 = 1 * MiB;
constexpr size_t WS_SSQ1 = WS_SSQ0 + 128 * KiB;
constexpr size_t WS_SSQ2 = WS_SSQ1 + 4 * MiB;
constexpr size_t WS_SSQ3 = WS_SSQ2 + 4 * MiB;
constexpr size_t WS_TOPE = WS_SSQ3 + 4 * MiB;
constexpr size_t WS_TOPG = WS_TOPE + 256 * KiB;
constexpr size_t WS_CNT  = WS_TOPG + 256 * KiB;
constexpr size_t WS_EOFF = WS_CNT + 64 * KiB;
constexpr size_t WS_TOK  = WS_EOFF + 4 * KiB;
constexpr size_t WS_GW   = WS_TOK + 272 * KiB;
constexpr size_t WS_DEST = WS_GW + 272 * KiB;
constexpr size_t WS_CA   = WS_DEST + 272 * KiB;
constexpr size_t WS_CB   = WS_CA + 1280 * KiB;
constexpr size_t WS_HIN  = WS_CB + 1280 * KiB;
constexpr size_t WS_SMALL_END = WS_HIN + 1280 * KiB;
static_assert(WS_SMALL_END <= 20 * MiB, "small region");
constexpr size_t WS_WODD = 20 * MiB;
constexpr size_t WS_W_ODIN = WS_WODD, WS_W_AX = WS_WODD + 20 * MiB, WS_W_ODOUT = WS_W_AX + 3 * MiB;
constexpr size_t WS_WL0 = 53 * MiB;
constexpr size_t WS_W_EVIN = WS_WL0, WS_W_EVOUT = WS_WL0 + 22 * MiB, WS_W_FGU = WS_W_EVOUT + 8 * MiB, WS_W_FDN = WS_W_FGU + 44 * MiB;
constexpr size_t WS_XB = 149 * MiB;
constexpr size_t WS_WEXP = 277 * MiB;
constexpr size_t WS_W_EGU = WS_WEXP, WS_W_EDN = WS_WEXP + 176 * MiB;
constexpr size_t WS_ACT = 541 * MiB;
constexpr size_t WS_END = 1021 * MiB;
constexpr size_t WS_U = WS_ACT, WS_VA = WS_ACT + 32 * MiB, WS_Q = WS_ACT + 64 * MiB, WS_K = WS_ACT + 160 * MiB, WS_V = WS_ACT + 256 * MiB, WS_CAT = WS_ACT + 352 * MiB;
constexpr size_t WS_H = WS_ACT;
constexpr size_t WS_G = WS_ACT, WS_XR = WS_ACT + 160 * MiB, WS_XC = WS_ACT + 320 * MiB, WS_LA = WS_XR;
constexpr size_t WS_BT = WS_WL0;
constexpr size_t WS_HM = WS_ACT;
constexpr size_t WS_Y = 21 * MiB;
static_assert(WS_BT + (size_t)M * DRNN * 2 <= WS_WEXP, "BT overlay");
static_assert(WS_Y + (size_t)2 * M * D * 2 <= WS_WEXP, "Y overlay");
static_assert((size_t)RMAX * DFE * 2 <= 480 * MiB, "HM fits ACT");

constexpr int LDS_BYTES = 147456;

#define LDS_WAIT() asm volatile("s_waitcnt lgkmcnt(0)" ::: "memory")
#define VM_WAIT() asm volatile("s_waitcnt vmcnt(0)" ::: "memory")
__device__ __forceinline__ unsigned f2bf(float f) { unsigned u = __builtin_bit_cast(unsigned, f); return (u + 0x7fffu + ((u >> 16) & 1u)) >> 16; }
__device__ __forceinline__ unsigned pk2(float lo, float hi) { return f2bf(lo) | (f2bf(hi) << 16); }
__device__ __forceinline__ float bflo(unsigned w) { return __builtin_bit_cast(float, w << 16); }
__device__ __forceinline__ float bfhi(unsigned w) { return __builtin_bit_cast(float, w & 0xffff0000u); }
__device__ __forceinline__ float bf2f(bf16 b) { return __builtin_bit_cast(float, ((unsigned)b) << 16); }
__device__ __forceinline__ float wave_sum(float v) {
#pragma unroll
    for (int o = 1; o < 64; o <<= 1) v += __shfl_xor(v, o);
    return v;
}
__device__ __forceinline__ float wave_max(float v) {
#pragma unroll
    for (int o = 1; o < 64; o <<= 1) v = fmaxf(v, __shfl_xor(v, o));
    return v;
}
__device__ __forceinline__ float fast_exp(float x) { return __builtin_amdgcn_exp2f(x * 1.44269504089f); }
__device__ __forceinline__ float sigmoid_f(float x) { return __builtin_amdgcn_rcpf(1.0f + fast_exp(-x)); }
__device__ __forceinline__ float silu_f(float x) { return x * sigmoid_f(x); }
__device__ __forceinline__ float gelu_f(float x) { const float u = 0.7978845608f * (x + 0.044715f * x * x * x); return x * sigmoid_f(2.0f * u); }

struct Frame {
    LAS unsigned char* lds;
    int tid, lane, wave, bid, G;
};
struct Unit { int pm, pn; };

template <class Map>
__device__ __forceinline__ void cvt_item(const Map& mp, int item, LAS float* scr, int lane) {
    const int nblk = mp.NP / 32, kb = item / nblk, nb = item % nblk, k0 = 64 * kb, n0 = 32 * nb;
#pragma unroll 8
    for (int i = 0; i < 32; ++i) { const int kk = 2 * i + (lane >> 5); scr[kk * 33 + (lane & 31)] = mp.load(k0 + kk, n0 + (lane & 31)); }
    LDS_WAIT();
    const int c = lane & 7;
#pragma unroll
    for (int j = 0; j < 4; ++j) { const int n = (lane >> 3) + 8 * j; const LAS float* s = scr + (8 * c) * 33 + n;
        u32x4 o; o.x = pk2(s[0 * 33], s[1 * 33]); o.y = pk2(s[2 * 33], s[3 * 33]); o.z = pk2(s[4 * 33], s[5 * 33]); o.w = pk2(s[6 * 33], s[7 * 33]);
        *(u32x4*)(mp.dst + (size_t)mp.drow(n0 + n) * mp.K + k0 + 8 * c) = o; }
    LDS_WAIT();
}
struct MapPlain {
    const float* W; const float* gain; bf16* dst; int K, NP;
    __device__ __forceinline__ float load(int k, int np) const { float v = W[(size_t)k * NP + np]; if (gain) v *= gain[k]; return v; }
    __device__ __forceinline__ int drow(int n) const { return n; }
};
struct MapEvIn {
    const float* W; const float* gain; bf16* dst; int K, NP;
    __device__ __forceinline__ float load(int k, int np) const {
        int col = np; float sc = gain[k];
        if (np >= 2 * DA && np < 2 * DA + 2 * DB) {
            const int base = (np < 2 * DA + DB) ? 2 * DA : 2 * DA + DB; const int cp = np - base, head = cp >> 7, c2 = cp & 127;
            col = base + head * 128 + (c2 >> 1) + 64 * (c2 & 1);
            if (np < 2 * DA + DB) sc *= 0.08838834764831845f * 1.4426950408889634f;
        }
        return W[(size_t)k * NP + col] * sc;
    }
    __device__ __forceinline__ int drow(int n) const { return n; }
};
struct MapHalf {
    const float* W; const float* gain; bf16* dst; int K, NP, half;
    __device__ __forceinline__ float load(int k, int n) const { float v = W[(size_t)k * NP + n]; if (gain) v *= gain[k]; return v; }
    __device__ __forceinline__ int drow(int n) const { return ((n >> 7) << 8) + half * 128 + (n & 127); }
};

template <class AR, class Epi>
__device__ __forceinline__ void naive_gemm_unit(const AR& ar, const bf16* Bt, int ldb, int K, const Unit& u, const Epi& E, int wr, int wc, int fr, int fq) {
    f32x4 acc[2][2][4][2];
#pragma unroll
    for (int a = 0; a < 2; ++a)
#pragma unroll
        for (int b = 0; b < 2; ++b)
#pragma unroll
            for (int m = 0; m < 4; ++m)
#pragma unroll
                for (int n = 0; n < 2; ++n) acc[a][b][m][n] = (f32x4){0.f, 0.f, 0.f, 0.f};
    const bf16* ap[2][4];
#pragma unroll
    for (int a = 0; a < 2; ++a)
#pragma unroll
        for (int m = 0; m < 4; ++m) ap[a][m] = ar.row(u, a * 128 + wr * 64 + m * 16 + fr);
#pragma unroll
    for (int b = 0; b < 2; ++b)
#pragma unroll
        for (int n = 0; n < 2; ++n) {
            const bf16* bp = Bt + (size_t)(b * 128 + wc * 32 + 8 * fq + 4 * n) * ldb;
#pragma unroll 1
            for (int k = 0; k < K; k += 4) {
                f32x4 bv[4];
#pragma unroll
                for (int j = 0; j < 4; ++j) { const u32x2 w = *(const u32x2*)(bp + (size_t)j * ldb + k); bv[j] = (f32x4){bflo(w.x), bfhi(w.x), bflo(w.y), bfhi(w.y)}; }
#pragma unroll
                for (int a = 0; a < 2; ++a)
#pragma unroll
                    for (int m = 0; m < 4; ++m) {
                        const u32x2 w = *(const u32x2*)(ap[a][m] + k); const f32x4 av = (f32x4){bflo(w.x), bfhi(w.x), bflo(w.y), bfhi(w.y)};
#pragma unroll
                        for (int j = 0; j < 4; ++j) { const f32x4 p = av * bv[j]; acc[a][b][m][n][j] += (p.x + p.y) + (p.z + p.w); }
                    }
            }
        }
    E(acc, u, wr, wc, fr, fq);
}
struct ARowDense { const bf16* A; int lda; __device__ __forceinline__ const bf16* row(const Unit& u, int r) const { return A + (size_t)(u.pm * 256 + r) * lda; } };
struct ARowGather { const bf16* A; int lda; const int* tok; __device__ __forceinline__ const bf16* row(const Unit& u, int r) const { return A + (size_t)tok[u.pm * 256 + r] * lda; } };

__device__ __forceinline__ float rs_from_ssq32(const float* ssq, int row) {
    const f32x4* p = (const f32x4*)(ssq + (size_t)row * 32); float s = 0.f;
#pragma unroll
    for (int i = 0; i < 8; ++i) { const f32x4 v = p[i]; s += (v.x + v.y) + (v.z + v.w); }
    return 1.0f / sqrtf(s * (1.0f / D) + RMS_EPS);
}
__device__ __forceinline__ void store8(bf16* p, const f32x4 v0, const f32x4 v1) {
    u32x4 w; w.x = pk2(v0[0], v0[1]); w.y = pk2(v0[2], v0[3]); w.z = pk2(v1[0], v1[1]); w.w = pk2(v1[2], v1[3]); *(u32x4*)p = w;
}
struct EpiEvIn {
    const float* ssq0; bf16 *U, *VA, *Q, *Kb, *V;
    __device__ __forceinline__ void operator()(const f32x4 (&acc)[2][2][4][2], const Unit& u, int wr, int wc, int fr, int fq) const {
        const int row0 = u.pm * 256 + wr * 64 + fr, cw = wc * 32 + 8 * fq;
        const int pn = u.pn;
        float invf[2][2];
#pragma unroll
        for (int n = 0; n < 2; ++n)
#pragma unroll
            for (int jj = 0; jj < 2; ++jj) { const int i = 16 * wc + 4 * fq + 2 * n + jj; invf[n][jj] = __builtin_amdgcn_exp2f(-13.287712379549449f * (float)i * (1.0f / 64.0f)) * 0.15915494309189535f; }
#pragma unroll
        for (int ai = 0; ai < 2; ++ai)
#pragma unroll
            for (int m = 0; m < 4; ++m) {
                const int r = row0 + ai * 128 + m * 16;
                const float rs = 1.0f / sqrtf(ssq0[r] * (1.0f / D) + RMS_EPS);
                const float pos = (float)(r & (S - 1));
#pragma unroll
                for (int bj = 0; bj < 2; ++bj) {
                    f32x4 v0 = acc[ai][bj][m][0] * rs, v1 = acc[ai][bj][m][1] * rs;
                    if (pn < 4) {
#pragma unroll
                        for (int j = 0; j < 4; ++j) { v0[j] = gelu_f(v0[j]); v1[j] = gelu_f(v1[j]); }
                        bf16* dst = (pn < 2 ? U : VA) + (size_t)r * DA + (pn & 1) * 256 + bj * 128 + cw;
                        store8(dst, v0, v1);
                    } else if (pn < 16) {
#pragma unroll
                        for (int n = 0; n < 2; ++n) {
                            f32x4& v = n ? v1 : v0;
#pragma unroll
                            for (int jj = 0; jj < 2; ++jj) {
                                const float c = invf[n][jj]; const float hi = pos * c; const float lo = __builtin_fmaf(pos, c, -hi);
                                const float fr_ = (hi - floorf(hi)) + lo;
                                const float sn = __builtin_amdgcn_sinf(fr_), cs = __builtin_amdgcn_cosf(fr_);
                                const float x1 = v[2 * jj], x2 = v[2 * jj + 1];
                                v[2 * jj] = x1 * cs - x2 * sn; v[2 * jj + 1] = x2 * cs + x1 * sn;
                            }
                        }
                        const int t = (pn < 10) ? pn - 4 : pn - 10;
                        bf16* dst = (pn < 10 ? Q : Kb) + (size_t)r * DB + t * 256 + bj * 128 + cw;
                        store8(dst, v0, v1);
                    } else {
                        bf16* dst = V + (size_t)r * DB + (pn - 16) * 256 + bj * 128 + cw;
                        store8(dst, v0, v1);
                    }
                }
            }
    }
};
struct EpiResid {
    const float* xi; float* xo; bf16* XB; float* ssq;
    __device__ __forceinline__ void operator()(const f32x4 (&acc)[2][2][4][2], const Unit& u, int wr, int wc, int fr, int fq) const {
        const int row0 = u.pm * 256 + wr * 64 + fr, col0 = u.pn * 256 + wc * 32 + 8 * fq;
#pragma unroll
        for (int ai = 0; ai < 2; ++ai)
#pragma unroll
            for (int m = 0; m < 4; ++m) {
                const int r = row0 + ai * 128 + m * 16; float sq = 0.f;
#pragma unroll
                for (int bj = 0; bj < 2; ++bj) {
                    const size_t off = (size_t)r * D + col0 + bj * 128;
                    const f32x4 x0 = *(const f32x4*)(xi + off), x1 = *(const f32x4*)(xi + off + 4);
                    const f32x4 v0 = x0 + acc[ai][bj][m][0], v1 = x1 + acc[ai][bj][m][1];
                    *(f32x4*)(xo + off) = v0; *(f32x4*)(xo + off + 4) = v1;
                    store8(XB + off, v0, v1);
                    sq += (v0.x * v0.x + v0.y * v0.y) + (v0.z * v0.z + v0.w * v0.w) + (v1.x * v1.x + v1.y * v1.y) + (v1.z * v1.z + v1.w * v1.w);
                }
                sq += __shfl_xor(sq, 16); sq += __shfl_xor(sq, 32);
                if (fq == 0) ssq[(size_t)r * 32 + u.pn * 4 + wc] = sq;
            }
    }
};
template <bool MOE> struct EpiGateUp {
    const float* ssq; bf16* H; int ldh; const int* tok; const float* gw;
    __device__ __forceinline__ void operator()(const f32x4 (&acc)[2][2][4][2], const Unit& u, int wr, int wc, int fr, int fq) const {
        const int row0 = u.pm * 256 + wr * 64 + fr, col0 = u.pn * 128 + wc * 32 + 8 * fq;
#pragma unroll
        for (int ai = 0; ai < 2; ++ai)
#pragma unroll
            for (int m = 0; m < 4; ++m) {
                const int r = row0 + ai * 128 + m * 16;
                const int t = MOE ? tok[r] : r;
                const float rs = rs_from_ssq32(ssq, t);
                const float w = MOE ? gw[r] : 1.0f;
                f32x4 h0, h1;
#pragma unroll
                for (int j = 0; j < 4; ++j) {
                    h0[j] = silu_f(acc[ai][0][m][0][j] * rs) * (acc[ai][1][m][0][j] * rs) * w;
                    h1[j] = silu_f(acc[ai][0][m][1][j] * rs) * (acc[ai][1][m][1][j] * rs) * w;
                }
                store8(H + (size_t)r * ldh + col0, h0, h1);
            }
    }
};
struct EpiOdIn {
    const float* ssq; bf16 *Gb, *XR;
    __device__ __forceinline__ void operator()(const f32x4 (&acc)[2][2][4][2], const Unit& u, int wr, int wc, int fr, int fq) const {
        const int row0 = u.pm * 256 + wr * 64 + fr, cw = wc * 32 + 8 * fq;
        const bool isg = u.pn < 10; const int cb = (isg ? u.pn : u.pn - 10) * 256;
#pragma unroll
        for (int ai = 0; ai < 2; ++ai)
#pragma unroll
            for (int m = 0; m < 4; ++m) {
                const int r = row0 + ai * 128 + m * 16;
                const float rs = rs_from_ssq32(ssq, r);
#pragma unroll
                for (int bj = 0; bj < 2; ++bj) {
                    f32x4 v0 = acc[ai][bj][m][0] * rs, v1 = acc[ai][bj][m][1] * rs;
                    if (isg) {
#pragma unroll
                        for (int j = 0; j < 4; ++j) { v0[j] = gelu_f(v0[j]); v1[j] = gelu_f(v1[j]); }
                    }
                    store8((isg ? Gb : XR) + (size_t)r * DRNN + cb + bj * 128 + cw, v0, v1);
                }
            }
    }
};
struct EpiGates {
    const bf16* XC; const float *b_a, *b_x, *lam; bf16 *LA, *BT;
    __device__ __forceinline__ void operator()(const f32x4 (&acc)[2][2][4][2], const Unit& u, int wr, int wc, int fr, int fq) const {
        const int row0 = u.pm * 256 + wr * 64 + fr, ch0 = u.pn * 128 + wc * 32 + 8 * fq;
        float ba[8], bx[8], sp8[8];
#pragma unroll
        for (int i = 0; i < 8; ++i) { ba[i] = b_a[ch0 + i]; bx[i] = b_x[ch0 + i]; sp8[i] = -8.0f * log1pf(expf(-lam[ch0 + i])); }
#pragma unroll
        for (int ai = 0; ai < 2; ++ai)
#pragma unroll
            for (int m = 0; m < 4; ++m) {
                const int r = row0 + ai * 128 + m * 16;
                const u32x4 xw = *(const u32x4*)(XC + (size_t)r * DRNN + ch0);
                const float xc[8] = {bflo(xw.x), bfhi(xw.x), bflo(xw.y), bfhi(xw.y), bflo(xw.z), bfhi(xw.z), bflo(xw.w), bfhi(xw.w)};
                f32x4 la0, la1, bt0, bt1;
#pragma unroll
                for (int i = 0; i < 8; ++i) {
                    const float pa = acc[ai][0][m][i >> 2][i & 3] + ba[i], px = acc[ai][1][m][i >> 2][i & 3] + bx[i];
                    const float rg = sigmoid_f(pa), ig = sigmoid_f(px);
                    const float log_a = sp8[i] * rg;
                    const float y2 = 2.0f * log_a;
                    const float om = (y2 > -0.02f) ? -(y2 * (1.0f + y2 * (0.5f + y2 * (1.0f / 6.0f)))) : (1.0f - fast_exp(y2));
                    const float bt = sqrtf(fmaxf(om, 0.f)) * ig * xc[i];
                    const float la2 = log_a * 1.4426950408889634f;
                    if (i < 4) { la0[i] = la2; bt0[i] = bt; } else { la1[i - 4] = la2; bt1[i - 4] = bt; }
                }
                store8(LA + (size_t)r * DRNN + ch0, la0, la1);
                store8(BT + (size_t)r * DRNN + ch0, bt0, bt1);
            }
    }
};
struct EpiMoeDown {
    const int* dest; bf16* Y;
    __device__ __forceinline__ void operator()(const f32x4 (&acc)[2][2][4][2], const Unit& u, int wr, int wc, int fr, int fq) const {
        const int row0 = u.pm * 256 + wr * 64 + fr, col0 = u.pn * 256 + wc * 32 + 8 * fq;
#pragma unroll
        for (int ai = 0; ai < 2; ++ai)
#pragma unroll
            for (int m = 0; m < 4; ++m) {
                const int r = row0 + ai * 128 + m * 16; const int d = dest[r];
                if (d >= 0) {
#pragma unroll
                    for (int bj = 0; bj < 2; ++bj) store8(Y + (size_t)d * D + col0 + bj * 128, acc[ai][bj][m][0], acc[ai][bj][m][1]);
                }
            }
    }
};

struct Args { const float* in[28]; float* out; unsigned char* ws; int ph_lo, ph_hi; };
enum { I_X = 0, I_EV_NORM_MIX, I_EV_W_IN, I_EV_LN_G, I_EV_LN_B, I_EV_W_S, I_EV_B_S, I_EV_W_OUT, I_EV_NORM_FFN, I_EV_FFN_GATE, I_EV_FFN_UP, I_EV_FFN_DOWN,
       I_OD_NORM_MIX, I_OD_W_IN, I_OD_CONV_W, I_OD_CONV_B, I_OD_W_A, I_OD_B_A, I_OD_W_X, I_OD_B_X, I_OD_LAM, I_OD_W_OUT, I_OD_NORM_FFN, I_OD_ROUTER,
       I_OD_EXP_GATE, I_OD_EXP_UP, I_OD_EXP_DOWN, I_FINAL_NORM };
constexpr int N_PHASES = 18;

template <class Epi>
__device__ __forceinline__ void dense_gemm_phase(const Frame& F, const bf16* A, int lda, const bf16* Bt, int ldb, int K, int ncol, int nunits, const Epi& E) {
    const int wr = F.wave >> 2, wc = F.wave & 3, fr = F.lane & 15, fq = F.lane >> 4;
    ARowDense ar{A, lda};
    for (int i = F.bid; i < nunits; i += F.G) { Unit u; u.pm = i / ncol; u.pn = i % ncol; naive_gemm_unit(ar, Bt + (size_t)u.pn * 256 * ldb, ldb, K, u, E, wr, wc, fr, fq); }
}

__global__ void __launch_bounds__(NTHR, 2) fwd(Args args) {
    extern __shared__ __attribute__((aligned(16))) unsigned char lds_raw[];
    Frame F; F.lds = (LAS unsigned char*)lds_raw; F.tid = threadIdx.x; F.lane = F.tid & 63; F.wave = __builtin_amdgcn_readfirstlane(F.tid >> 6); F.bid = blockIdx.x; F.G = gridDim.x;
    unsigned char* ws = args.ws;
    const int lo = args.ph_lo, hi = args.ph_hi;
#define IN(k) (lo <= (k) && (k) < hi)
    const int gw = F.bid * NWAVES + F.wave, NGW = F.G * NWAVES;
    const int gt = F.bid * NTHR + F.tid, NGT = F.G * NTHR;
    float* const xres = args.out;
    bf16* const XB = (bf16*)(ws + WS_XB);
    float* const SSQ0 = (float*)(ws + WS_SSQ0); float* const SSQ1 = (float*)(ws + WS_SSQ1); float* const SSQ2 = (float*)(ws + WS_SSQ2); float* const SSQ3 = (float*)(ws + WS_SSQ3);

    if (IN(0)) {
        LAS float* scr = (LAS float*)(F.lds + F.wave * 16384);
        constexpr int I0 = 32 * 176, I1 = 32 * 64, I2 = 32 * 176, I3 = 88 * 64, I4 = 32 * 160, I5 = 4 * 8, I6 = 40 * 64, I7 = 32 * 88, I8 = 44 * 64;
        constexpr int NITEMS = I0 + I1 + 2 * I2 + I3 + I4 + 20 * I5 + I6 + 16 * I7 + 8 * I8;
        for (int it = gw; it < NITEMS; it += NGW) {
            int r = it;
            if (r < I0) { MapEvIn mp{args.in[I_EV_W_IN], args.in[I_EV_NORM_MIX], (bf16*)(ws + WS_W_EVIN), D, NIN0}; cvt_item(mp, r, scr, F.lane); continue; } r -= I0;
            if (r < I1) { MapPlain mp{args.in[I_EV_W_OUT], nullptr, (bf16*)(ws + WS_W_EVOUT), D, D}; cvt_item(mp, r, scr, F.lane); continue; } r -= I1;
            if (r < I2) { MapHalf mp{args.in[I_EV_FFN_GATE], args.in[I_EV_NORM_FFN], (bf16*)(ws + WS_W_FGU), D, DFF, 0}; cvt_item(mp, r, scr, F.lane); continue; } r -= I2;
            if (r < I2) { MapHalf mp{args.in[I_EV_FFN_UP], args.in[I_EV_NORM_FFN], (bf16*)(ws + WS_W_FGU), D, DFF, 1}; cvt_item(mp, r, scr, F.lane); continue; } r -= I2;
            if (r < I3) { MapPlain mp{args.in[I_EV_FFN_DOWN], nullptr, (bf16*)(ws + WS_W_FDN), DFF, D}; cvt_item(mp, r, scr, F.lane); continue; } r -= I3;
            if (r < I4) { MapPlain mp{args.in[I_OD_W_IN], args.in[I_OD_NORM_MIX], (bf16*)(ws + WS_W_ODIN), D, 2 * DRNN}; cvt_item(mp, r, scr, F.lane); continue; } r -= I4;
            if (r < 10 * I5) { const int n = r / I5; MapHalf mp{args.in[I_OD_W_A] + (size_t)n * 65536, nullptr, (bf16*)(ws + WS_W_AX) + (size_t)n * 512 * 256, 256, 256, 0}; cvt_item(mp, r % I5, scr, F.lane); continue; } r -= 10 * I5;
            if (r < 10 * I5) { const int n = r / I5; MapHalf mp{args.in[I_OD_W_X] + (size_t)n * 65536, nullptr, (bf16*)(ws + WS_W_AX) + (size_t)n * 512 * 256, 256, 256, 1}; cvt_item(mp, r % I5, scr, F.lane); continue; } r -= 10 * I5;
            if (r < I6) { MapPlain mp{args.in[I_OD_W_OUT], nullptr, (bf16*)(ws + WS_W_ODOUT), DRNN, D}; cvt_item(mp, r, scr, F.lane); continue; } r -= I6;
            if (r < 8 * I7) { const int e = r / I7; MapHalf mp{args.in[I_OD_EXP_GATE] + (size_t)e * D * DFE, args.in[I_OD_NORM_FFN], (bf16*)(ws + WS_W_EGU) + (size_t)e * 2 * DFE * D, D, DFE, 0}; cvt_item(mp, r % I7, scr, F.lane); continue; } r -= 8 * I7;
            if (r < 8 * I7) { const int e = r / I7; MapHalf mp{args.in[I_OD_EXP_UP] + (size_t)e * D * DFE, args.in[I_OD_NORM_FFN], (bf16*)(ws + WS_W_EGU) + (size_t)e * 2 * DFE * D, D, DFE, 1}; cvt_item(mp, r % I7, scr, F.lane); continue; } r -= 8 * I7;
            { const int e = r / I8; MapPlain mp{args.in[I_OD_EXP_DOWN] + (size_t)e * DFE * D, nullptr, (bf16*)(ws + WS_W_EDN) + (size_t)e * D * DFE, DFE, D}; cvt_item(mp, r % I8, scr, F.lane); }
        }
        const float* x = args.in[I_X];
        for (int m = gw; m < M; m += NGW) {
            const f32x4* xr = (const f32x4*)(x + (size_t)m * D) + F.lane; u32x2* o8 = (u32x2*)(XB + (size_t)m * D) + F.lane; float s = 0.f;
#pragma unroll
            for (int j = 0; j < 8; ++j) { const f32x4 v = xr[64 * j]; s += (v.x * v.x + v.y * v.y) + (v.z * v.z + v.w * v.w); u32x2 w; w.x = pk2(v.x, v.y); w.y = pk2(v.z, v.w); o8[64 * j] = w; }
            s = wave_sum(s); if (F.lane == 0) SSQ0[m] = s;
        }
    }
    if (IN(1)) {
        EpiEvIn E{SSQ0, (bf16*)(ws + WS_U), (bf16*)(ws + WS_VA), (bf16*)(ws + WS_Q), (bf16*)(ws + WS_K), (bf16*)(ws + WS_V)};
        dense_gemm_phase(F, XB, D, (const bf16*)(ws + WS_W_EVIN), D, D, NIN0 / 256, (M / 256) * (NIN0 / 256), E);
    }
    if (IN(2)) {
        const bf16* U = (const bf16*)(ws + WS_U); const bf16* VA = (const bf16*)(ws + WS_VA); bf16* CAT = (bf16*)(ws + WS_CAT);
        const float* ln_g = args.in[I_EV_LN_G]; const float* ln_b = args.in[I_EV_LN_B]; const float* Ws = args.in[I_EV_W_S]; const float* bs = args.in[I_EV_B_S];
        LAS float* stats = (LAS float*)F.lds;
        LAS float* vln = (LAS float*)(F.lds + 1024);
        for (int c = F.bid; c < M / 128; c += F.G) {
            const int r0 = c * 128;
            for (int rr = 0; rr < 16; ++rr) {
                const int s = F.wave * 16 + rr; const u32x4 w = *(const u32x4*)(VA + (size_t)(r0 + s) * DA + 8 * F.lane);
                const float v[8] = {bflo(w.x), bfhi(w.x), bflo(w.y), bfhi(w.y), bflo(w.z), bfhi(w.z), bflo(w.w), bfhi(w.w)};
                float sm = 0.f;
#pragma unroll
                for (int i = 0; i < 8; ++i) sm += v[i];
                const float mean = wave_sum(sm) * (1.0f / DA); float q = 0.f;
#pragma unroll
                for (int i = 0; i < 8; ++i) { const float d = v[i] - mean; q += d * d; }
                const float var = wave_sum(q) * (1.0f / DA);
                if (F.lane == 0) { stats[2 * s] = mean; stats[2 * s + 1] = 1.0f / sqrtf(var + LN_EPS); }
            }
            __syncthreads();
            for (int g = 0; g < 4; ++g) {
                { const int s = F.tid >> 2, cq = (F.tid & 3) * 32; const float mean = stats[2 * s], rstd = stats[2 * s + 1];
#pragma unroll
                  for (int i4 = 0; i4 < 4; ++i4) { const int col = g * 128 + cq + 8 * i4; const u32x4 w = *(const u32x4*)(VA + (size_t)(r0 + s) * DA + col);
                      const float v[8] = {bflo(w.x), bfhi(w.x), bflo(w.y), bfhi(w.y), bflo(w.z), bfhi(w.z), bflo(w.w), bfhi(w.w)};
#pragma unroll
                      for (int i = 0; i < 8; ++i) vln[s * 128 + cq + 8 * i4 + i] = (v[i] - mean) * rstd * ln_g[col + i] + ln_b[col + i]; } }
                __syncthreads();
                { const int t = F.tid >> 2, dq = (F.tid & 3) * 32; float a[32];
#pragma unroll
                  for (int i = 0; i < 32; ++i) a[i] = 0.f;
                  const float* wrow = Ws + (size_t)(g * 128 + t) * 128;
                  for (int s = 0; s <= t; ++s) { const float w = wrow[s]; const LAS f32x4* vp = (const LAS f32x4*)(vln + s * 128 + dq);
#pragma unroll
                      for (int i = 0; i < 8; ++i) { const f32x4 v = vp[i]; a[4 * i] += w * v.x; a[4 * i + 1] += w * v.y; a[4 * i + 2] += w * v.z; a[4 * i + 3] += w * v.w; } }
                  const float bias = bs[g * 128 + t];
#pragma unroll
                  for (int i4 = 0; i4 < 4; ++i4) { const int col = g * 128 + dq + 8 * i4; const u32x4 w = *(const u32x4*)(U + (size_t)(r0 + t) * DA + col);
                      const float uv[8] = {bflo(w.x), bfhi(w.x), bflo(w.y), bfhi(w.y), bflo(w.z), bfhi(w.z), bflo(w.w), bfhi(w.w)};
                      u32x4 o; o.x = pk2(uv[0] * (a[8 * i4] + bias), uv[1] * (a[8 * i4 + 1] + bias)); o.y = pk2(uv[2] * (a[8 * i4 + 2] + bias), uv[3] * (a[8 * i4 + 3] + bias));
                      o.z = pk2(uv[4] * (a[8 * i4 + 4] + bias), uv[5] * (a[8 * i4 + 5] + bias)); o.w = pk2(uv[6] * (a[8 * i4 + 6] + bias), uv[7] * (a[8 * i4 + 7] + bias));
                      *(u32x4*)(CAT + (size_t)(r0 + t) * D + col) = o; } }
                __syncthreads();
            }
        }
        const bf16* Qb = (const bf16*)(ws + WS_Q); const bf16* Kb = (const bf16*)(ws + WS_K); const bf16* Vb = (const bf16*)(ws + WS_V);
        __syncthreads();
        LAS float* qs = (LAS float*)(F.lds + F.wave * 4096); LAS float* ps = qs + 128;
        for (int it = gw; it < M * 12; it += NGW) {
            const int row = it / 12, h = it - row * 12; const int b = row / S, pos = row - b * S;
            { const unsigned qw = *(const unsigned*)(Qb + (size_t)row * DB + h * 128 + 2 * F.lane); qs[2 * F.lane] = bflo(qw); qs[2 * F.lane + 1] = bfhi(qw); }
            LDS_WAIT();
            float sc[7]; float mx = -INFINITY;
#pragma unroll
            for (int c = 0; c < 7; ++c) {
                const int e = c * 64 + F.lane; const int p = e / 129, j = e - p * 129; const int dl = (p == 0) ? 1 : (p == 1 ? 4 : 16); const int kpos = pos - dl * j;
                float s = -INFINITY;
                if (e < 387 && kpos >= 0) {
                    const u32x4* kr = (const u32x4*)(Kb + (size_t)(b * S + kpos) * DB + h * 128); float a = 0.f;
#pragma unroll
                    for (int i = 0; i < 16; ++i) { const u32x4 w = kr[i]; const f32x4 q0 = *(const LAS f32x4*)(qs + 8 * i), q1 = *(const LAS f32x4*)(qs + 8 * i + 4);
                        a += bflo(w.x) * q0.x + bfhi(w.x) * q0.y + bflo(w.y) * q0.z + bfhi(w.y) * q0.w + bflo(w.z) * q1.x + bfhi(w.z) * q1.y + bflo(w.w) * q1.z + bfhi(w.w) * q1.w; }
                    s = a;
                }
                sc[c] = s; mx = fmaxf(mx, s);
            }
            mx = wave_max(mx); float sum = 0.f;
#pragma unroll
            for (int c = 0; c < 7; ++c) { const float pv = (sc[c] == -INFINITY) ? 0.f : __builtin_amdgcn_exp2f(sc[c] - mx); ps[c * 64 + F.lane] = pv; sum += pv; }
            sum = wave_sum(sum);
            LDS_WAIT();
            float o0 = 0.f, o1 = 0.f;
            for (int p = 0; p < 3; ++p) { const int dl = (p == 0) ? 1 : (p == 1 ? 4 : 16);
                for (int j = 0; j < 129; ++j) { const int kpos = pos - dl * j; if (kpos < 0) break;
                    const float pv = ps[p * 129 + j]; const unsigned vw = *(const unsigned*)(Vb + (size_t)(b * S + kpos) * DB + h * 128 + 2 * F.lane);
                    o0 += pv * bflo(vw); o1 += pv * bfhi(vw); } }
            const float inv = 1.0f / sum;
            *(unsigned*)(CAT + (size_t)row * D + DA + h * 128 + 2 * F.lane) = pk2(o0 * inv, o1 * inv);
            LDS_WAIT();
        }
    }
    if (IN(3)) {
        EpiResid E{args.in[I_X], xres, XB, SSQ1};
        dense_gemm_phase(F, (const bf16*)(ws + WS_CAT), D, (const bf16*)(ws + WS_W_EVOUT), D, D, D / 256, (M / 256) * (D / 256), E);
    }
    if (IN(4)) {
        EpiGateUp<false> E{SSQ1, (bf16*)(ws + WS_H), DFF, nullptr, nullptr};
        dense_gemm_phase(F, XB, D, (const bf16*)(ws + WS_W_FGU), D, D, 2 * DFF / 256, (M / 256) * (2 * DFF / 256), E);
    }
    if (IN(5)) {
        EpiResid E{xres, xres, XB, SSQ2};
        dense_gemm_phase(F, (const bf16*)(ws + WS_H), DFF, (const bf16*)(ws + WS_W_FDN), DFF, DFF, D / 256, (M / 256) * (D / 256), E);
    }
    if (IN(6)) {
        EpiOdIn E{SSQ2, (bf16*)(ws + WS_G), (bf16*)(ws + WS_XR)};
        dense_gemm_phase(F, XB, D, (const bf16*)(ws + WS_W_ODIN), D, D, 2 * DRNN / 256, (M / 256) * (2 * DRNN / 256), E);
    }
    if (IN(7)) {
        const bf16* XR = (const bf16*)(ws + WS_XR); bf16* XC = (bf16*)(ws + WS_XC); const float* cw = args.in[I_OD_CONV_W]; const float* cb = args.in[I_OD_CONV_B];
        for (int idx = gt; idx < M * (DRNN / 8); idx += NGT) {
            const int row = idx / (DRNN / 8), cg = idx - row * (DRNN / 8), ch = cg * 8; const int pos = row & (S - 1);
            float y[8];
#pragma unroll
            for (int i = 0; i < 8; ++i) y[i] = cb[ch + i];
#pragma unroll
            for (int tap = 0; tap < 4; ++tap) { const int sp = pos - 3 + tap;
                if (sp >= 0) { const u32x4 w = *(const u32x4*)(XR + (size_t)(row - 3 + tap) * DRNN + ch);
                    const float v[8] = {bflo(w.x), bfhi(w.x), bflo(w.y), bfhi(w.y), bflo(w.z), bfhi(w.z), bflo(w.w), bfhi(w.w)};
#pragma unroll
                    for (int i = 0; i < 8; ++i) y[i] += v[i] * cw[tap * DRNN + ch + i]; } }
            u32x4 o; o.x = pk2(y[0], y[1]); o.y = pk2(y[2], y[3]); o.z = pk2(y[4], y[5]); o.w = pk2(y[6], y[7]);
            *(u32x4*)(XC + (size_t)row * DRNN + ch) = o;
        }
    }
    if (IN(8)) {
        const bf16* XC = (const bf16*)(ws + WS_XC);
        EpiGates E{XC, args.in[I_OD_B_A], args.in[I_OD_B_X], args.in[I_OD_LAM], (bf16*)(ws + WS_LA), (bf16*)(ws + WS_BT)};
        const int wr = F.wave >> 2, wc = F.wave & 3, fr = F.lane & 15, fq = F.lane >> 4;
        for (int i = F.bid; i < (M / 256) * 20; i += F.G) { Unit u; u.pm = i / 20; u.pn = i % 20;
            ARowDense ar{XC + (u.pn >> 1) * 256, DRNN};
            naive_gemm_unit(ar, (const bf16*)(ws + WS_W_AX) + (size_t)u.pn * 256 * 256, 256, 256, u, E, wr, wc, fr, fq); }
    }
    const bf16* LA = (const bf16*)(ws + WS_LA); const bf16* BT = (const bf16*)(ws + WS_BT);
    float* CA = (float*)(ws + WS_CA); float* CBv = (float*)(ws + WS_CB); float* HIN = (float*)(ws + WS_HIN);
    if (IN(9)) {
        for (int idx = gt; idx < 2 * 64 * DRNN; idx += NGT) {
            const int ch = idx % DRNN, bc = idx / DRNN; const size_t base = (size_t)bc * 256 * DRNN + ch;
            float h = 0.f, P = 1.f;
            for (int t = 0; t < 256; ++t) { const float a = __builtin_amdgcn_exp2f(bf2f(LA[base + (size_t)t * DRNN])); const float bb = bf2f(BT[base + (size_t)t * DRNN]); h = a * h + bb; P *= a; }
            CA[idx] = P; CBv[idx] = h;
        }
    }
    if (IN(10)) {
        for (int idx = gt; idx < 2 * DRNN; idx += NGT) {
            const int b = idx / DRNN, ch = idx - b * DRNN; float h = 0.f;
            for (int c = 0; c < 64; ++c) { const int k = (b * 64 + c) * DRNN + ch; HIN[k] = h; h = CA[k] * h + CBv[k]; }
        }
    }
    if (IN(11)) {
        bf16* Gb = (bf16*)(ws + WS_G);
        for (int idx = gt; idx < 2 * 64 * DRNN; idx += NGT) {
            const int ch = idx % DRNN, bc = idx / DRNN; const size_t base = (size_t)bc * 256 * DRNN + ch;
            float h = HIN[idx];
            for (int t = 0; t < 256; ++t) { const size_t o = base + (size_t)t * DRNN; const float a = __builtin_amdgcn_exp2f(bf2f(LA[o])); const float bb = bf2f(BT[o]); h = a * h + bb; Gb[o] = (bf16)f2bf(bf2f(Gb[o]) * h); }
        }
    }
    if (IN(12)) {
        EpiResid E{xres, xres, XB, SSQ3};
        dense_gemm_phase(F, (const bf16*)(ws + WS_G), DRNN, (const bf16*)(ws + WS_W_ODOUT), DRNN, DRNN, D / 256, (M / 256) * (D / 256), E);
    }
    int* TOPE = (int*)(ws + WS_TOPE); float* TOPG = (float*)(ws + WS_TOPG); int* CNT = (int*)(ws + WS_CNT); int* EOFF = (int*)(ws + WS_EOFF);
    int* TOK = (int*)(ws + WS_TOK); float* GWv = (float*)(ws + WS_GW); int* DEST = (int*)(ws + WS_DEST);
    const int TPW = (M + F.G - 1) / F.G;
    if (IN(13)) {
        const float* Wr = args.in[I_OD_ROUTER]; const float* gn = args.in[I_OD_NORM_FFN];
        LAS int* cnt8 = (LAS int*)F.lds;
        if (F.tid < 8) cnt8[F.tid] = 0;
        __syncthreads();
        int myc[8];
#pragma unroll
        for (int e = 0; e < 8; ++e) myc[e] = 0;
        for (int tl = F.wave; tl < TPW; tl += NWAVES) {
            const int t = F.bid * TPW + tl; if (t >= M) break;
            float a[8];
#pragma unroll
            for (int e = 0; e < 8; ++e) a[e] = 0.f;
            const f32x4* xr = (const f32x4*)(xres + (size_t)t * D) + F.lane;
#pragma unroll
            for (int j = 0; j < 8; ++j) { const int k0 = 4 * F.lane + 256 * j; const f32x4 xv = xr[64 * j]; const f32x4 gv = *(const f32x4*)(gn + k0);
#pragma unroll
                for (int kk = 0; kk < 4; ++kk) { const float xg = xv[kk] * gv[kk]; const f32x4 w0 = *(const f32x4*)(Wr + (size_t)(k0 + kk) * 8), w1 = *(const f32x4*)(Wr + (size_t)(k0 + kk) * 8 + 4);
                    a[0] += xg * w0.x; a[1] += xg * w0.y; a[2] += xg * w0.z; a[3] += xg * w0.w; a[4] += xg * w1.x; a[5] += xg * w1.y; a[6] += xg * w1.z; a[7] += xg * w1.w; } }
#pragma unroll
            for (int e = 0; e < 8; ++e) a[e] = wave_sum(a[e]);
            const float sq = (F.lane < 32) ? SSQ3[(size_t)t * 32 + F.lane] : 0.f; const float rs = 1.0f / sqrtf(wave_sum(sq) * (1.0f / D) + RMS_EPS);
            int e1 = 0; float l1 = a[0];
#pragma unroll
            for (int e = 1; e < 8; ++e) if (a[e] > l1) { l1 = a[e]; e1 = e; }
            int e2 = -1; float l2 = -INFINITY;
#pragma unroll
            for (int e = 0; e < 8; ++e) if (e != e1 && a[e] > l2) { l2 = a[e]; e2 = e; }
            const float g1 = 1.0f / (1.0f + expf((l2 - l1) * rs)), g2 = 1.0f - g1;
            if (F.lane == 0) { TOPE[2 * t] = e1; TOPE[2 * t + 1] = e2; TOPG[2 * t] = g1; TOPG[2 * t + 1] = g2; }
#pragma unroll
            for (int e = 0; e < 8; ++e) myc[e] += (e == e1) + (e == e2);
        }
        if (F.lane == 0) {
#pragma unroll
            for (int e = 0; e < 8; ++e) atomicAdd((int*)(lds_raw) + e, myc[e]);
        }
        __syncthreads();
        if (F.tid < 8) CNT[F.bid * 8 + F.tid] = cnt8[F.tid];
    }
    if (IN(14)) {
        LAS int* tot = (LAS int*)F.lds;
        LAS int* bef = tot + 8;
        LAS int* eoff = tot + 16;
        LAS int* cntc = tot + 32;
        LAS int* run = tot + 32 + 8 * 64;
        if (F.tid < 8) { int t = 0, b = 0; for (int w = 0; w < F.G; ++w) { const int c = CNT[w * 8 + F.tid]; t += c; if (w < F.bid) b += c; } tot[F.tid] = t; bef[F.tid] = b; }
        __syncthreads();
        if (F.tid == 0) { int o = 0; for (int e = 0; e < 8; ++e) { eoff[e] = o; o += (tot[e] + 255) & ~255; } eoff[8] = o; }
        __syncthreads();
        if (F.bid == 0 && F.tid < 9) EOFF[F.tid] = eoff[F.tid];
        const int nslots = 2 * TPW, nchunk = (nslots + 63) / 64;
        for (int c = F.wave; c < nchunk; c += NWAVES) {
            const int sl = c * 64 + F.lane; const int t = F.bid * TPW + (sl >> 1); const int e = (sl < nslots && t < M) ? TOPE[2 * t + (sl & 1)] : -1;
#pragma unroll
            for (int x = 0; x < 8; ++x) { const unsigned long long mk = __ballot(e == x); if (F.lane == 0) cntc[c * 8 + x] = __popcll(mk); }
        }
        __syncthreads();
        if (F.tid < 8) { int r = 0; for (int c = 0; c < nchunk; ++c) { const int v = cntc[c * 8 + F.tid]; cntc[c * 8 + F.tid] = r; r += v; } }
        __syncthreads();
        for (int c = F.wave; c < nchunk; c += NWAVES) {
            const int sl = c * 64 + F.lane; const int t = F.bid * TPW + (sl >> 1); const bool ok = (sl < nslots && t < M); const int e = ok ? TOPE[2 * t + (sl & 1)] : -1;
            int posn = -1;
#pragma unroll
            for (int x = 0; x < 8; ++x) { const unsigned long long mk = __ballot(e == x); if (e == x) posn = eoff[x] + bef[x] + cntc[c * 8 + x] + __popcll(mk & ((1ull << F.lane) - 1ull)); }
            if (ok) { TOK[posn] = t; GWv[posn] = TOPG[2 * t + (sl & 1)]; DEST[posn] = (sl & 1) * M + t; }
        }
        if (F.bid < 8) { const int e = F.bid; for (int p = eoff[e] + tot[e] + F.tid; p < eoff[e + 1]; p += NTHR) { TOK[p] = 0; GWv[p] = 0.f; DEST[p] = -1; } }
        (void)run;
    }
    if (IN(15)) {
        EpiGateUp<true> E{SSQ3, (bf16*)(ws + WS_HM), DFE, TOK, GWv};
        const int wr = F.wave >> 2, wc = F.wave & 3, fr = F.lane & 15, fq = F.lane >> 4;
        int eo[9];
#pragma unroll
        for (int e = 0; e < 9; ++e) eo[e] = EOFF[e];
        const int NT = eo[8] / 256; ARowGather ar{XB, D, TOK};
        for (int i = F.bid; i < NT * 22; i += F.G) { Unit u; u.pm = i / 22; u.pn = i % 22; int e = 0;
#pragma unroll
            for (int x = 1; x < 8; ++x) e += (u.pm * 256 >= eo[x]);
            naive_gemm_unit(ar, (const bf16*)(ws + WS_W_EGU) + (size_t)e * 2 * DFE * D + (size_t)u.pn * 256 * D, D, D, u, E, wr, wc, fr, fq); }
    }
    if (IN(16)) {
        EpiMoeDown E{DEST, (bf16*)(ws + WS_Y)};
        const int wr = F.wave >> 2, wc = F.wave & 3, fr = F.lane & 15, fq = F.lane >> 4;
        int eo[9];
#pragma unroll
        for (int e = 0; e < 9; ++e) eo[e] = EOFF[e];
        const int NT = eo[8] / 256; ARowDense ar{(const bf16*)(ws + WS_HM), DFE};
        for (int i = F.bid; i < NT * 8; i += F.G) { Unit u; u.pm = i / 8; u.pn = i % 8; int e = 0;
#pragma unroll
            for (int x = 1; x < 8; ++x) e += (u.pm * 256 >= eo[x]);
            naive_gemm_unit(ar, (const bf16*)(ws + WS_W_EDN) + (size_t)e * D * DFE + (size_t)u.pn * 256 * DFE, DFE, DFE, u, E, wr, wc, fr, fq); }
    }
    if (IN(17)) {
        const bf16* Y = (const bf16*)(ws + WS_Y); const float* gf = args.in[I_FINAL_NORM];
        for (int m = gw; m < M; m += NGW) {
            f32x4* xr = (f32x4*)(xres + (size_t)m * D) + F.lane; const u32x2* y0 = (const u32x2*)(Y + (size_t)m * D) + F.lane; const u32x2* y1 = (const u32x2*)(Y + (size_t)(M + m) * D) + F.lane;
            f32x4 v[8]; float s = 0.f;
#pragma unroll
            for (int j = 0; j < 8; ++j) { const f32x4 x = xr[64 * j]; const u32x2 a = y0[64 * j], b = y1[64 * j];
                v[j] = (f32x4){x.x + bflo(a.x) + bflo(b.x), x.y + bfhi(a.x) + bfhi(b.x), x.z + bflo(a.y) + bflo(b.y), x.w + bfhi(a.y) + bfhi(b.y)};
                s += (v[j].x * v[j].x + v[j].y * v[j].y) + (v[j].z * v[j].z + v[j].w * v[j].w); }
            const float rs = 1.0f / sqrtf(wave_sum(s) * (1.0f / D) + RMS_EPS);
#pragma unroll
            for (int j = 0; j < 8; ++j) { const f32x4 g = *((const f32x4*)gf + F.lane + 64 * j); xr[64 * j] = v[j] * rs * g; }
        }
    }
#undef IN
}

extern "C" void kernel_launch(void* const* d_in, const int* in_sizes, int n_in, void* d_out, int out_size, void* d_ws, size_t ws_size, hipStream_t stream) {
    static int grid = 0;
    if (grid == 0) {
        if (n_in != 28 || in_sizes[0] != M * D || out_size != M * D || ws_size < WS_END) { fprintf(stderr, "kernel_launch: unexpected shapes (n_in %d, in0 %d, out %d, ws %zu); nothing launched\n", n_in, n_in > 0 ? in_sizes[0] : -1, out_size, ws_size); grid = -1; return; }
        int dev = 0, cus = 0;
        if (hipGetDevice(&dev) != hipSuccess || hipDeviceGetAttribute(&cus, hipDeviceAttributeMultiprocessorCount, dev) != hipSuccess) { grid = -1; return; }
        if (hipFuncSetAttribute((const void*)fwd, hipFuncAttributeMaxDynamicSharedMemorySize, LDS_BYTES) != hipSuccess) { grid = -1; return; }
        grid = cus;
    }
    if (grid < 0) return;
    (void)hipMemsetAsync((char*)d_ws + WS_CTL, 0, CTL_ZERO_BYTES, stream);
    Args a{};
    for (int i = 0; i < 28; ++i) a.in[i] = (const float*)d_in[i];
    a.out = (float*)d_out; a.ws = (unsigned char*)d_ws;
    for (int ph = 0; ph < N_PHASES; ++ph) { a.ph_lo = ph; a.ph_hi = ph + 1; hipLaunchKernelGGL(fwd, dim3(grid), dim3(NTHR), LDS_BYTES, stream, a); }
}
```

```cpp
#include <hip/hip_runtime.h>
#include <cstdio>
#include <cstdint>

#define GAS __attribute__((address_space(1)))
#define LAS __attribute__((address_space(3)))
typedef unsigned short bf16;
typedef float f32x4 __attribute__((ext_vector_type(4)));
typedef float f32x2 __attribute__((ext_vector_type(2)));
typedef unsigned u32x4 __attribute__((ext_vector_type(4)));
typedef unsigned u32x2 __attribute__((ext_vector_type(2)));

constexpr int M = 32768, S = 16384, D = 2048;
constexpr int DA = 512, DB = 1536, NIN0 = 5632, DFF = 5632, DRNN = 2560, NEXP = 8, DFE = 2816;
constexpr int NWAVES = 8, NTHR = 512;
constexpr float RMS_EPS = 1e-6f, LN_EPS = 1e-5f;
constexpr int RMAX = 2 * M + NEXP * 256;

constexpr size_t MiB = 1u << 20, KiB = 1u << 10;
constexpr size_t WS_CTL = 0, CTL_ZERO_BYTES = 1 * MiB;
constexpr size_t WS_SSQ0 = 1 * MiB;
constexpr size_t WS_SSQ1 = WS_SSQ0 + 128 * KiB;
constexpr size_t WS_SSQ2 = WS_SSQ1 + 4 * MiB;
constexpr size_t WS_SSQ3 = WS_SSQ2 + 4 * MiB;
constexpr size_t WS_TOPE = WS_SSQ3 + 4 * MiB;
constexpr size_t WS_TOPG = WS_TOPE + 256 * KiB;
constexpr size_t WS_CNT  = WS_TOPG + 256 * KiB;
constexpr size_t WS_EOFF = WS_CNT + 64 * KiB;
constexpr size_t WS_TOK  = WS_EOFF + 4 * KiB;
constexpr size_t WS_GW   = WS_TOK + 272 * KiB;
constexpr size_t WS_DEST = WS_GW + 272 * KiB;
constexpr size_t WS_CA   = WS_DEST + 272 * KiB;
constexpr size_t WS_CB   = WS_CA + 1280 * KiB;
constexpr size_t WS_HIN  = WS_CB + 1280 * KiB;
constexpr size_t WS_SP8  = WS_HIN + 1280 * KiB;
constexpr size_t WS_SMALL_END = WS_SP8 + 16 * KiB;
static_assert(WS_SMALL_END <= 20 * MiB, "small region");
constexpr size_t WS_WODD = 20 * MiB;
constexpr size_t WS_W_ODIN = WS_WODD, WS_W_AX = WS_WODD + 20 * MiB, WS_W_ODOUT = WS_W_AX + 3 * MiB;
constexpr size_t WS_WL0 = 53 * MiB;
constexpr size_t WS_W_EVIN = WS_WL0, WS_W_EVOUT = WS_WL0 + 22 * MiB, WS_W_FGU = WS_W_EVOUT + 8 * MiB, WS_W_FDN = WS_W_FGU + 44 * MiB;
constexpr size_t WS_XB = 149 * MiB;
constexpr size_t WS_WEXP = 277 * MiB;
constexpr size_t WS_W_EGU = WS_WEXP, WS_W_EDN = WS_WEXP + 176 * MiB;
constexpr size_t WS_ACT = 541 * MiB;
constexpr size_t WS_END = 1021 * MiB;
constexpr size_t WS_U = WS_ACT, WS_VA = WS_ACT + 32 * MiB, WS_Q = WS_ACT + 64 * MiB, WS_K = WS_ACT + 160 * MiB, WS_V = WS_ACT + 256 * MiB, WS_CAT = WS_ACT + 352 * MiB;
constexpr size_t WS_H = WS_ACT;
constexpr size_t WS_G = WS_ACT, WS_XR = WS_ACT + 160 * MiB, WS_XC = WS_ACT + 320 * MiB, WS_LA = WS_XR;
constexpr size_t WS_BT = WS_WL0;
constexpr size_t WS_HM = WS_ACT;
constexpr size_t WS_Y = 21 * MiB;
static_assert(WS_BT + (size_t)M * DRNN * 2 <= WS_WEXP, "BT overlay");
static_assert(WS_Y + (size_t)2 * M * D * 2 <= WS_WEXP, "Y overlay");
static_assert((size_t)RMAX * DFE * 2 <= 480 * MiB, "HM fits ACT");

constexpr int LDS_BYTES = 147456;

#define LDS_WAIT() asm volatile("s_waitcnt lgkmcnt(0)" ::: "memory")
#define VM_WAIT() asm volatile("s_waitcnt vmcnt(0)" ::: "memory")
__device__ __forceinline__ unsigned f2bf(float f) { unsigned u = __builtin_bit_cast(unsigned, f); return (u + 0x7fffu + ((u >> 16) & 1u)) >> 16; }
__device__ __forceinline__ unsigned pk2(float lo, float hi) { return f2bf(lo) | (f2bf(hi) << 16); }
__device__ __forceinline__ float bflo(unsigned w) { return __builtin_bit_cast(float, w << 16); }
__device__ __forceinline__ float bfhi(unsigned w) { return __builtin_bit_cast(float, w & 0xffff0000u); }
__device__ __forceinline__ float bf2f(bf16 b) { return __builtin_bit_cast(float, ((unsigned)b) << 16); }
__device__ __forceinline__ float wave_sum(float v) {
#pragma unroll
    for (int o = 1; o < 64; o <<= 1) v += __shfl_xor(v, o);
    return v;
}
__device__ __forceinline__ float wave_max(float v) {
#pragma unroll
    for (int o = 1; o < 64; o <<= 1) v = fmaxf(v, __shfl_xor(v, o));
    return v;
}
__device__ __forceinline__ float fast_exp(float x) { return __builtin_amdgcn_exp2f(x * 1.44269504089f); }
__device__ __forceinline__ float sigmoid_f(float x) { return __builtin_amdgcn_rcpf(1.0f + fast_exp(-x)); }
__device__ __forceinline__ float silu_f(float x) { return x * sigmoid_f(x); }
__device__ __forceinline__ float gelu_f(float x) { const float u = 0.7978845608f * (x + 0.044715f * x * x * x); return x * sigmoid_f(2.0f * u); }

struct Frame {
    LAS unsigned char* lds;
    int tid, lane, wave, bid, G;
};
struct Unit { int pm, pn; };

template <class Map>
__device__ __forceinline__ void cvt_item(const Map& mp, int item, LAS float* scr, int lane) {
    const int nblk = mp.NP / 32, kb = item / nblk, nb = item % nblk, k0 = 64 * kb, n0 = 32 * nb;
#pragma unroll 8
    for (int i = 0; i < 32; ++i) { const int kk = 2 * i + (lane >> 5); scr[kk * 33 + (lane & 31)] = mp.load(k0 + kk, n0 + (lane & 31)); }
    LDS_WAIT();
    const int c = lane & 7;
#pragma unroll
    for (int j = 0; j < 4; ++j) { const int n = (lane >> 3) + 8 * j; const LAS float* s = scr + (8 * c) * 33 + n;
        u32x4 o; o.x = pk2(s[0 * 33], s[1 * 33]); o.y = pk2(s[2 * 33], s[3 * 33]); o.z = pk2(s[4 * 33], s[5 * 33]); o.w = pk2(s[6 * 33], s[7 * 33]);
        *(u32x4*)(mp.dst + (size_t)mp.drow(n0 + n) * mp.K + k0 + 8 * c) = o; }
    LDS_WAIT();
}
struct MapPlain {
    const float* W; const float* gain; bf16* dst; int K, NP;
    __device__ __forceinline__ float load(int k, int np) const { float v = W[(size_t)k * NP + np]; if (gain) v *= gain[k]; return v; }
    __device__ __forceinline__ int drow(int n) const { return n; }
};
struct MapEvIn {
    const float* W; const float* gain; bf16* dst; int K, NP;
    __device__ __forceinline__ float load(int k, int np) const {
        int col = np; float sc = gain[k];
        if (np >= 2 * DA && np < 2 * DA + 2 * DB) {
            const int base = (np < 2 * DA + DB) ? 2 * DA : 2 * DA + DB; const int cp = np - base, head = cp >> 7, c2 = cp & 127;
            col = base + head * 128 + (c2 >> 1) + 64 * (c2 & 1);
            if (np < 2 * DA + DB) sc *= 0.08838834764831845f * 1.4426950408889634f;
        }
        return W[(size_t)k * NP + col] * sc;
    }
    __device__ __forceinline__ int drow(int n) const { return n; }
};
struct MapHalf {
    const float* W; const float* gain; bf16* dst; int K, NP, half;
    __device__ __forceinline__ float load(int k, int n) const { float v = W[(size_t)k * NP + n]; if (gain) v *= gain[k]; return v; }
    __device__ __forceinline__ int drow(int n) const { return ((n >> 7) << 8) + half * 128 + (n & 127); }
};

template <class AR, class Epi>
__device__ __forceinline__ void naive_gemm_unit(const AR& ar, const bf16* Bt, int ldb, int K, const Unit& u, const Epi& E, int wr, int wc, int fr, int fq) {
    f32x4 acc[2][2][4][2];
#pragma unroll
    for (int a = 0; a < 2; ++a)
#pragma unroll
        for (int b = 0; b < 2; ++b)
#pragma unroll
            for (int m = 0; m < 4; ++m)
#pragma unroll
                for (int n = 0; n < 2; ++n) acc[a][b][m][n] = (f32x4){0.f, 0.f, 0.f, 0.f};
    const bf16* ap[2][4];
#pragma unroll
    for (int a = 0; a < 2; ++a)
#pragma unroll
        for (int m = 0; m < 4; ++m) ap[a][m] = ar.row(u, a * 128 + wr * 64 + m * 16 + fr);
#pragma unroll
    for (int b = 0; b < 2; ++b)
#pragma unroll
        for (int n = 0; n < 2; ++n) {
            const bf16* bp = Bt + (size_t)(b * 128 + wc * 32 + 8 * fq + 4 * n) * ldb;
#pragma unroll 1
            for (int k = 0; k < K; k += 4) {
                f32x4 bv[4];
#pragma unroll
                for (int j = 0; j < 4; ++j) { const u32x2 w = *(const u32x2*)(bp + (size_t)j * ldb + k); bv[j] = (f32x4){bflo(w.x), bfhi(w.x), bflo(w.y), bfhi(w.y)}; }
#pragma unroll
                for (int a = 0; a < 2; ++a)
#pragma unroll
                    for (int m = 0; m < 4; ++m) {
                        const u32x2 w = *(const u32x2*)(ap[a][m] + k); const f32x4 av = (f32x4){bflo(w.x), bfhi(w.x), bflo(w.y), bfhi(w.y)};
#pragma unroll
                        for (int j = 0; j < 4; ++j) { const f32x4 p = av * bv[j]; acc[a][b][m][n][j] += (p.x + p.y) + (p.z + p.w); }
                    }
            }
        }
    E(acc, u, wr, wc, fr, fq);
}
struct ARowDense { const bf16* A; int lda; __device__ __forceinline__ const bf16* row(const Unit& u, int r) const { return A + (size_t)(u.pm * 256 + r) * lda; } };
struct ARowGather { const bf16* A; int lda; const int* tok; __device__ __forceinline__ const bf16* row(const Unit& u, int r) const { return A + (size_t)tok[u.pm * 256 + r] * lda; } };

namespace pg8 {
typedef short bf16x8 __attribute__((ext_vector_type(8)));
constexpr int BM = 256, BK = 64, HALF = 128, HTB = HALF * BK * 2, STAGE_BYTES = 8 * HTB, NXCD = 8, WGM = 8;
__host__ __device__ __forceinline__ int lds_byte(int r, int c) { const int st = (r >> 4) * 2 + (c >> 5), rr = r & 15, cc = c & 31, ob = rr * 64 + cc * 2; return st * 1024 + (ob ^ (((ob >> 9) & 1) << 5)); }
__host__ __device__ __forceinline__ void stage_rc(int b, int& R, int& C) { const int st = b / 1024, sb = b % 1024, swz = sb ^ (((sb >> 9) & 1) << 5); R = (st >> 1) * 16 + swz / 64; C = (st & 1) * 32 + (swz % 64) / 2; }
__host__ __device__ __forceinline__ int perm32(int rho) { const int n = rho >> 4, i = rho & 15; return 8 * (i >> 2) + 4 * n + (i & 3); }
struct StaticOrder {
    int nM, nN, nwg, G, c;
    __host__ __device__ void init(int nM_, int nN_, int G_, int c_) { nM = nM_; nN = nN_; nwg = nM * nN; G = G_; c = c_; }
    __host__ __device__ bool next(int i, Unit& u) const {
        const long L = (long)i * G + c; if (L >= nwg) return false;
        int wgid = (int)L; { const int q = nwg / NXCD, r = nwg % NXCD, xcd = wgid % NXCD, off = wgid / NXCD; wgid = (xcd < r ? xcd * (q + 1) : r * (q + 1) + (xcd - r) * q) + off; }
        const int nig = WGM * nN, gid = wgid / nig, fm = gid * WGM, gsz = (nM - fm) < WGM ? (nM - fm) : WGM;
        u.pm = fm + ((wgid % nig) % gsz); u.pn = (wgid % nig) / gsz; return true;
    }
};
template <class Epi, class Sched, bool GATHER, bool ALIGN_EPI>
__device__ __forceinline__ void gemm_phase(LAS unsigned char* lds, const Sched& S, const Epi& E, const int K, const int lda, const int ldb) {
    const int tid = threadIdx.x, wid = __builtin_amdgcn_readfirstlane(tid >> 6), lane = tid & 63, wr = wid >> 2, wc = wid & 3, fr = lane & 15, fq = lane >> 4;
    const int nt = K / BK;
    unsigned voffA[2][2], nvoffA[2][2], voffB[2]; int RA[2]; unsigned CA2[2];
#pragma unroll
    for (int i = 0; i < 2; ++i) { int R, C; stage_rc(tid * 16 + i * 8192, R, C); const int Rb = (R & ~31) + perm32(R & 31);
        voffB[i] = (unsigned)(Rb * ldb + C) * 2u; RA[i] = R; CA2[i] = (unsigned)C * 2u;
        voffA[0][i] = (unsigned)(R * lda + C) * 2u; voffA[1][i] = (unsigned)((R + HALF) * lda + C) * 2u; nvoffA[0][i] = voffA[0][i]; nvoffA[1][i] = voffA[1][i]; }
    const size_t kstep = (size_t)(BK * 2);
    const size_t hstepB = (size_t)HALF * ldb * 2;
    const unsigned ldsw = (unsigned)wid * 1024u;
    const int aoff = lds_byte(wr * 64 + fr, fq * 8), boff = lds_byte(wc * 32 + fr, fq * 8);
#define PG8_SA(b, h) (((b) * 2 + (h)) * HTB)
#define PG8_SB(b, h) ((4 + (b) * 2 + (h)) * HTB)
#define PG8_STAGE(bufoff, gbase, voff) do { _Pragma("unroll") for (int _i = 0; _i < 2; ++_i) \
        __builtin_amdgcn_global_load_lds((const unsigned*)((const char*)(gbase) + (voff)[_i]), (LAS unsigned*)(lds + (bufoff) + ldsw + _i * 8192), 16, 0, 0); } while (0)
#define PG8_LDA(dst, b, h) do { _Pragma("unroll") for (int m = 0; m < 4; ++m) _Pragma("unroll") for (int k = 0; k < 2; ++k) dst[m][k] = *(const LAS bf16x8*)(lds + PG8_SA(b, h) + aoff + m * 2048 + k * 1024); } while (0)
#define PG8_LDB(dst, b, h) do { _Pragma("unroll") for (int n = 0; n < 2; ++n) _Pragma("unroll") for (int k = 0; k < 2; ++k) dst[n][k] = *(const LAS bf16x8*)(lds + PG8_SB(b, h) + boff + n * 2048 + k * 1024); } while (0)
#define PG8_MMA(ai, bj, At, Bt) do { __builtin_amdgcn_s_setprio(1); _Pragma("unroll") for (int m = 0; m < 4; ++m) _Pragma("unroll") for (int n = 0; n < 2; ++n) _Pragma("unroll") for (int k = 0; k < 2; ++k) \
        acc[ai][bj][m][n] = __builtin_amdgcn_mfma_f32_16x16x32_bf16(Bt[n][k], At[m][k], acc[ai][bj][m][n], 0, 0, 0); __builtin_amdgcn_s_setprio(0); } while (0)
#define PG8_WAIT_V(n) asm volatile("s_waitcnt vmcnt(" #n ")" ::: "memory")
#define PG8_WAIT_L(n) asm volatile("s_waitcnt lgkmcnt(" #n ")" ::: "memory")
#define PG8_BAR __builtin_amdgcn_s_barrier()
#define PG8_SCHED __builtin_amdgcn_sched_barrier(0)
    Unit cur, nxt; int ui = 0;
    if (!S.next(0, cur)) return;
    if constexpr (GATHER) {
#pragma unroll
        for (int h = 0; h < 2; ++h)
#pragma unroll
            for (int i = 0; i < 2; ++i) voffA[h][i] = (unsigned)S.tok[cur.pm * BM + h * HALF + RA[i]] * (unsigned)(lda * 2) + CA2[i];
    }
    f32x4 acc[2][2][4][2];
#pragma unroll
    for (int a = 0; a < 2; ++a)
#pragma unroll
        for (int b = 0; b < 2; ++b)
#pragma unroll
            for (int m = 0; m < 4; ++m)
#pragma unroll
                for (int n = 0; n < 2; ++n) acc[a][b][m][n] = (f32x4){0.f, 0.f, 0.f, 0.f};
    bf16x8 At[4][2], B0[2][2], B1[2][2];
    const char* cA = S.a_base(cur); const char* cB = S.b_base(cur);
    PG8_STAGE(PG8_SB(0, 0), cB, voffB); PG8_STAGE(PG8_SB(0, 1), cB + hstepB, voffB); PG8_STAGE(PG8_SA(0, 0), cA, voffA[0]); PG8_STAGE(PG8_SA(0, 1), cA, voffA[1]);
    if (wr == 1) PG8_BAR;
    PG8_WAIT_V(2); PG8_BAR;
    PG8_STAGE(PG8_SB(1, 0), cB + kstep, voffB); PG8_STAGE(PG8_SA(1, 0), cA + kstep, voffA[0]); PG8_STAGE(PG8_SB(1, 1), cB + hstepB + kstep, voffB);
    PG8_WAIT_V(6); PG8_BAR;
    for (;;) {
        const bool has_next = S.next(ui + 1, nxt);
        const char* nA = has_next ? S.a_base(nxt) : cA; const char* nB = has_next ? S.b_base(nxt) : cB;
        if constexpr (GATHER) {
            if (has_next) {
#pragma unroll
                for (int h = 0; h < 2; ++h)
#pragma unroll
                    for (int i = 0; i < 2; ++i) nvoffA[h][i] = (unsigned)S.tok[nxt.pm * BM + h * HALF + RA[i]] * (unsigned)(lda * 2) + CA2[i];
            } else {
#pragma unroll
                for (int h = 0; h < 2; ++h)
#pragma unroll
                    for (int i = 0; i < 2; ++i) nvoffA[h][i] = voffA[h][i];
            }
        }
        for (int t = 0; t < nt; t += 2) {
            const bool last = (t == nt - 2);
            const char* a1 = cA + (size_t)(t + 1) * kstep;
            const char* a2 = last ? nA : cA + (size_t)(t + 2) * kstep; const char* b2 = last ? nB : cB + (size_t)(t + 2) * kstep;
            const char* a3 = a2 + kstep; const char* b3 = b2 + kstep;
            unsigned v2[2][2];
#pragma unroll
            for (int h = 0; h < 2; ++h)
#pragma unroll
                for (int i = 0; i < 2; ++i) v2[h][i] = (GATHER && last) ? nvoffA[h][i] : voffA[h][i];
            PG8_LDB(B0, 0, 0); PG8_LDB(B1, 0, 1); PG8_SCHED; PG8_LDA(At, 0, 0); PG8_STAGE(PG8_SA(1, 1), a1, voffA[1]);
            PG8_WAIT_V(8); PG8_WAIT_L(0); PG8_BAR; PG8_MMA(0, 0, At, B0); PG8_MMA(0, 1, At, B1); PG8_BAR; PG8_SCHED;
            PG8_LDA(At, 0, 1); PG8_STAGE(PG8_SB(0, 0), b2, voffB); PG8_STAGE(PG8_SB(0, 1), b2 + hstepB, voffB); PG8_STAGE(PG8_SA(0, 0), a2, v2[0]);
            PG8_WAIT_V(8); PG8_WAIT_L(0); PG8_BAR; PG8_MMA(1, 0, At, B0); PG8_MMA(1, 1, At, B1); PG8_BAR; PG8_SCHED;
            PG8_LDB(B0, 1, 0); PG8_LDB(B1, 1, 1); PG8_SCHED; PG8_LDA(At, 1, 0); PG8_STAGE(PG8_SA(0, 1), a2, v2[1]);
            PG8_WAIT_V(8); PG8_WAIT_L(0); PG8_BAR; PG8_MMA(0, 0, At, B0); PG8_MMA(0, 1, At, B1); PG8_BAR; PG8_SCHED;
            PG8_LDA(At, 1, 1); PG8_STAGE(PG8_SB(1, 0), b3, voffB); PG8_STAGE(PG8_SB(1, 1), b3 + hstepB, voffB); PG8_STAGE(PG8_SA(1, 0), a3, v2[0]);
            PG8_WAIT_V(8); PG8_WAIT_L(0); PG8_BAR; PG8_MMA(1, 0, At, B0); PG8_MMA(1, 1, At, B1); PG8_BAR; PG8_SCHED;
        }
        if constexpr (ALIGN_EPI) { if (wr == 0) PG8_BAR; }
        E(acc, cur, wr, wc, fr, fq);
        if (!has_next) break;
#pragma unroll
        for (int a = 0; a < 2; ++a)
#pragma unroll
            for (int b = 0; b < 2; ++b)
#pragma unroll
                for (int m = 0; m < 4; ++m)
#pragma unroll
                    for (int n = 0; n < 2; ++n) acc[a][b][m][n] = (f32x4){0.f, 0.f, 0.f, 0.f};
        cur = nxt; cA = nA; cB = nB; ++ui;
        if constexpr (GATHER) {
#pragma unroll
            for (int h = 0; h < 2; ++h)
#pragma unroll
                for (int i = 0; i < 2; ++i) voffA[h][i] = nvoffA[h][i];
        }
        if constexpr (ALIGN_EPI) { if (wr == 1) PG8_BAR; }
    }
    PG8_WAIT_V(0);
    if constexpr (!ALIGN_EPI) { if (wr == 0) PG8_BAR; }
    PG8_BAR;
#undef PG8_SA
#undef PG8_SB
#undef PG8_STAGE
#undef PG8_LDA
#undef PG8_LDB
#undef PG8_MMA
#undef PG8_WAIT_V
#undef PG8_WAIT_L
#undef PG8_BAR
#undef PG8_SCHED
}
struct SchedDense {
    StaticOrder so; const char* A; const char* B; size_t tstepA, tstepB; int acol_shift; size_t acol_bytes; const int* tok;
    __device__ __forceinline__ bool next(int i, Unit& u) const { return so.next(i, u); }
    __device__ __forceinline__ const char* a_base(const Unit& u) const { return A + (size_t)u.pm * tstepA + (acol_shift >= 0 ? (size_t)(u.pn >> acol_shift) * acol_bytes : 0); }
    __device__ __forceinline__ const char* b_base(const Unit& u) const { return B + (size_t)u.pn * tstepB; }
};
struct SchedMoe {
    StaticOrder so; const char* A; const char* B; size_t tstepA, tstepB, estrideB; int eo[9]; const int* tok; bool gather;
    __device__ __forceinline__ bool next(int i, Unit& u) const { return so.next(i, u); }
    __device__ __forceinline__ int expert(int pm) const { int e = 0;
#pragma unroll
        for (int x = 1; x < 8; ++x) e += (pm * 256 >= eo[x]); return e; }
    __device__ __forceinline__ const char* a_base(const Unit& u) const { return gather ? A : A + (size_t)u.pm * tstepA; }
    __device__ __forceinline__ const char* b_base(const Unit& u) const { return B + (size_t)expert(u.pm) * estrideB + (size_t)u.pn * tstepB; }
};
}

__device__ __forceinline__ float rs_from_ssq32(const float* ssq, int row) {
    const f32x4* p = (const f32x4*)(ssq + (size_t)row * 32); float s = 0.f;
#pragma unroll
    for (int i = 0; i < 8; ++i) { const f32x4 v = p[i]; s += (v.x + v.y) + (v.z + v.w); }
    return 1.0f / sqrtf(s * (1.0f / D) + RMS_EPS);
}
__device__ __forceinline__ void store8(bf16* p, const f32x4 v0, const f32x4 v1) {
    u32x4 w; w.x = pk2(v0[0], v0[1]); w.y = pk2(v0[2], v0[3]); w.z = pk2(v1[0], v1[1]); w.w = pk2(v1[2], v1[3]); *(u32x4*)p = w;
}
struct EpiEvIn {
    const float* ssq0; bf16 *U, *VA, *Q, *Kb, *V;
    __device__ __forceinline__ void operator()(const f32x4 (&acc)[2][2][4][2], const Unit& u, int wr, int wc, int fr, int fq) const {
        const int row0 = u.pm * 256 + wr * 64 + fr, cw = wc * 32 + 8 * fq;
        const int pn = u.pn;
        float invf[2][2];
#pragma unroll
        for (int n = 0; n < 2; ++n)
#pragma unroll
            for (int jj = 0; jj < 2; ++jj) { const int i = 16 * wc + 4 * fq + 2 * n + jj; invf[n][jj] = __builtin_amdgcn_exp2f(-13.287712379549449f * (float)i * (1.0f / 64.0f)) * 0.15915494309189535f; }
#pragma unroll
        for (int ai = 0; ai < 2; ++ai)
#pragma unroll
            for (int m = 0; m < 4; ++m) {
                const int r = row0 + ai * 128 + m * 16;
                const float rs = 1.0f / sqrtf(ssq0[r] * (1.0f / D) + RMS_EPS);
                const float pos = (float)(r & (S - 1));
#pragma unroll
                for (int bj = 0; bj < 2; ++bj) {
                    f32x4 v0 = acc[ai][bj][m][0] * rs, v1 = acc[ai][bj][m][1] * rs;
                    if (pn < 4) {
#pragma unroll
                        for (int j = 0; j < 4; ++j) { v0[j] = gelu_f(v0[j]); v1[j] = gelu_f(v1[j]); }
                        bf16* dst = (pn < 2 ? U : VA) + (size_t)r * DA + (pn & 1) * 256 + bj * 128 + cw;
                        store8(dst, v0, v1);
                    } else if (pn < 16) {
#pragma unroll
                        for (int n = 0; n < 2; ++n) {
                            f32x4& v = n ? v1 : v0;
#pragma unroll
                            for (int jj = 0; jj < 2; ++jj) {
                                const float c = invf[n][jj]; const float hi = pos * c; const float lo = __builtin_fmaf(pos, c, -hi);
                                const float fr_ = (hi - floorf(hi)) + lo;
                                const float sn = __builtin_amdgcn_sinf(fr_), cs = __builtin_amdgcn_cosf(fr_);
                                const float x1 = v[2 * jj], x2 = v[2 * jj + 1];
                                v[2 * jj] = x1 * cs - x2 * sn; v[2 * jj + 1] = x2 * cs + x1 * sn;
                            }
                        }
                        const int t = (pn < 10) ? pn - 4 : pn - 10;
                        bf16* dst = (pn < 10 ? Q : Kb) + (size_t)r * DB + t * 256 + bj * 128 + cw;
                        store8(dst, v0, v1);
                    } else {
                        bf16* dst = V + (size_t)r * DB + (pn - 16) * 256 + bj * 128 + cw;
                        store8(dst, v0, v1);
                    }
                }
            }
    }
};
struct EpiResid {
    const float* xi; float* xo; bf16* XB; float* ssq;
    __device__ __forceinline__ void operator()(const f32x4 (&acc)[2][2][4][2], const Unit& u, int wr, int wc, int fr, int fq) const {
        const int row0 = u.pm * 256 + wr * 64 + fr, col0 = u.pn * 256 + wc * 32 + 8 * fq;
#pragma unroll
        for (int ai = 0; ai < 2; ++ai)
#pragma unroll
            for (int m = 0; m < 4; ++m) {
                const int r = row0 + ai * 128 + m * 16; float sq = 0.f;
#pragma unroll
                for (int bj = 0; bj < 2; ++bj) {
                    const size_t off = (size_t)r * D + col0 + bj * 128;
                    const f32x4 x0 = *(const f32x4*)(xi + off), x1 = *(const f32x4*)(xi + off + 4);
                    const f32x4 v0 = x0 + acc[ai][bj][m][0], v1 = x1 + acc[ai][bj][m][1];
                    *(f32x4*)(xo + off) = v0; *(f32x4*)(xo + off + 4) = v1;
                    store8(XB + off, v0, v1);
                    sq += (v0.x * v0.x + v0.y * v0.y) + (v0.z * v0.z + v0.w * v0.w) + (v1.x * v1.x + v1.y * v1.y) + (v1.z * v1.z + v1.w * v1.w);
                }
                sq += __shfl_xor(sq, 16); sq += __shfl_xor(sq, 32);
                if (fq == 0) ssq[(size_t)r * 32 + u.pn * 4 + wc] = sq;
            }
    }
};
template <bool MOE> struct EpiGateUp {
    const float* ssq; bf16* H; int ldh; const int* tok; const float* gw;
    __device__ __forceinline__ void operator()(const f32x4 (&acc)[2][2][4][2], const Unit& u, int wr, int wc, int fr, int fq) const {
        const int row0 = u.pm * 256 + wr * 64 + fr, col0 = u.pn * 128 + wc * 32 + 8 * fq;
#pragma unroll
        for (int ai = 0; ai < 2; ++ai)
#pragma unroll
            for (int m = 0; m < 4; ++m) {
                const int r = row0 + ai * 128 + m * 16;
                const int t = MOE ? tok[r] : r;
                const float rs = rs_from_ssq32(ssq, t);
                const float w = MOE ? gw[r] : 1.0f;
                f32x4 h0, h1;
#pragma unroll
                for (int j = 0; j < 4; ++j) {
                    h0[j] = silu_f(acc[ai][0][m][0][j] * rs) * (acc[ai][1][m][0][j] * rs) * w;
                    h1[j] = silu_f(acc[ai][0][m][1][j] * rs) * (acc[ai][1][m][1][j] * rs) * w;
                }
                store8(H + (size_t)r * ldh + col0, h0, h1);
            }
    }
};
struct EpiOdIn {
    const float* ssq; bf16 *Gb, *XR;
    __device__ __forceinline__ void operator()(const f32x4 (&acc)[2][2][4][2], const Unit& u, int wr, int wc, int fr, int fq) const {
        const int row0 = u.pm * 256 + wr * 64 + fr, cw = wc * 32 + 8 * fq;
        const bool isg = u.pn < 10; const int cb = (isg ? u.pn : u.pn - 10) * 256;
#pragma unroll
        for (int ai = 0; ai < 2; ++ai)
#pragma unroll
            for (int m = 0; m < 4; ++m) {
                const int r = row0 + ai * 128 + m * 16;
                const float rs = rs_from_ssq32(ssq, r);
#pragma unroll
                for (int bj = 0; bj < 2; ++bj) {
                    f32x4 v0 = acc[ai][bj][m][0] * rs, v1 = acc[ai][bj][m][1] * rs;
                    if (isg) {
#pragma unroll
                        for (int j = 0; j < 4; ++j) { v0[j] = gelu_f(v0[j]); v1[j] = gelu_f(v1[j]); }
                    }
                    store8((isg ? Gb : XR) + (size_t)r * DRNN + cb + bj * 128 + cw, v0, v1);
                }
            }
    }
};
struct EpiGates {
    const bf16* XC; const float *b_a, *b_x, *sp8; bf16 *LA, *BT;
    __device__ __forceinline__ void operator()(const f32x4 (&acc)[2][2][4][2], const Unit& u, int wr, int wc, int fr, int fq) const {
        const int row0 = u.pm * 256 + wr * 64 + fr, ch0 = u.pn * 128 + wc * 32 + 8 * fq;
#pragma unroll
        for (int ai = 0; ai < 2; ++ai)
#pragma unroll
            for (int m = 0; m < 4; ++m) {
                const int r = row0 + ai * 128 + m * 16;
                const u32x4 xw = *(const u32x4*)(XC + (size_t)r * DRNN + ch0);
                const float xc[8] = {bflo(xw.x), bfhi(xw.x), bflo(xw.y), bfhi(xw.y), bflo(xw.z), bfhi(xw.z), bflo(xw.w), bfhi(xw.w)};
                f32x4 la[2], bt[2];
#pragma unroll
                for (int n = 0; n < 2; ++n) {
                    const f32x4 ba = *(const f32x4*)(b_a + ch0 + 4 * n), bx = *(const f32x4*)(b_x + ch0 + 4 * n), sp = *(const f32x4*)(sp8 + ch0 + 4 * n);
#pragma unroll
                    for (int j = 0; j < 4; ++j) {
                        const float rg = sigmoid_f(acc[ai][0][m][n][j] + ba[j]), ig = sigmoid_f(acc[ai][1][m][n][j] + bx[j]);
                        const float log_a = sp[j] * rg;
                        const float y2 = 2.0f * log_a;
                        const float om = (y2 > -0.02f) ? -(y2 * (1.0f + y2 * (0.5f + y2 * (1.0f / 6.0f)))) : (1.0f - fast_exp(y2));
                        bt[n][j] = sqrtf(fmaxf(om, 0.f)) * ig * xc[4 * n + j];
                        la[n][j] = log_a * 1.4426950408889634f;
                    }
                }
                store8(LA + (size_t)r * DRNN + ch0, la[0], la[1]);
                store8(BT + (size_t)r * DRNN + ch0, bt[0], bt[1]);
                asm volatile("" ::: "memory");
            }
    }
};
struct EpiMoeDown {
    const int* dest; bf16* Y;
    __device__ __forceinline__ void operator()(const f32x4 (&acc)[2][2][4][2], const Unit& u, int wr, int wc, int fr, int fq) const {
        const int row0 = u.pm * 256 + wr * 64 + fr, col0 = u.pn * 256 + wc * 32 + 8 * fq;
#pragma unroll
        for (int ai = 0; ai < 2; ++ai)
#pragma unroll
            for (int m = 0; m < 4; ++m) {
                const int r = row0 + ai * 128 + m * 16; const int d = dest[r];
                if (d >= 0) {
#pragma unroll
                    for (int bj = 0; bj < 2; ++bj) store8(Y + (size_t)d * D + col0 + bj * 128, acc[ai][bj][m][0], acc[ai][bj][m][1]);
                }
            }
    }
};

struct Args { const float* in[28]; float* out; unsigned char* ws; int ph_lo, ph_hi; };
enum { I_X = 0, I_EV_NORM_MIX, I_EV_W_IN, I_EV_LN_G, I_EV_LN_B, I_EV_W_S, I_EV_B_S, I_EV_W_OUT, I_EV_NORM_FFN, I_EV_FFN_GATE, I_EV_FFN_UP, I_EV_FFN_DOWN,
       I_OD_NORM_MIX, I_OD_W_IN, I_OD_CONV_W, I_OD_CONV_B, I_OD_W_A, I_OD_B_A, I_OD_W_X, I_OD_B_X, I_OD_LAM, I_OD_W_OUT, I_OD_NORM_FFN, I_OD_ROUTER,
       I_OD_EXP_GATE, I_OD_EXP_UP, I_OD_EXP_DOWN, I_FINAL_NORM };
constexpr int N_PHASES = 18;

#ifndef MFMA_MASK
#define MFMA_MASK 0x1ff
#endif
template <int ID, class Epi>
__device__ __forceinline__ void dense_gemm_phase(const Frame& F, const bf16* A, int lda, const bf16* Bt, int ldb, int K, int ncol, int nunits, const Epi& E) {
    if constexpr ((MFMA_MASK >> ID) & 1) {
        pg8::SchedDense S; S.so.init(nunits / ncol, ncol, F.G, F.bid); S.A = (const char*)A; S.B = (const char*)Bt; S.tstepA = (size_t)256 * lda * 2; S.tstepB = (size_t)256 * ldb * 2; S.acol_shift = -1; S.acol_bytes = 0; S.tok = nullptr;
        pg8::gemm_phase<Epi, pg8::SchedDense, false, true>(F.lds, S, E, K, lda, ldb);
    } else {
        const int wr = F.wave >> 2, wc = F.wave & 3, fr = F.lane & 15, fq = F.lane >> 4;
        ARowDense ar{A, lda};
        for (int i = F.bid; i < nunits; i += F.G) { Unit u; u.pm = i / ncol; u.pn = i % ncol; naive_gemm_unit(ar, Bt + (size_t)u.pn * 256 * ldb, ldb, K, u, E, wr, wc, fr, fq); }
    }
}

__global__ void __launch_bounds__(NTHR, 2) fwd(Args args) {
    extern __shared__ __attribute__((aligned(16))) unsigned char lds_raw[];
    Frame F; F.lds = (LAS unsigned char*)lds_raw; F.tid = threadIdx.x; F.lane = F.tid & 63; F.wave = __builtin_amdgcn_readfirstlane(F.tid >> 6); F.bid = blockIdx.x; F.G = gridDim.x;
    unsigned char* ws = args.ws;
    const int lo = args.ph_lo, hi = args.ph_hi;
#define IN(k) (lo <= (k) && (k) < hi)
    const int gw = F.bid * NWAVES + F.wave, NGW = F.G * NWAVES;
    const int gt = F.bid * NTHR + F.tid, NGT = F.G * NTHR;
    float* const xres = args.out;
    bf16* const XB = (bf16*)(ws + WS_XB);
    float* const SSQ0 = (float*)(ws + WS_SSQ0); float* const SSQ1 = (float*)(ws + WS_SSQ1); float* const SSQ2 = (float*)(ws + WS_SSQ2); float* const SSQ3 = (float*)(ws + WS_SSQ3);

    if (IN(0)) {
        LAS float* scr = (LAS float*)(F.lds + F.wave * 16384);
        constexpr int I0 = 32 * 176, I1 = 32 * 64, I2 = 32 * 176, I3 = 88 * 64, I4 = 32 * 160, I5 = 4 * 8, I6 = 40 * 64, I7 = 32 * 88, I8 = 44 * 64;
        constexpr int NITEMS = I0 + I1 + 2 * I2 + I3 + I4 + 20 * I5 + I6 + 16 * I7 + 8 * I8;
        for (int it = gw; it < NITEMS; it += NGW) {
            int r = it;
            if (r < I0) { MapEvIn mp{args.in[I_EV_W_IN], args.in[I_EV_NORM_MIX], (bf16*)(ws + WS_W_EVIN), D, NIN0}; cvt_item(mp, r, scr, F.lane); continue; } r -= I0;
            if (r < I1) { MapPlain mp{args.in[I_EV_W_OUT], nullptr, (bf16*)(ws + WS_W_EVOUT), D, D}; cvt_item(mp, r, scr, F.lane); continue; } r -= I1;
            if (r < I2) { MapHalf mp{args.in[I_EV_FFN_GATE], args.in[I_EV_NORM_FFN], (bf16*)(ws + WS_W_FGU), D, DFF, 0}; cvt_item(mp, r, scr, F.lane); continue; } r -= I2;
            if (r < I2) { MapHalf mp{args.in[I_EV_FFN_UP], args.in[I_EV_NORM_FFN], (bf16*)(ws + WS_W_FGU), D, DFF, 1}; cvt_item(mp, r, scr, F.lane); continue; } r -= I2;
            if (r < I3) { MapPlain mp{args.in[I_EV_FFN_DOWN], nullptr, (bf16*)(ws + WS_W_FDN), DFF, D}; cvt_item(mp, r, scr, F.lane); continue; } r -= I3;
            if (r < I4) { MapPlain mp{args.in[I_OD_W_IN], args.in[I_OD_NORM_MIX], (bf16*)(ws + WS_W_ODIN), D, 2 * DRNN}; cvt_item(mp, r, scr, F.lane); continue; } r -= I4;
            if (r < 10 * I5) { const int n = r / I5; MapHalf mp{args.in[I_OD_W_A] + (size_t)n * 65536, nullptr, (bf16*)(ws + WS_W_AX) + (size_t)n * 512 * 256, 256, 256, 0}; cvt_item(mp, r % I5, scr, F.lane); continue; } r -= 10 * I5;
            if (r < 10 * I5) { const int n = r / I5; MapHalf mp{args.in[I_OD_W_X] + (size_t)n * 65536, nullptr, (bf16*)(ws + WS_W_AX) + (size_t)n * 512 * 256, 256, 256, 1}; cvt_item(mp, r % I5, scr, F.lane); continue; } r -= 10 * I5;
            if (r < I6) { MapPlain mp{args.in[I_OD_W_OUT], nullptr, (bf16*)(ws + WS_W_ODOUT), DRNN, D}; cvt_item(mp, r, scr, F.lane); continue; } r -= I6;
            if (r < 8 * I7) { const int e = r / I7; MapHalf mp{args.in[I_OD_EXP_GATE] + (size_t)e * D * DFE, args.in[I_OD_NORM_FFN], (bf16*)(ws + WS_W_EGU) + (size_t)e * 2 * DFE * D, D, DFE, 0}; cvt_item(mp, r % I7, scr, F.lane); continue; } r -= 8 * I7;
            if (r < 8 * I7) { const int e = r / I7; MapHalf mp{args.in[I_OD_EXP_UP] + (size_t)e * D * DFE, args.in[I_OD_NORM_FFN], (bf16*)(ws + WS_W_EGU) + (size_t)e * 2 * DFE * D, D, DFE, 1}; cvt_item(mp, r % I7, scr, F.lane); continue; } r -= 8 * I7;
            { const int e = r / I8; MapPlain mp{args.in[I_OD_EXP_DOWN] + (size_t)e * DFE * D, nullptr, (bf16*)(ws + WS_W_EDN) + (size_t)e * D * DFE, DFE, D}; cvt_item(mp, r % I8, scr, F.lane); }
        }
        for (int c = gt; c < DRNN; c += NGT) ((float*)(ws + WS_SP8))[c] = -8.0f * log1pf(expf(-args.in[I_OD_LAM][c]));
        const float* x = args.in[I_X];
        for (int m = gw; m < M; m += NGW) {
            const f32x4* xr = (const f32x4*)(x + (size_t)m * D) + F.lane; u32x2* o8 = (u32x2*)(XB + (size_t)m * D) + F.lane; float s = 0.f;
#pragma unroll
            for (int j = 0; j < 8; ++j) { const f32x4 v = xr[64 * j]; s += (v.x * v.x + v.y * v.y) + (v.z * v.z + v.w * v.w); u32x2 w; w.x = pk2(v.x, v.y); w.y = pk2(v.z, v.w); o8[64 * j] = w; }
            s = wave_sum(s); if (F.lane == 0) SSQ0[m] = s;
        }
    }
    if (IN(1)) {
        EpiEvIn E{SSQ0, (bf16*)(ws + WS_U), (bf16*)(ws + WS_VA), (bf16*)(ws + WS_Q), (bf16*)(ws + WS_K), (bf16*)(ws + WS_V)};
        dense_gemm_phase<0>(F, XB, D, (const bf16*)(ws + WS_W_EVIN), D, D, NIN0 / 256, (M / 256) * (NIN0 / 256), E);
    }
    if (IN(2)) {
        const bf16* U = (const bf16*)(ws + WS_U); const bf16* VA = (const bf16*)(ws + WS_VA); bf16* CAT = (bf16*)(ws + WS_CAT);
        const float* ln_g = args.in[I_EV_LN_G]; const float* ln_b = args.in[I_EV_LN_B]; const float* Ws = args.in[I_EV_W_S]; const float* bs = args.in[I_EV_B_S];
        LAS float* stats = (LAS float*)F.lds;
        LAS float* vln = (LAS float*)(F.lds + 1024);
        for (int c = F.bid; c < M / 128; c += F.G) {
            const int r0 = c * 128;
            for (int rr = 0; rr < 16; ++rr) {
                const int s = F.wave * 16 + rr; const u32x4 w = *(const u32x4*)(VA + (size_t)(r0 + s) * DA + 8 * F.lane);
                const float v[8] = {bflo(w.x), bfhi(w.x), bflo(w.y), bfhi(w.y), bflo(w.z), bfhi(w.z), bflo(w.w), bfhi(w.w)};
                float sm = 0.f;
#pragma unroll
                for (int i = 0; i < 8; ++i) sm += v[i];
                const float mean = wave_sum(sm) * (1.0f / DA); float q = 0.f;
#pragma unroll
                for (int i = 0; i < 8; ++i) { const float d = v[i] - mean; q += d * d; }
                const float var = wave_sum(q) * (1.0f / DA);
                if (F.lane == 0) { stats[2 * s] = mean; stats[2 * s + 1] = 1.0f / sqrtf(var + LN_EPS); }
            }
            __syncthreads();
            for (int g = 0; g < 4; ++g) {
                { const int s = F.tid >> 2, cq = (F.tid & 3) * 32; const float mean = stats[2 * s], rstd = stats[2 * s + 1];
#pragma unroll
                  for (int i4 = 0; i4 < 4; ++i4) { const int col = g * 128 + cq + 8 * i4; const u32x4 w = *(const u32x4*)(VA + (size_t)(r0 + s) * DA + col);
                      const float v[8] = {bflo(w.x), bfhi(w.x), bflo(w.y), bfhi(w.y), bflo(w.z), bfhi(w.z), bflo(w.w), bfhi(w.w)};
#pragma unroll
                      for (int i = 0; i < 8; ++i) vln[s * 128 + cq + 8 * i4 + i] = (v[i] - mean) * rstd * ln_g[col + i] + ln_b[col + i]; } }
                __syncthreads();
                { const int t = F.tid >> 2, dq = (F.tid & 3) * 32; float a[32];
#pragma unroll
                  for (int i = 0; i < 32; ++i) a[i] = 0.f;
                  const float* wrow = Ws + (size_t)(g * 128 + t) * 128;
                  for (int s = 0; s <= t; ++s) { const float w = wrow[s]; const LAS f32x4* vp = (const LAS f32x4*)(vln + s * 128 + dq);
#pragma unroll
                      for (int i = 0; i < 8; ++i) { const f32x4 v = vp[i]; a[4 * i] += w * v.x; a[4 * i + 1] += w * v.y; a[4 * i + 2] += w * v.z; a[4 * i + 3] += w * v.w; } }
                  const float bias = bs[g * 128 + t];
#pragma unroll
                  for (int i4 = 0; i4 < 4; ++i4) { const int col = g * 128 + dq + 8 * i4; const u32x4 w = *(const u32x4*)(U + (size_t)(r0 + t) * DA + col);
                      const float uv[8] = {bflo(w.x), bfhi(w.x), bflo(w.y), bfhi(w.y), bflo(w.z), bfhi(w.z), bflo(w.w), bfhi(w.w)};
                      u32x4 o; o.x = pk2(uv[0] * (a[8 * i4] + bias), uv[1] * (a[8 * i4 + 1] + bias)); o.y = pk2(uv[2] * (a[8 * i4 + 2] + bias), uv[3] * (a[8 * i4 + 3] + bias));
                      o.z = pk2(uv[4] * (a[8 * i4 + 4] + bias), uv[5] * (a[8 * i4 + 5] + bias)); o.w = pk2(uv[6] * (a[8 * i4 + 6] + bias), uv[7] * (a[8 * i4 + 7] + bias));
                      *(u32x4*)(CAT + (size_t)(r0 + t) * D + col) = o; } }
                __syncthreads();
            }
        }
        const bf16* Qb = (const bf16*)(ws + WS_Q); const bf16* Kb = (const bf16*)(ws + WS_K); const bf16* Vb = (const bf16*)(ws + WS_V);
        __syncthreads();
        LAS float* qs = (LAS float*)(F.lds + F.wave * 4096); LAS float* ps = qs + 128;
        for (int it = gw; it < M * 12; it += NGW) {
            const int row = it / 12, h = it - row * 12; const int b = row / S, pos = row - b * S;
            { const unsigned qw = *(const unsigned*)(Qb + (size_t)row * DB + h * 128 + 2 * F.lane); qs[2 * F.lane] = bflo(qw); qs[2 * F.lane + 1] = bfhi(qw); }
            LDS_WAIT();
            float sc[7]; float mx = -INFINITY;
#pragma unroll
            for (int c = 0; c < 7; ++c) {
                const int e = c * 64 + F.lane; const int p = e / 129, j = e - p * 129; const int dl = (p == 0) ? 1 : (p == 1 ? 4 : 16); const int kpos = pos - dl * j;
                float s = -INFINITY;
                if (e < 387 && kpos >= 0) {
                    const u32x4* kr = (const u32x4*)(Kb + (size_t)(b * S + kpos) * DB + h * 128); float a = 0.f;
#pragma unroll
                    for (int i = 0; i < 16; ++i) { const u32x4 w = kr[i]; const f32x4 q0 = *(const LAS f32x4*)(qs + 8 * i), q1 = *(const LAS f32x4*)(qs + 8 * i + 4);
                        a += bflo(w.x) * q0.x + bfhi(w.x) * q0.y + bflo(w.y) * q0.z + bfhi(w.y) * q0.w + bflo(w.z) * q1.x + bfhi(w.z) * q1.y + bflo(w.w) * q1.z + bfhi(w.w) * q1.w; }
                    s = a;
                }
                sc[c] = s; mx = fmaxf(mx, s);
            }
            mx = wave_max(mx); float sum = 0.f;
#pragma unroll
            for (int c = 0; c < 7; ++c) { const float pv = (sc[c] == -INFINITY) ? 0.f : __builtin_amdgcn_exp2f(sc[c] - mx); ps[c * 64 + F.lane] = pv; sum += pv; }
            sum = wave_sum(sum);
            LDS_WAIT();
            float o0 = 0.f, o1 = 0.f;
            for (int p = 0; p < 3; ++p) { const int dl = (p == 0) ? 1 : (p == 1 ? 4 : 16);
                for (int j = 0; j < 129; ++j) { const int kpos = pos - dl * j; if (kpos < 0) break;
                    const float pv = ps[p * 129 + j]; const unsigned vw = *(const unsigned*)(Vb + (size_t)(b * S + kpos) * DB + h * 128 + 2 * F.lane);
                    o0 += pv * bflo(vw); o1 += pv * bfhi(vw); } }
            const float inv = 1.0f / sum;
            *(unsigned*)(CAT + (size_t)row * D + DA + h * 128 + 2 * F.lane) = pk2(o0 * inv, o1 * inv);
            LDS_WAIT();
        }
    }
    if (IN(3)) {
        EpiResid E{args.in[I_X], xres, XB, SSQ1};
        dense_gemm_phase<1>(F, (const bf16*)(ws + WS_CAT), D, (const bf16*)(ws + WS_W_EVOUT), D, D, D / 256, (M / 256) * (D / 256), E);
    }
    if (IN(4)) {
        EpiGateUp<false> E{SSQ1, (bf16*)(ws + WS_H), DFF, nullptr, nullptr};
        dense_gemm_phase<2>(F, XB, D, (const bf16*)(ws + WS_W_FGU), D, D, 2 * DFF / 256, (M / 256) * (2 * DFF / 256), E);
    }
    if (IN(5)) {
        EpiResid E{xres, xres, XB, SSQ2};
        dense_gemm_phase<3>(F, (const bf16*)(ws + WS_H), DFF, (const bf16*)(ws + WS_W_FDN), DFF, DFF, D / 256, (M / 256) * (D / 256), E);
    }
    if (IN(6)) {
        EpiOdIn E{SSQ2, (bf16*)(ws + WS_G), (bf16*)(ws + WS_XR)};
        dense_gemm_phase<4>(F, XB, D, (const bf16*)(ws + WS_W_ODIN), D, D, 2 * DRNN / 256, (M / 256) * (2 * DRNN / 256), E);
    }
    if (IN(7)) {
        const bf16* XR = (const bf16*)(ws + WS_XR); bf16* XC = (bf16*)(ws + WS_XC); const float* cw = args.in[I_OD_CONV_W]; const float* cb = args.in[I_OD_CONV_B];
        for (int idx = gt; idx < M * (DRNN / 8); idx += NGT) {
            const int row = idx / (DRNN / 8), cg = idx - row * (DRNN / 8), ch = cg * 8; const int pos = row & (S - 1);
            float y[8];
#pragma unroll
            for (int i = 0; i < 8; ++i) y[i] = cb[ch + i];
#pragma unroll
            for (int tap = 0; tap < 4; ++tap) { const int sp = pos - 3 + tap;
                if (sp >= 0) { const u32x4 w = *(const u32x4*)(XR + (size_t)(row - 3 + tap) * DRNN + ch);
                    const float v[8] = {bflo(w.x), bfhi(w.x), bflo(w.y), bfhi(w.y), bflo(w.z), bfhi(w.z), bflo(w.w), bfhi(w.w)};
#pragma unroll
                    for (int i = 0; i < 8; ++i) y[i] += v[i] * cw[tap * DRNN + ch + i]; } }
            u32x4 o; o.x = pk2(y[0], y[1]); o.y = pk2(y[2], y[3]); o.z = pk2(y[4], y[5]); o.w = pk2(y[6], y[7]);
            *(u32x4*)(XC + (size_t)row * DRNN + ch) = o;
        }
    }
    if (IN(8)) {
        const bf16* XC = (const bf16*)(ws + WS_XC);
        EpiGates E{XC, args.in[I_OD_B_A], args.in[I_OD_B_X], (const float*)(ws + WS_SP8), (bf16*)(ws + WS_LA), (bf16*)(ws + WS_BT)};
        if constexpr ((MFMA_MASK >> 5) & 1) {
            pg8::SchedDense Sg; Sg.so.init(M / 256, 20, F.G, F.bid); Sg.A = (const char*)XC; Sg.B = (const char*)(ws + WS_W_AX); Sg.tstepA = (size_t)256 * DRNN * 2; Sg.tstepB = (size_t)256 * 256 * 2; Sg.acol_shift = 1; Sg.acol_bytes = 512; Sg.tok = nullptr;
            pg8::gemm_phase<EpiGates, pg8::SchedDense, false, true>(F.lds, Sg, E, 256, DRNN, 256);
        } else {
        const int wr = F.wave >> 2, wc = F.wave & 3, fr = F.lane & 15, fq = F.lane >> 4;
        for (int i = F.bid; i < (M / 256) * 20; i += F.G) { Unit u; u.pm = i / 20; u.pn = i % 20;
            ARowDense ar{XC + (u.pn >> 1) * 256, DRNN};
            naive_gemm_unit(ar, (const bf16*)(ws + WS_W_AX) + (size_t)u.pn * 256 * 256, 256, 256, u, E, wr, wc, fr, fq); }
        }
    }
    const bf16* LA = (const bf16*)(ws + WS_LA); const bf16* BT = (const bf16*)(ws + WS_BT);
    float* CA = (float*)(ws + WS_CA); float* CBv = (float*)(ws + WS_CB); float* HIN = (float*)(ws + WS_HIN);
    if (IN(9)) {
        for (int idx = gt; idx < 2 * 64 * DRNN; idx += NGT) {
            const int ch = idx % DRNN, bc = idx / DRNN; const size_t base = (size_t)bc * 256 * DRNN + ch;
            float h = 0.f, P = 1.f;
            for (int t = 0; t < 256; ++t) { const float a = __builtin_amdgcn_exp2f(bf2f(LA[base + (size_t)t * DRNN])); const float bb = bf2f(BT[base + (size_t)t * DRNN]); h = a * h + bb; P *= a; }
            CA[idx] = P; CBv[idx] = h;
        }
    }
    if (IN(10)) {
        for (int idx = gt; idx < 2 * DRNN; idx += NGT) {
            const int b = idx / DRNN, ch = idx - b * DRNN; float h = 0.f;
            for (int c = 0; c < 64; ++c) { const int k = (b * 64 + c) * DRNN + ch; HIN[k] = h; h = CA[k] * h + CBv[k]; }
        }
    }
    if (IN(11)) {
        bf16* Gb = (bf16*)(ws + WS_G);
        for (int idx = gt; idx < 2 * 64 * DRNN; idx += NGT) {
            const int ch = idx % DRNN, bc = idx / DRNN; const size_t base = (size_t)bc * 256 * DRNN + ch;
            float h = HIN[idx];
            for (int t = 0; t < 256; ++t) { const size_t o = base + (size_t)t * DRNN; const float a = __builtin_amdgcn_exp2f(bf2f(LA[o])); const float bb = bf2f(BT[o]); h = a * h + bb; Gb[o] = (bf16)f2bf(bf2f(Gb[o]) * h); }
        }
    }
    if (IN(12)) {
        EpiResid E{xres, xres, XB, SSQ3};
        dense_gemm_phase<6>(F, (const bf16*)(ws + WS_G), DRNN, (const bf16*)(ws + WS_W_ODOUT), DRNN, DRNN, D / 256, (M / 256) * (D / 256), E);
    }
    int* TOPE = (int*)(ws + WS_TOPE); float* TOPG = (float*)(ws + WS_TOPG); int* CNT = (int*)(ws + WS_CNT); int* EOFF = (int*)(ws + WS_EOFF);
    int* TOK = (int*)(ws + WS_TOK); float* GWv = (float*)(ws + WS_GW); int* DEST = (int*)(ws + WS_DEST);
    const int TPW = (M + F.G - 1) / F.G;
    if (IN(13)) {
        const float* Wr = args.in[I_OD_ROUTER]; const float* gn = args.in[I_OD_NORM_FFN];
        LAS int* cnt8 = (LAS int*)F.lds;
        if (F.tid < 8) cnt8[F.tid] = 0;
        __syncthreads();
        int myc[8];
#pragma unroll
        for (int e = 0; e < 8; ++e) myc[e] = 0;
        for (int tl = F.wave; tl < TPW; tl += NWAVES) {
            const int t = F.bid * TPW + tl; if (t >= M) break;
            float a[8];
#pragma unroll
            for (int e = 0; e < 8; ++e) a[e] = 0.f;
            const f32x4* xr = (const f32x4*)(xres + (size_t)t * D) + F.lane;
#pragma unroll
            for (int j = 0; j < 8; ++j) { const int k0 = 4 * F.lane + 256 * j; const f32x4 xv = xr[64 * j]; const f32x4 gv = *(const f32x4*)(gn + k0);
#pragma unroll
                for (int kk = 0; kk < 4; ++kk) { const float xg = xv[kk] * gv[kk]; const f32x4 w0 = *(const f32x4*)(Wr + (size_t)(k0 + kk) * 8), w1 = *(const f32x4*)(Wr + (size_t)(k0 + kk) * 8 + 4);
                    a[0] += xg * w0.x; a[1] += xg * w0.y; a[2] += xg * w0.z; a[3] += xg * w0.w; a[4] += xg * w1.x; a[5] += xg * w1.y; a[6] += xg * w1.z; a[7] += xg * w1.w; } }
#pragma unroll
            for (int e = 0; e < 8; ++e) a[e] = wave_sum(a[e]);
            const float sq = (F.lane < 32) ? SSQ3[(size_t)t * 32 + F.lane] : 0.f; const float rs = 1.0f / sqrtf(wave_sum(sq) * (1.0f / D) + RMS_EPS);
            int e1 = 0; float l1 = a[0];
#pragma unroll
            for (int e = 1; e < 8; ++e) if (a[e] > l1) { l1 = a[e]; e1 = e; }
            int e2 = -1; float l2 = -INFINITY;
#pragma unroll
            for (int e = 0; e < 8; ++e) if (e != e1 && a[e] > l2) { l2 = a[e]; e2 = e; }
            const float g1 = 1.0f / (1.0f + expf((l2 - l1) * rs)), g2 = 1.0f - g1;
            if (F.lane == 0) { TOPE[2 * t] = e1; TOPE[2 * t + 1] = e2; TOPG[2 * t] = g1; TOPG[2 * t + 1] = g2; }
#pragma unroll
            for (int e = 0; e < 8; ++e) myc[e] += (e == e1) + (e == e2);
        }
        if (F.lane == 0) {
#pragma unroll
            for (int e = 0; e < 8; ++e) atomicAdd((int*)(lds_raw) + e, myc[e]);
        }
        __syncthreads();
        if (F.tid < 8) CNT[F.bid * 8 + F.tid] = cnt8[F.tid];
    }
    if (IN(14)) {
        LAS int* tot = (LAS int*)F.lds;
        LAS int* bef = tot + 8;
        LAS int* eoff = tot + 16;
        LAS int* cntc = tot + 32;
        LAS int* run = tot + 32 + 8 * 64;
        if (F.tid < 8) { int t = 0, b = 0; for (int w = 0; w < F.G; ++w) { const int c = CNT[w * 8 + F.tid]; t += c; if (w < F.bid) b += c; } tot[F.tid] = t; bef[F.tid] = b; }
        __syncthreads();
        if (F.tid == 0) { int o = 0; for (int e = 0; e < 8; ++e) { eoff[e] = o; o += (tot[e] + 255) & ~255; } eoff[8] = o; }
        __syncthreads();
        if (F.bid == 0 && F.tid < 9) EOFF[F.tid] = eoff[F.tid];
        const int nslots = 2 * TPW, nchunk = (nslots + 63) / 64;
        for (int c = F.wave; c < nchunk; c += NWAVES) {
            const int sl = c * 64 + F.lane; const int t = F.bid * TPW + (sl >> 1); const int e = (sl < nslots && t < M) ? TOPE[2 * t + (sl & 1)] : -1;
#pragma unroll
            for (int x = 0; x < 8; ++x) { const unsigned long long mk = __ballot(e == x); if (F.lane == 0) cntc[c * 8 + x] = __popcll(mk); }
        }
        __syncthreads();
        if (F.tid < 8) { int r = 0; for (int c = 0; c < nchunk; ++c) { const int v = cntc[c * 8 + F.tid]; cntc[c * 8 + F.tid] = r; r += v; } }
        __syncthreads();
        for (int c = F.wave; c < nchunk; c += NWAVES) {
            const int sl = c * 64 + F.lane; const int t = F.bid * TPW + (sl >> 1); const bool ok = (sl < nslots && t < M); const int e = ok ? TOPE[2 * t + (sl & 1)] : -1;
            int posn = -1;
#pragma unroll
            for (int x = 0; x < 8; ++x) { const unsigned long long mk = __ballot(e == x); if (e == x) posn = eoff[x] + bef[x] + cntc[c * 8 + x] + __popcll(mk & ((1ull << F.lane) - 1ull)); }
            if (ok) { TOK[posn] = t; GWv[posn] = TOPG[2 * t + (sl & 1)]; DEST[posn] = (sl & 1) * M + t; }
        }
        if (F.bid < 8) { const int e = F.bid; for (int p = eoff[e] + tot[e] + F.tid; p < eoff[e + 1]; p += NTHR) { TOK[p] = 0; GWv[p] = 0.f; DEST[p] = -1; } }
        (void)run;
    }
    if (IN(15)) {
        EpiGateUp<true> E{SSQ3, (bf16*)(ws + WS_HM), DFE, TOK, GWv};
        const int wr = F.wave >> 2, wc = F.wave & 3, fr = F.lane & 15, fq = F.lane >> 4;
        int eo[9];
#pragma unroll
        for (int e = 0; e < 9; ++e) eo[e] = EOFF[e];
        const int NT = eo[8] / 256;
        if constexpr ((MFMA_MASK >> 7) & 1) {
            pg8::SchedMoe Sm; Sm.so.init(NT, 22, F.G, F.bid); Sm.A = (const char*)XB; Sm.B = (const char*)(ws + WS_W_EGU); Sm.tstepA = 0; Sm.tstepB = (size_t)256 * D * 2; Sm.estrideB = (size_t)2 * DFE * D * 2;
#pragma unroll
            for (int e = 0; e < 9; ++e) Sm.eo[e] = eo[e];
            Sm.tok = TOK; Sm.gather = true;
            pg8::gemm_phase<EpiGateUp<true>, pg8::SchedMoe, true, true>(F.lds, Sm, E, D, D, D);
        } else {
        ARowGather ar{XB, D, TOK};
        for (int i = F.bid; i < NT * 22; i += F.G) { Unit u; u.pm = i / 22; u.pn = i % 22; int e = 0;
#pragma unroll
            for (int x = 1; x < 8; ++x) e += (u.pm * 256 >= eo[x]);
            naive_gemm_unit(ar, (const bf16*)(ws + WS_W_EGU) + (size_t)e * 2 * DFE * D + (size_t)u.pn * 256 * D, D, D, u, E, wr, wc, fr, fq); }
        }
    }
    if (IN(16)) {
        EpiMoeDown E{DEST, (bf16*)(ws + WS_Y)};
        const int wr = F.wave >> 2, wc = F.wave & 3, fr = F.lane & 15, fq = F.lane >> 4;
        int eo[9];
#pragma unroll
        for (int e = 0; e < 9; ++e) eo[e] = EOFF[e];
        const int NT = eo[8] / 256;
        if constexpr ((MFMA_MASK >> 8) & 1) {
            pg8::SchedMoe Sm; Sm.so.init(NT, 8, F.G, F.bid); Sm.A = (const char*)(ws + WS_HM); Sm.B = (const char*)(ws + WS_W_EDN); Sm.tstepA = (size_t)256 * DFE * 2; Sm.tstepB = (size_t)256 * DFE * 2; Sm.estrideB = (size_t)D * DFE * 2;
#pragma unroll
            for (int e = 0; e < 9; ++e) Sm.eo[e] = eo[e];
            Sm.tok = nullptr; Sm.gather = false;
            pg8::gemm_phase<EpiMoeDown, pg8::SchedMoe, false, true>(F.lds, Sm, E, DFE, DFE, DFE);
        } else {
        ARowDense ar{(const bf16*)(ws + WS_HM), DFE};
        for (int i = F.bid; i < NT * 8; i += F.G) { Unit u; u.pm = i / 8; u.pn = i % 8; int e = 0;
#pragma unroll
            for (int x = 1; x < 8; ++x) e += (u.pm * 256 >= eo[x]);
            naive_gemm_unit(ar, (const bf16*)(ws + WS_W_EDN) + (size_t)e * D * DFE + (size_t)u.pn * 256 * DFE, DFE, DFE, u, E, wr, wc, fr, fq); }
        }
    }
    if (IN(17)) {
        const bf16* Y = (const bf16*)(ws + WS_Y); const float* gf = args.in[I_FINAL_NORM];
        for (int m = gw; m < M; m += NGW) {
            f32x4* xr = (f32x4*)(xres + (size_t)m * D) + F.lane; const u32x2* y0 = (const u32x2*)(Y + (size_t)m * D) + F.lane; const u32x2* y1 = (const u32x2*)(Y + (size_t)(M + m) * D) + F.lane;
            f32x4 v[8]; float s = 0.f;
#pragma unroll
            for (int j = 0; j < 8; ++j) { const f32x4 x = xr[64 * j]; const u32x2 a = y0[64 * j], b = y1[64 * j];
                v[j] = (f32x4){x.x + bflo(a.x) + bflo(b.x), x.y + bfhi(a.x) + bfhi(b.x), x.z + bflo(a.y) + bflo(b.y), x.w + bfhi(a.y) + bfhi(b.y)};
                s += (v[j].x * v[j].x + v[j].y * v[j].y) + (v[j].z * v[j].z + v[j].w * v[j].w); }
            const float rs = 1.0f / sqrtf(wave_sum(s) * (1.0f / D) + RMS_EPS);
#pragma unroll
            for (int j = 0; j < 8; ++j) { const f32x4 g = *((const f32x4*)gf + F.lane + 64 * j); xr[64 * j] = v[j] * rs * g; }
        }
    }
#undef IN
}

extern "C" void kernel_launch(void* const* d_in, const int* in_sizes, int n_in, void* d_out, int out_size, void* d_ws, size_t ws_size, hipStream_t stream) {
    static int grid = 0;
    if (grid == 0) {
        if (n_in != 28 || in_sizes[0] != M * D || out_size != M * D || ws_size < WS_END) { fprintf(stderr, "kernel_launch: unexpected shapes (n_in %d, in0 %d, out %d, ws %zu); nothing launched\n", n_in, n_in > 0 ? in_sizes[0] : -1, out_size, ws_size); grid = -1; return; }
        int dev = 0, cus = 0;
        if (hipGetDevice(&dev) != hipSuccess || hipDeviceGetAttribute(&cus, hipDeviceAttributeMultiprocessorCount, dev) != hipSuccess) { grid = -1; return; }
        if (hipFuncSetAttribute((const void*)fwd, hipFuncAttributeMaxDynamicSharedMemorySize, LDS_BYTES) != hipSuccess) { grid = -1; return; }
        grid = cus;
    }
    if (grid < 0) return;
    (void)hipMemsetAsync((char*)d_ws + WS_CTL, 0, CTL_ZERO_BYTES, stream);
    Args a{};
    for (int i = 0; i < 28; ++i) a.in[i] = (const float*)d_in[i];
    a.out = (float*)d_out; a.ws = (unsigned char*)d_ws;
    for (int ph = 0; ph < N_PHASES; ++ph) { a.ph_lo = ph; a.ph_hi = ph + 1; hipLaunchKernelGGL(fwd, dim3(grid), dim3(NTHR), LDS_BYTES, stream, a); }
}
```

```cpp
#include <hip/hip_runtime.h>
#include <cstdio>
#include <cstdint>

#define GAS __attribute__((address_space(1)))
#define LAS __attribute__((address_space(3)))
typedef unsigned short bf16;
typedef float f32x4 __attribute__((ext_vector_type(4)));
typedef float f32x2 __attribute__((ext_vector_type(2)));
typedef unsigned u32x4 __attribute__((ext_vector_type(4)));
typedef unsigned u32x2 __attribute__((ext_vector_type(2)));

constexpr int M = 32768, S = 16384, D = 2048;
constexpr int DA = 512, DB = 1536, NIN0 = 5632, DFF = 5632, DRNN = 2560, NEXP = 8, DFE = 2816;
constexpr int NWAVES = 8, NTHR = 512;
constexpr float RMS_EPS = 1e-6f, LN_EPS = 1e-5f;
constexpr int RMAX = 2 * M + NEXP * 256;

constexpr size_t MiB = 1u << 20, KiB = 1u << 10;
constexpr size_t WS_CTL = 0, CTL_ZERO_BYTES = 1 * MiB;
constexpr size_t WS_SSQ0 = 1 * MiB;
constexpr size_t WS_SSQ1 = WS_SSQ0 + 128 * KiB;
constexpr size_t WS_SSQ2 = WS_SSQ1 + 4 * MiB;
constexpr size_t WS_SSQ3 = WS_SSQ2 + 4 * MiB;
constexpr size_t WS_TOPE = WS_SSQ3 + 4 * MiB;
constexpr size_t WS_TOPG = WS_TOPE + 256 * KiB;
constexpr size_t WS_CNT  = WS_TOPG + 256 * KiB;
constexpr size_t WS_EOFF = WS_CNT + 64 * KiB;
constexpr size_t WS_TOK  = WS_EOFF + 4 * KiB;
constexpr size_t WS_GW   = WS_TOK + 272 * KiB;
constexpr size_t WS_DEST = WS_GW + 272 * KiB;
constexpr size_t WS_CA   = WS_DEST + 272 * KiB;
constexpr size_t WS_CB   = WS_CA + 1280 * KiB;
constexpr size_t WS_HIN  = WS_CB + 1280 * KiB;
constexpr size_t WS_SP8  = WS_HIN + 1280 * KiB;
constexpr size_t WS_LSE  = WS_SP8 + 16 * KiB;
constexpr size_t WS_SMALL_END = WS_LSE + 1536 * KiB;
static_assert(WS_SMALL_END <= 20 * MiB, "small region");
constexpr size_t WS_WODD = 20 * MiB;
constexpr size_t WS_W_ODIN = WS_WODD, WS_W_AX = WS_WODD + 20 * MiB, WS_W_ODOUT = WS_W_AX + 3 * MiB;
constexpr size_t WS_WL0 = 53 * MiB;
constexpr size_t WS_W_EVIN = WS_WL0, WS_W_EVOUT = WS_WL0 + 22 * MiB, WS_W_FGU = WS_W_EVOUT + 8 * MiB, WS_W_FDN = WS_W_FGU + 44 * MiB;
constexpr size_t WS_XB = 149 * MiB;
constexpr size_t WS_WEXP = 277 * MiB;
constexpr size_t WS_W_EGU = WS_WEXP, WS_W_EDN = WS_WEXP + 176 * MiB;
constexpr size_t WS_ACT = 541 * MiB;
constexpr size_t WS_END = 1021 * MiB;
constexpr size_t WS_U = WS_ACT, WS_VA = WS_ACT + 32 * MiB, WS_Q = WS_ACT + 64 * MiB, WS_K = WS_ACT + 160 * MiB, WS_V = WS_ACT + 256 * MiB, WS_CAT = WS_ACT + 352 * MiB;
constexpr size_t WS_H = WS_ACT;
constexpr size_t WS_G = WS_ACT, WS_XR = WS_ACT + 160 * MiB, WS_XC = WS_ACT + 320 * MiB, WS_LA = WS_XR;
constexpr size_t WS_BT = WS_WL0;
constexpr size_t WS_HM = WS_ACT;
constexpr size_t WS_Y = 21 * MiB;
static_assert(WS_BT + (size_t)M * DRNN * 2 <= WS_WEXP, "BT overlay");
static_assert(WS_Y + (size_t)2 * M * D * 2 <= WS_WEXP, "Y overlay");
static_assert((size_t)RMAX * DFE * 2 <= 480 * MiB, "HM fits ACT");

constexpr int LDS_BYTES = 147456;
constexpr int LDSCTL_OFF = 146432;
constexpr int CW_BAR = 4096;
static_assert((CW_BAR + 3456) * 4 <= (int)CTL_ZERO_BYTES, "barrier words inside the memset region");

#define LDS_WAIT() asm volatile("s_waitcnt lgkmcnt(0)" ::: "memory")
#define VM_WAIT() asm volatile("s_waitcnt vmcnt(0)" ::: "memory")
__device__ __forceinline__ unsigned f2bf(float f) { unsigned u = __builtin_bit_cast(unsigned, f); return (u + 0x7fffu + ((u >> 16) & 1u)) >> 16; }
__device__ __forceinline__ unsigned pk2(float lo, float hi) { return f2bf(lo) | (f2bf(hi) << 16); }
__device__ __forceinline__ float bflo(unsigned w) { return __builtin_bit_cast(float, w << 16); }
__device__ __forceinline__ float bfhi(unsigned w) { return __builtin_bit_cast(float, w & 0xffff0000u); }
__device__ __forceinline__ float bf2f(bf16 b) { return __builtin_bit_cast(float, ((unsigned)b) << 16); }
__device__ __forceinline__ float wave_sum(float v) {
#pragma unroll
    for (int o = 1; o < 64; o <<= 1) v += __shfl_xor(v, o);
    return v;
}
__device__ __forceinline__ float wave_max(float v) {
#pragma unroll
    for (int o = 1; o < 64; o <<= 1) v = fmaxf(v, __shfl_xor(v, o));
    return v;
}
__device__ __forceinline__ float fast_exp(float x) { return __builtin_amdgcn_exp2f(x * 1.44269504089f); }
__device__ __forceinline__ float sigmoid_f(float x) { return __builtin_amdgcn_rcpf(1.0f + fast_exp(-x)); }
__device__ __forceinline__ float silu_f(float x) { return x * sigmoid_f(x); }
__device__ __forceinline__ float gelu_f(float x) { const float u = 0.7978845608f * (x + 0.044715f * x * x * x); return x * sigmoid_f(2.0f * u); }

#define XB_TMO      128
#define XB_XCNT(j)  (256  + 64 * (j))
#define XB_XSUB(j)  (1280 + 64 * (j))
#define XB_XGEN(j)  (2304 + 64 * (j))
#define XB_TOP      3328
#define XB_TOPGEN   3392
#define XCD_BAR_WORDS 3456
#define XB_SPIN_CAP (1u << 18)

__device__ __forceinline__ unsigned xb_ld(unsigned* p)              { return __hip_atomic_load(p, __ATOMIC_RELAXED, __HIP_MEMORY_SCOPE_AGENT); }
__device__ __forceinline__ unsigned xb_add(unsigned* p, unsigned v) { return __hip_atomic_fetch_add(p, v, __ATOMIC_RELAXED, __HIP_MEMORY_SCOPE_AGENT); }
__device__ __forceinline__ unsigned xb_xcc_id() { return (unsigned)__builtin_amdgcn_s_getreg((3 << 11) | 20) & 0xFu; }
#define XB_SPIN(cond, bar) do { unsigned _sp = 0; while (cond) { __builtin_amdgcn_s_sleep(1); \
    if ((++_sp & 255u) == 0u) { if (xb_ld(&(bar)[XB_TMO])) break; if (_sp > XB_SPIN_CAP) { atomicAdd(&(bar)[XB_TMO], 1u); break; } } } } while (0)

struct XcdBarrier {
    unsigned* bar; unsigned x;
    volatile LAS unsigned* st;
};

__device__ __forceinline__ XcdBarrier xcd_barrier_post(unsigned* bar, volatile LAS unsigned* st) {
    XcdBarrier b; b.bar = bar; b.x = xb_xcc_id(); b.st = st;
    if (threadIdx.x == 0) (void)xb_add(&bar[XB_XCNT(b.x)], 1u);
    return b;
}
__device__ __forceinline__ void xcd_barrier_complete(unsigned* bar, unsigned x, unsigned& nloc, unsigned& nx) {
    const unsigned G = gridDim.x * gridDim.y * gridDim.z;
    unsigned sum, cnt, mine, sp = 0u;
    for (;;) {
        sum = 0u; cnt = 0u; mine = 0u;
#pragma unroll
        for (unsigned j = 0; j < 16; ++j) { const unsigned c = xb_ld(&bar[XB_XCNT(j)]); sum += c; cnt += (c > 0u) ? 1u : 0u; mine = (j == x) ? c : mine; }
        if (sum == G) break;
        __builtin_amdgcn_s_sleep(1);
        if ((++sp & 255u) == 0u) { if (xb_ld(&bar[XB_TMO])) break; if (sp > XB_SPIN_CAP) { atomicAdd(&bar[XB_TMO], 1u); break; } }
    }
    nloc = mine > 0u ? mine : 1u; nx = cnt > 0u ? cnt : 1u;
}

__device__ __forceinline__ void xcd_barrier(const XcdBarrier& b) {
    asm volatile("s_waitcnt vmcnt(0)" ::: "memory");
    __syncthreads();
    if (threadIdx.x == 0) {
        unsigned* bar = b.bar;
        __builtin_amdgcn_s_waitcnt(0);
        unsigned nloc = b.st[0], nx = b.st[1];
        if (nloc == 0u) { xcd_barrier_complete(bar, b.x, nloc, nx); b.st[0] = nloc; b.st[1] = nx; }
        const unsigned old = xb_add(&bar[XB_XSUB(b.x)], 1u);
        const unsigned gen = old / nloc;
        if (old + 1u == (gen + 1u) * nloc) {
            __builtin_amdgcn_fence(__ATOMIC_RELEASE, "agent");
            asm volatile("s_waitcnt vmcnt(0)" ::: "memory");
            const unsigned og = xb_add(&bar[XB_TOP], 1u);
            const unsigned tg = og / nx;
            if (og + 1u == (tg + 1u) * nx) xb_add(&bar[XB_TOPGEN], 1u);
            else XB_SPIN(xb_ld(&bar[XB_TOPGEN]) == tg, bar);
            __builtin_amdgcn_fence(__ATOMIC_ACQUIRE, "agent");
            xb_add(&bar[XB_XGEN(b.x)], 1u);
            asm volatile("s_waitcnt vmcnt(0)" ::: "memory");
        } else {
            XB_SPIN(xb_ld(&bar[XB_XGEN(b.x)]) == gen, bar);
            __builtin_amdgcn_fence(__ATOMIC_ACQUIRE, "agent");
            asm volatile("s_waitcnt vmcnt(0)" ::: "memory");
        }
    }
    __syncthreads();
}

struct Frame {
    LAS unsigned char* lds;
    int tid, lane, wave, bid, G;
};
struct Unit { int pm, pn; };

template <class Map>
__device__ __forceinline__ void cvt_item(const Map& mp, int item, LAS float* scr, int lane) {
    const int nblk = mp.NP / 32, kb = item / nblk, nb = item % nblk, k0 = 64 * kb, n0 = 32 * nb;
#pragma unroll 8
    for (int i = 0; i < 32; ++i) { const int kk = 2 * i + (lane >> 5); scr[kk * 33 + (lane & 31)] = mp.load(k0 + kk, n0 + (lane & 31)); }
    LDS_WAIT();
    const int c = lane & 7;
#pragma unroll
    for (int j = 0; j < 4; ++j) { const int n = (lane >> 3) + 8 * j; const LAS float* s = scr + (8 * c) * 33 + n;
        u32x4 o; o.x = pk2(s[0 * 33], s[1 * 33]); o.y = pk2(s[2 * 33], s[3 * 33]); o.z = pk2(s[4 * 33], s[5 * 33]); o.w = pk2(s[6 * 33], s[7 * 33]);
        *(u32x4*)(mp.dst + (size_t)mp.drow(n0 + n) * mp.K + k0 + 8 * c) = o; }
    LDS_WAIT();
}
struct MapPlain {
    const float* W; const float* gain; bf16* dst; int K, NP;
    __device__ __forceinline__ float load(int k, int np) const { float v = W[(size_t)k * NP + np]; if (gain) v *= gain[k]; return v; }
    __device__ __forceinline__ int drow(int n) const { return n; }
};
struct MapEvIn {
    const float* W; const float* gain; bf16* dst; int K, NP;
    __device__ __forceinline__ float load(int k, int np) const {
        int col = np; float sc = gain[k];
        if (np >= 2 * DA && np < 2 * DA + 2 * DB) {
            const int base = (np < 2 * DA + DB) ? 2 * DA : 2 * DA + DB; const int cp = np - base, head = cp >> 7, c2 = cp & 127;
            col = base + head * 128 + (c2 >> 1) + 64 * (c2 & 1);
            if (np < 2 * DA + DB) sc *= 0.08838834764831845f * 1.4426950408889634f;
        }
        return W[(size_t)k * NP + col] * sc;
    }
    __device__ __forceinline__ int drow(int n) const { return n; }
};
struct MapHalf {
    const float* W; const float* gain; bf16* dst; int K, NP, half;
    __device__ __forceinline__ float load(int k, int n) const { float v = W[(size_t)k * NP + n]; if (gain) v *= gain[k]; return v; }
    __device__ __forceinline__ int drow(int n) const { return ((n >> 7) << 8) + half * 128 + (n & 127); }
};

template <class AR, class Epi>
__device__ __forceinline__ void naive_gemm_unit(const AR& ar, const bf16* Bt, int ldb, int K, const Unit& u, const Epi& E, int wr, int wc, int fr, int fq) {
    f32x4 acc[2][2][4][2];
#pragma unroll
    for (int a = 0; a < 2; ++a)
#pragma unroll
        for (int b = 0; b < 2; ++b)
#pragma unroll
            for (int m = 0; m < 4; ++m)
#pragma unroll
                for (int n = 0; n < 2; ++n) acc[a][b][m][n] = (f32x4){0.f, 0.f, 0.f, 0.f};
    const bf16* ap[2][4];
#pragma unroll
    for (int a = 0; a < 2; ++a)
#pragma unroll
        for (int m = 0; m < 4; ++m) ap[a][m] = ar.row(u, a * 128 + wr * 64 + m * 16 + fr);
#pragma unroll
    for (int b = 0; b < 2; ++b)
#pragma unroll
        for (int n = 0; n < 2; ++n) {
            const bf16* bp = Bt + (size_t)(b * 128 + wc * 32 + 8 * fq + 4 * n) * ldb;
#pragma unroll 1
            for (int k = 0; k < K; k += 4) {
                f32x4 bv[4];
#pragma unroll
                for (int j = 0; j < 4; ++j) { const u32x2 w = *(const u32x2*)(bp + (size_t)j * ldb + k); bv[j] = (f32x4){bflo(w.x), bfhi(w.x), bflo(w.y), bfhi(w.y)}; }
#pragma unroll
                for (int a = 0; a < 2; ++a)
#pragma unroll
                    for (int m = 0; m < 4; ++m) {
                        const u32x2 w = *(const u32x2*)(ap[a][m] + k); const f32x4 av = (f32x4){bflo(w.x), bfhi(w.x), bflo(w.y), bfhi(w.y)};
#pragma unroll
                        for (int j = 0; j < 4; ++j) { const f32x4 p = av * bv[j]; acc[a][b][m][n][j] += (p.x + p.y) + (p.z + p.w); }
                    }
            }
        }
    E(acc, u, wr, wc, fr, fq);
}
struct ARowDense { const bf16* A; int lda; __device__ __forceinline__ const bf16* row(const Unit& u, int r) const { return A + (size_t)(u.pm * 256 + r) * lda; } };
struct ARowGather { const bf16* A; int lda; const int* tok; __device__ __forceinline__ const bf16* row(const Unit& u, int r) const { return A + (size_t)tok[u.pm * 256 + r] * lda; } };

namespace pg8 {
typedef short bf16x8 __attribute__((ext_vector_type(8)));
constexpr int BM = 256, BK = 64, HALF = 128, HTB = HALF * BK * 2, STAGE_BYTES = 8 * HTB, NXCD = 8, WGM = 8;
__host__ __device__ __forceinline__ int lds_byte(int r, int c) { const int st = (r >> 4) * 2 + (c >> 5), rr = r & 15, cc = c & 31, ob = rr * 64 + cc * 2; return st * 1024 + (ob ^ (((ob >> 9) & 1) << 5)); }
__host__ __device__ __forceinline__ void stage_rc(int b, int& R, int& C) { const int st = b / 1024, sb = b % 1024, swz = sb ^ (((sb >> 9) & 1) << 5); R = (st >> 1) * 16 + swz / 64; C = (st & 1) * 32 + (swz % 64) / 2; }
__host__ __device__ __forceinline__ int perm32(int rho) { const int n = rho >> 4, i = rho & 15; return 8 * (i >> 2) + 4 * n + (i & 3); }
struct StaticOrder {
    int nM, nN, nwg, G, c;
    __host__ __device__ void init(int nM_, int nN_, int G_, int c_) { nM = nM_; nN = nN_; nwg = nM * nN; G = G_; c = c_; }
    __host__ __device__ bool next(int i, Unit& u) const {
        const long L = (long)i * G + c; if (L >= nwg) return false;
        int wgid = (int)L; { const int q = nwg / NXCD, r = nwg % NXCD, xcd = wgid % NXCD, off = wgid / NXCD; wgid = (xcd < r ? xcd * (q + 1) : r * (q + 1) + (xcd - r) * q) + off; }
        const int nig = WGM * nN, gid = wgid / nig, fm = gid * WGM, gsz = (nM - fm) < WGM ? (nM - fm) : WGM;
        u.pm = fm + ((wgid % nig) % gsz); u.pn = (wgid % nig) / gsz; return true;
    }
};
template <class Epi, class Sched, bool GATHER, bool ALIGN_EPI>
__device__ __forceinline__ void gemm_phase(LAS unsigned char* lds, const Sched& S, const Epi& E, const int K, const int lda, const int ldb) {
    const int tid = threadIdx.x, wid = __builtin_amdgcn_readfirstlane(tid >> 6), lane = tid & 63, wr = wid >> 2, wc = wid & 3, fr = lane & 15, fq = lane >> 4;
    const int nt = K / BK;
    unsigned voffA[2][2], nvoffA[2][2], voffB[2]; int RA[2]; unsigned CA2[2];
#pragma unroll
    for (int i = 0; i < 2; ++i) { int R, C; stage_rc(tid * 16 + i * 8192, R, C); const int Rb = (R & ~31) + perm32(R & 31);
        voffB[i] = (unsigned)(Rb * ldb + C) * 2u; RA[i] = R; CA2[i] = (unsigned)C * 2u;
        voffA[0][i] = (unsigned)(R * lda + C) * 2u; voffA[1][i] = (unsigned)((R + HALF) * lda + C) * 2u; nvoffA[0][i] = voffA[0][i]; nvoffA[1][i] = voffA[1][i]; }
    const size_t kstep = (size_t)(BK * 2);
    const size_t hstepB = (size_t)HALF * ldb * 2;
    const unsigned ldsw = (unsigned)wid * 1024u;
    const int aoff = lds_byte(wr * 64 + fr, fq * 8), boff = lds_byte(wc * 32 + fr, fq * 8);
#define PG8_SA(b, h) (((b) * 2 + (h)) * HTB)
#define PG8_SB(b, h) ((4 + (b) * 2 + (h)) * HTB)
#define PG8_STAGE(bufoff, gbase, voff) do { _Pragma("unroll") for (int _i = 0; _i < 2; ++_i) \
        __builtin_amdgcn_global_load_lds((const unsigned*)((const char*)(gbase) + (voff)[_i]), (LAS unsigned*)(lds + (bufoff) + ldsw + _i * 8192), 16, 0, 0); } while (0)
#define PG8_LDA(dst, b, h) do { _Pragma("unroll") for (int m = 0; m < 4; ++m) _Pragma("unroll") for (int k = 0; k < 2; ++k) dst[m][k] = *(const LAS bf16x8*)(lds + PG8_SA(b, h) + aoff + m * 2048 + k * 1024); } while (0)
#define PG8_LDB(dst, b, h) do { _Pragma("unroll") for (int n = 0; n < 2; ++n) _Pragma("unroll") for (int k = 0; k < 2; ++k) dst[n][k] = *(const LAS bf16x8*)(lds + PG8_SB(b, h) + boff + n * 2048 + k * 1024); } while (0)
#define PG8_MMA(ai, bj, At, Bt) do { __builtin_amdgcn_s_setprio(1); _Pragma("unroll") for (int m = 0; m < 4; ++m) _Pragma("unroll") for (int n = 0; n < 2; ++n) _Pragma("unroll") for (int k = 0; k < 2; ++k) \
        acc[ai][bj][m][n] = __builtin_amdgcn_mfma_f32_16x16x32_bf16(Bt[n][k], At[m][k], acc[ai][bj][m][n], 0, 0, 0); __builtin_amdgcn_s_setprio(0); } while (0)
#define PG8_WAIT_V(n) asm volatile("s_waitcnt vmcnt(" #n ")" ::: "memory")
#define PG8_WAIT_L(n) asm volatile("s_waitcnt lgkmcnt(" #n ")" ::: "memory")
#define PG8_BAR __builtin_amdgcn_s_barrier()
#define PG8_SCHED __builtin_amdgcn_sched_barrier(0)
    Unit cur, nxt; int ui = 0;
    if (!S.next(0, cur)) return;
    if constexpr (GATHER) {
#pragma unroll
        for (int h = 0; h < 2; ++h)
#pragma unroll
            for (int i = 0; i < 2; ++i) voffA[h][i] = (unsigned)S.tok[cur.pm * BM + h * HALF + RA[i]] * (unsigned)(lda * 2) + CA2[i];
    }
    f32x4 acc[2][2][4][2];
#pragma unroll
    for (int a = 0; a < 2; ++a)
#pragma unroll
        for (int b = 0; b < 2; ++b)
#pragma unroll
            for (int m = 0; m < 4; ++m)
#pragma unroll
                for (int n = 0; n < 2; ++n) acc[a][b][m][n] = (f32x4){0.f, 0.f, 0.f, 0.f};
    bf16x8 At[4][2], B0[2][2], B1[2][2];
    const char* cA = S.a_base(cur); const char* cB = S.b_base(cur);
    PG8_STAGE(PG8_SB(0, 0), cB, voffB); PG8_STAGE(PG8_SB(0, 1), cB + hstepB, voffB); PG8_STAGE(PG8_SA(0, 0), cA, voffA[0]); PG8_STAGE(PG8_SA(0, 1), cA, voffA[1]);
    if (wr == 1) PG8_BAR;
    PG8_WAIT_V(2); PG8_BAR;
    PG8_STAGE(PG8_SB(1, 0), cB + kstep, voffB); PG8_STAGE(PG8_SA(1, 0), cA + kstep, voffA[0]); PG8_STAGE(PG8_SB(1, 1), cB + hstepB + kstep, voffB);
    PG8_WAIT_V(6); PG8_BAR;
    for (;;) {
        const bool has_next = S.next(ui + 1, nxt);
        const char* nA = has_next ? S.a_base(nxt) : cA; const char* nB = has_next ? S.b_base(nxt) : cB;
        if constexpr (GATHER) {
            if (has_next) {
#pragma unroll
                for (int h = 0; h < 2; ++h)
#pragma unroll
                    for (int i = 0; i < 2; ++i) nvoffA[h][i] = (unsigned)S.tok[nxt.pm * BM + h * HALF + RA[i]] * (unsigned)(lda * 2) + CA2[i];
            } else {
#pragma unroll
                for (int h = 0; h < 2; ++h)
#pragma unroll
                    for (int i = 0; i < 2; ++i) nvoffA[h][i] = voffA[h][i];
            }
        }
        for (int t = 0; t < nt; t += 2) {
            const bool last = (t == nt - 2);
            const char* a1 = cA + (size_t)(t + 1) * kstep;
            const char* a2 = last ? nA : cA + (size_t)(t + 2) * kstep; const char* b2 = last ? nB : cB + (size_t)(t + 2) * kstep;
            const char* a3 = a2 + kstep; const char* b3 = b2 + kstep;
            unsigned v2[2][2];
#pragma unroll
            for (int h = 0; h < 2; ++h)
#pragma unroll
                for (int i = 0; i < 2; ++i) v2[h][i] = (GATHER && last) ? nvoffA[h][i] : voffA[h][i];
            PG8_LDB(B0, 0, 0); PG8_LDB(B1, 0, 1); PG8_SCHED; PG8_LDA(At, 0, 0); PG8_STAGE(PG8_SA(1, 1), a1, voffA[1]);
            PG8_WAIT_V(8); PG8_WAIT_L(0); PG8_BAR; PG8_MMA(0, 0, At, B0); PG8_MMA(0, 1, At, B1); PG8_BAR; PG8_SCHED;
            PG8_LDA(At, 0, 1); PG8_STAGE(PG8_SB(0, 0), b2, voffB); PG8_STAGE(PG8_SB(0, 1), b2 + hstepB, voffB); PG8_STAGE(PG8_SA(0, 0), a2, v2[0]);
            PG8_WAIT_V(8); PG8_WAIT_L(0); PG8_BAR; PG8_MMA(1, 0, At, B0); PG8_MMA(1, 1, At, B1); PG8_BAR; PG8_SCHED;
            PG8_LDB(B0, 1, 0); PG8_LDB(B1, 1, 1); PG8_SCHED; PG8_LDA(At, 1, 0); PG8_STAGE(PG8_SA(0, 1), a2, v2[1]);
            PG8_WAIT_V(8); PG8_WAIT_L(0); PG8_BAR; PG8_MMA(0, 0, At, B0); PG8_MMA(0, 1, At, B1); PG8_BAR; PG8_SCHED;
            PG8_LDA(At, 1, 1); PG8_STAGE(PG8_SB(1, 0), b3, voffB); PG8_STAGE(PG8_SB(1, 1), b3 + hstepB, voffB); PG8_STAGE(PG8_SA(1, 0), a3, v2[0]);
            PG8_WAIT_V(8); PG8_WAIT_L(0); PG8_BAR; PG8_MMA(1, 0, At, B0); PG8_MMA(1, 1, At, B1); PG8_BAR; PG8_SCHED;
        }
        if constexpr (ALIGN_EPI) { if (wr == 0) PG8_BAR; }
        E(acc, cur, wr, wc, fr, fq);
        if (!has_next) break;
#pragma unroll
        for (int a = 0; a < 2; ++a)
#pragma unroll
            for (int b = 0; b < 2; ++b)
#pragma unroll
                for (int m = 0; m < 4; ++m)
#pragma unroll
                    for (int n = 0; n < 2; ++n) acc[a][b][m][n] = (f32x4){0.f, 0.f, 0.f, 0.f};
        cur = nxt; cA = nA; cB = nB; ++ui;
        if constexpr (GATHER) {
#pragma unroll
            for (int h = 0; h < 2; ++h)
#pragma unroll
                for (int i = 0; i < 2; ++i) voffA[h][i] = nvoffA[h][i];
        }
        if constexpr (ALIGN_EPI) { if (wr == 1) PG8_BAR; }
    }
    PG8_WAIT_V(0);
    if constexpr (!ALIGN_EPI) { if (wr == 0) PG8_BAR; }
    PG8_BAR;
#undef PG8_SA
#undef PG8_SB
#undef PG8_STAGE
#undef PG8_LDA
#undef PG8_LDB
#undef PG8_MMA
#undef PG8_WAIT_V
#undef PG8_WAIT_L
#undef PG8_BAR
#undef PG8_SCHED
}
struct SchedDense {
    StaticOrder so; const char* A; const char* B; size_t tstepA, tstepB; int acol_shift; size_t acol_bytes; const int* tok;
    __device__ __forceinline__ bool next(int i, Unit& u) const { return so.next(i, u); }
    __device__ __forceinline__ const char* a_base(const Unit& u) const { return A + (size_t)u.pm * tstepA + (acol_shift >= 0 ? (size_t)(u.pn >> acol_shift) * acol_bytes : 0); }
    __device__ __forceinline__ const char* b_base(const Unit& u) const { return B + (size_t)u.pn * tstepB; }
};
struct SchedMoe {
    StaticOrder so; const char* A; const char* B; size_t tstepA, tstepB, estrideB; int eo[9]; const int* tok; bool gather;
    __device__ __forceinline__ bool next(int i, Unit& u) const { return so.next(i, u); }
    __device__ __forceinline__ int expert(int pm) const { int e = 0;
#pragma unroll
        for (int x = 1; x < 8; ++x) e += (pm * 256 >= eo[x]); return e; }
    __device__ __forceinline__ const char* a_base(const Unit& u) const { return gather ? A : A + (size_t)u.pm * tstepA; }
    __device__ __forceinline__ const char* b_base(const Unit& u) const { return B + (size_t)expert(u.pm) * estrideB + (size_t)u.pn * tstepB; }
};
}

__device__ __forceinline__ float rs_from_ssq32(const float* ssq, int row) {
    const f32x4* p = (const f32x4*)(ssq + (size_t)row * 32); float s = 0.f;
#pragma unroll
    for (int i = 0; i < 8; ++i) { const f32x4 v = p[i]; s += (v.x + v.y) + (v.z + v.w); }
    return 1.0f / sqrtf(s * (1.0f / D) + RMS_EPS);
}
__device__ __forceinline__ void store8(bf16* p, const f32x4 v0, const f32x4 v1) {
    u32x4 w; w.x = pk2(v0[0], v0[1]); w.y = pk2(v0[2], v0[3]); w.z = pk2(v1[0], v1[1]); w.w = pk2(v1[2], v1[3]); *(u32x4*)p = w;
}
struct EpiEvIn {
    const float* ssq0; bf16 *U, *VA, *Q, *Kb, *V;
    __device__ __forceinline__ void operator()(const f32x4 (&acc)[2][2][4][2], const Unit& u, int wr, int wc, int fr, int fq) const {
        const int row0 = u.pm * 256 + wr * 64 + fr, cw = wc * 32 + 8 * fq;
        const int pn = u.pn;
        float invf[2][2];
#pragma unroll
        for (int n = 0; n < 2; ++n)
#pragma unroll
            for (int jj = 0; jj < 2; ++jj) { const int i = 16 * wc + 4 * fq + 2 * n + jj; invf[n][jj] = __builtin_amdgcn_exp2f(-13.287712379549449f * (float)i * (1.0f / 64.0f)) * 0.15915494309189535f; }
#pragma unroll
        for (int ai = 0; ai < 2; ++ai)
#pragma unroll
            for (int m = 0; m < 4; ++m) {
                const int r = row0 + ai * 128 + m * 16;
                const float rs = 1.0f / sqrtf(ssq0[r] * (1.0f / D) + RMS_EPS);
                const float pos = (float)(r & (S - 1));
#pragma unroll
                for (int bj = 0; bj < 2; ++bj) {
                    f32x4 v0 = acc[ai][bj][m][0] * rs, v1 = acc[ai][bj][m][1] * rs;
                    if (pn < 4) {
#pragma unroll
                        for (int j = 0; j < 4; ++j) { v0[j] = gelu_f(v0[j]); v1[j] = gelu_f(v1[j]); }
                        bf16* dst = (pn < 2 ? U : VA) + (size_t)r * DA + (pn & 1) * 256 + bj * 128 + cw;
                        store8(dst, v0, v1);
                    } else if (pn < 16) {
#pragma unroll
                        for (int n = 0; n < 2; ++n) {
                            f32x4& v = n ? v1 : v0;
#pragma unroll
                            for (int jj = 0; jj < 2; ++jj) {
                                const float c = invf[n][jj]; const float hi = pos * c; const float lo = __builtin_fmaf(pos, c, -hi);
                                const float fr_ = (hi - floorf(hi)) + lo;
                                const float sn = __builtin_amdgcn_sinf(fr_), cs = __builtin_amdgcn_cosf(fr_);
                                const float x1 = v[2 * jj], x2 = v[2 * jj + 1];
                                v[2 * jj] = x1 * cs - x2 * sn; v[2 * jj + 1] = x2 * cs + x1 * sn;
                            }
                        }
                        const int t = (pn < 10) ? pn - 4 : pn - 10;
                        bf16* dst = (pn < 10 ? Q : Kb) + (size_t)r * DB + t * 256 + bj * 128 + cw;
                        store8(dst, v0, v1);
                    } else {
                        bf16* dst = V + (size_t)r * DB + (pn - 16) * 256 + bj * 128 + cw;
                        store8(dst, v0, v1);
                    }
                }
            }
    }
};
struct EpiResid {
    const float* xi; float* xo; bf16* XB; float* ssq;
    __device__ __forceinline__ void operator()(const f32x4 (&acc)[2][2][4][2], const Unit& u, int wr, int wc, int fr, int fq) const {
        const int row0 = u.pm * 256 + wr * 64 + fr, col0 = u.pn * 256 + wc * 32 + 8 * fq;
#pragma unroll
        for (int ai = 0; ai < 2; ++ai)
#pragma unroll
            for (int m = 0; m < 4; ++m) {
                const int r = row0 + ai * 128 + m * 16; float sq = 0.f;
#pragma unroll
                for (int bj = 0; bj < 2; ++bj) {
                    const size_t off = (size_t)r * D + col0 + bj * 128;
                    const f32x4 x0 = *(const f32x4*)(xi + off), x1 = *(const f32x4*)(xi + off + 4);
                    const f32x4 v0 = x0 + acc[ai][bj][m][0], v1 = x1 + acc[ai][bj][m][1];
                    *(f32x4*)(xo + off) = v0; *(f32x4*)(xo + off + 4) = v1;
                    store8(XB + off, v0, v1);
                    sq += (v0.x * v0.x + v0.y * v0.y) + (v0.z * v0.z + v0.w * v0.w) + (v1.x * v1.x + v1.y * v1.y) + (v1.z * v1.z + v1.w * v1.w);
                }
                sq += __shfl_xor(sq, 16); sq += __shfl_xor(sq, 32);
                if (fq == 0) ssq[(size_t)r * 32 + u.pn * 4 + wc] = sq;
            }
    }
};
template <bool MOE> struct EpiGateUp {
    const float* ssq; bf16* H; int ldh; const int* tok; const float* gw;
    __device__ __forceinline__ void operator()(const f32x4 (&acc)[2][2][4][2], const Unit& u, int wr, int wc, int fr, int fq) const {
        const int row0 = u.pm * 256 + wr * 64 + fr, col0 = u.pn * 128 + wc * 32 + 8 * fq;
#pragma unroll
        for (int ai = 0; ai < 2; ++ai)
#pragma unroll
            for (int m = 0; m < 4; ++m) {
                const int r = row0 + ai * 128 + m * 16;
                const int t = MOE ? tok[r] : r;
                const float rs = rs_from_ssq32(ssq, t);
                const float w = MOE ? gw[r] : 1.0f;
                f32x4 h0, h1;
#pragma unroll
                for (int j = 0; j < 4; ++j) {
                    h0[j] = silu_f(acc[ai][0][m][0][j] * rs) * (acc[ai][1][m][0][j] * rs) * w;
                    h1[j] = silu_f(acc[ai][0][m][1][j] * rs) * (acc[ai][1][m][1][j] * rs) * w;
                }
                store8(H + (size_t)r * ldh + col0, h0, h1);
            }
    }
};
struct EpiOdIn {
    const float* ssq; bf16 *Gb, *XR;
    __device__ __forceinline__ void operator()(const f32x4 (&acc)[2][2][4][2], const Unit& u, int wr, int wc, int fr, int fq) const {
        const int row0 = u.pm * 256 + wr * 64 + fr, cw = wc * 32 + 8 * fq;
        const bool isg = u.pn < 10; const int cb = (isg ? u.pn : u.pn - 10) * 256;
#pragma unroll
        for (int ai = 0; ai < 2; ++ai)
#pragma unroll
            for (int m = 0; m < 4; ++m) {
                const int r = row0 + ai * 128 + m * 16;
                const float rs = rs_from_ssq32(ssq, r);
#pragma unroll
                for (int bj = 0; bj < 2; ++bj) {
                    f32x4 v0 = acc[ai][bj][m][0] * rs, v1 = acc[ai][bj][m][1] * rs;
                    if (isg) {
#pragma unroll
                        for (int j = 0; j < 4; ++j) { v0[j] = gelu_f(v0[j]); v1[j] = gelu_f(v1[j]); }
                    }
                    store8((isg ? Gb : XR) + (size_t)r * DRNN + cb + bj * 128 + cw, v0, v1);
                }
            }
    }
};
struct EpiGates {
    const bf16* XC; const float *b_a, *b_x, *sp8; bf16 *LA, *BT;
    __device__ __forceinline__ void operator()(const f32x4 (&acc)[2][2][4][2], const Unit& u, int wr, int wc, int fr, int fq) const {
        const int row0 = u.pm * 256 + wr * 64 + fr, ch0 = u.pn * 128 + wc * 32 + 8 * fq;
#pragma unroll
        for (int ai = 0; ai < 2; ++ai)
#pragma unroll
            for (int m = 0; m < 4; ++m) {
                const int r = row0 + ai * 128 + m * 16;
                const u32x4 xw = *(const u32x4*)(XC + (size_t)r * DRNN + ch0);
                const float xc[8] = {bflo(xw.x), bfhi(xw.x), bflo(xw.y), bfhi(xw.y), bflo(xw.z), bfhi(xw.z), bflo(xw.w), bfhi(xw.w)};
                f32x4 la[2], bt[2];
#pragma unroll
                for (int n = 0; n < 2; ++n) {
                    const f32x4 ba = *(const f32x4*)(b_a + ch0 + 4 * n), bx = *(const f32x4*)(b_x + ch0 + 4 * n), sp = *(const f32x4*)(sp8 + ch0 + 4 * n);
#pragma unroll
                    for (int j = 0; j < 4; ++j) {
                        const float rg = sigmoid_f(acc[ai][0][m][n][j] + ba[j]), ig = sigmoid_f(acc[ai][1][m][n][j] + bx[j]);
                        const float log_a = sp[j] * rg;
                        const float y2 = 2.0f * log_a;
                        const float om = (y2 > -0.02f) ? -(y2 * (1.0f + y2 * (0.5f + y2 * (1.0f / 6.0f)))) : (1.0f - fast_exp(y2));
                        bt[n][j] = sqrtf(fmaxf(om, 0.f)) * ig * xc[4 * n + j];
                        la[n][j] = log_a * 1.4426950408889634f;
                    }
                }
                store8(LA + (size_t)r * DRNN + ch0, la[0], la[1]);
                store8(BT + (size_t)r * DRNN + ch0, bt[0], bt[1]);
                asm volatile("" ::: "memory");
            }
    }
};
struct EpiMoeDown {
    const int* dest; bf16* Y;
    __device__ __forceinline__ void operator()(const f32x4 (&acc)[2][2][4][2], const Unit& u, int wr, int wc, int fr, int fq) const {
        const int row0 = u.pm * 256 + wr * 64 + fr, col0 = u.pn * 256 + wc * 32 + 8 * fq;
#pragma unroll
        for (int ai = 0; ai < 2; ++ai)
#pragma unroll
            for (int m = 0; m < 4; ++m) {
                const int r = row0 + ai * 128 + m * 16; const int d = dest[r];
                if (d >= 0) {
#pragma unroll
                    for (int bj = 0; bj < 2; ++bj) store8(Y + (size_t)d * D + col0 + bj * 128, acc[ai][bj][m][0], acc[ai][bj][m][1]);
                }
            }
    }
};

typedef short s16x4 __attribute__((ext_vector_type(4)));
template <int OFF> __device__ __forceinline__ s16x4 tr_read(unsigned vb) { s16x4 r; asm volatile("ds_read_b64_tr_b16 %0, %1 offset:%2" : "=&v"(r) : "v"(vb), "i"(OFF) : "memory"); return r; }
template <int P>
__device__ __forceinline__ void attn_pass(const Frame& F, unsigned lds_base, const bf16* Qb, const bf16* Kb, const bf16* Vb, bf16* CAT, float* LSE) {
    typedef pg8::bf16x8 bf16x8;
    constexpr int d = (P == 0) ? 1 : (P == 1 ? 4 : 16);
    constexpr int NBLK = 128 / d;
    constexpr int KP = 272, VP = 288, VOFF = 256 * KP;
    LAS unsigned char* Kl = F.lds; LAS unsigned char* Vl = F.lds + VOFF;
    const int w = F.wave, lane = F.lane, fr = lane & 15, fq = lane >> 4;
    const unsigned vb = lds_base + VOFF + (unsigned)((16 * w + 4 * fq + ((lane & 15) >> 2)) * VP + (lane & 3) * 8);
    for (int u = F.bid; u < 2 * 12 * 128; u += F.G) {
        const int bh = u >> 7, rem = u & 127; const int b = bh / 12, h = bh - b * 12; const int r = rem / NBLK, blk = rem - r * NBLK; const int l0 = blk * 128;
        const size_t rowbase = (size_t)b * S + r;
        const int lq = l0 + 16 * w + fr;
        const size_t qrow = rowbase + (size_t)lq * d;
        bf16x8 qf[4];
        { const bf16* qp = Qb + qrow * DB + h * 128 + 8 * fq;
#pragma unroll
          for (int kk = 0; kk < 4; ++kk) qf[kk] = *(const bf16x8*)(qp + 32 * kk); }
        __syncthreads();
#pragma unroll
        for (int j = 0; j < 8; ++j) { const int pc = F.tid + NTHR * j, wi = pc >> 4, piece = pc & 15, lw = l0 - 128 + wi;
            u32x4 kv = (u32x4){0u, 0u, 0u, 0u}, vv = (u32x4){0u, 0u, 0u, 0u};
            if (lw >= 0) { const size_t o = (rowbase + (size_t)lw * d) * DB + h * 128 + piece * 8; kv = *(const u32x4*)(Kb + o); vv = *(const u32x4*)(Vb + o); }
            *(LAS u32x4*)(Kl + wi * KP + piece * 16) = kv; *(LAS u32x4*)(Vl + wi * VP + piece * 16) = vv; }
        __syncthreads();
        f32x4 sacc[9];
        const LAS unsigned char* kb = Kl + (16 * w + fr) * KP + fq * 16;
#pragma unroll
        for (int t = 0; t < 9; ++t) { sacc[t] = (f32x4){0.f, 0.f, 0.f, 0.f};
#pragma unroll
            for (int kk = 0; kk < 4; ++kk) { const bf16x8 kf = *(const LAS bf16x8*)(kb + t * 16 * KP + kk * 64); sacc[t] = __builtin_amdgcn_mfma_f32_16x16x32_bf16(kf, qf[kk], sacc[t], 0, 0, 0); } }
#pragma unroll
        for (int i = 0; i < 4; ++i) { if (fr > 4 * fq + i) sacc[0][i] = -INFINITY; if (fr < 4 * fq + i) sacc[8][i] = -INFINITY; }
        if (l0 == 0) {
#pragma unroll
            for (int t = 0; t < 8; ++t)
#pragma unroll
                for (int i = 0; i < 4; ++i) if (16 * w + 16 * t + 4 * fq + i < 128) sacc[t][i] = -INFINITY;
        }
        float mx = -INFINITY;
#pragma unroll
        for (int t = 0; t < 9; ++t)
#pragma unroll
            for (int i = 0; i < 4; ++i) mx = fmaxf(mx, sacc[t][i]);
        mx = fmaxf(mx, __shfl_xor(mx, 16)); mx = fmaxf(mx, __shfl_xor(mx, 32));
        float l = 0.f;
#pragma unroll
        for (int t = 0; t < 9; ++t)
#pragma unroll
            for (int i = 0; i < 4; ++i) { const float pv = __builtin_amdgcn_exp2f(sacc[t][i] - mx); sacc[t][i] = pv; l += pv; }
        l += __shfl_xor(l, 16); l += __shfl_xor(l, 32);
        f32x4 oacc[8];
#pragma unroll
        for (int dt = 0; dt < 8; ++dt) oacc[dt] = (f32x4){0.f, 0.f, 0.f, 0.f};
#define ATT_PV(T0, T1, HAS1) do { \
            bf16x8 pk; { const unsigned a0 = pk2(sacc[T0][0], sacc[T0][1]), a1 = pk2(sacc[T0][2], sacc[T0][3]); \
                unsigned b0 = 0u, b1 = 0u; if (HAS1) { b0 = pk2(sacc[(HAS1) ? (T1) : 0][0], sacc[(HAS1) ? (T1) : 0][1]); b1 = pk2(sacc[(HAS1) ? (T1) : 0][2], sacc[(HAS1) ? (T1) : 0][3]); } \
                const u32x4 pw = (u32x4){a0, a1, b0, b1}; pk = __builtin_bit_cast(bf16x8, pw); } \
            s16x4 va[8], vc[8]; \
            va[0] = tr_read<(T0) * 16 * VP + 0 * 32>(vb); vc[0] = tr_read<((HAS1) ? (T1) : (T0)) * 16 * VP + 0 * 32>(vb); \
            va[1] = tr_read<(T0) * 16 * VP + 1 * 32>(vb); vc[1] = tr_read<((HAS1) ? (T1) : (T0)) * 16 * VP + 1 * 32>(vb); \
            va[2] = tr_read<(T0) * 16 * VP + 2 * 32>(vb); vc[2] = tr_read<((HAS1) ? (T1) : (T0)) * 16 * VP + 2 * 32>(vb); \
            va[3] = tr_read<(T0) * 16 * VP + 3 * 32>(vb); vc[3] = tr_read<((HAS1) ? (T1) : (T0)) * 16 * VP + 3 * 32>(vb); \
            va[4] = tr_read<(T0) * 16 * VP + 4 * 32>(vb); vc[4] = tr_read<((HAS1) ? (T1) : (T0)) * 16 * VP + 4 * 32>(vb); \
            va[5] = tr_read<(T0) * 16 * VP + 5 * 32>(vb); vc[5] = tr_read<((HAS1) ? (T1) : (T0)) * 16 * VP + 5 * 32>(vb); \
            va[6] = tr_read<(T0) * 16 * VP + 6 * 32>(vb); vc[6] = tr_read<((HAS1) ? (T1) : (T0)) * 16 * VP + 6 * 32>(vb); \
            va[7] = tr_read<(T0) * 16 * VP + 7 * 32>(vb); vc[7] = tr_read<((HAS1) ? (T1) : (T0)) * 16 * VP + 7 * 32>(vb); \
            asm volatile("s_waitcnt lgkmcnt(0)" ::: "memory"); __builtin_amdgcn_sched_barrier(0); \
            _Pragma("unroll") for (int dt = 0; dt < 8; ++dt) { const bf16x8 vf = (bf16x8){va[dt][0], va[dt][1], va[dt][2], va[dt][3], vc[dt][0], vc[dt][1], vc[dt][2], vc[dt][3]}; \
                oacc[dt] = __builtin_amdgcn_mfma_f32_16x16x32_bf16(vf, pk, oacc[dt], 0, 0, 0); } \
            __builtin_amdgcn_sched_barrier(0); } while (0)
        ATT_PV(0, 1, 1); ATT_PV(2, 3, 1); ATT_PV(4, 5, 1); ATT_PV(6, 7, 1); ATT_PV(8, 8, 0);
#undef ATT_PV
        const float inv = 1.0f / l; const float lse2 = mx + __builtin_amdgcn_logf(l);
        bf16* op = CAT + qrow * D + DA + h * 128 + 4 * fq; float* lp = LSE + qrow * 12 + h;
        if (P == 0) {
#pragma unroll
            for (int dt = 0; dt < 8; ++dt) { u32x2 o; o.x = pk2(oacc[dt][0] * inv, oacc[dt][1] * inv); o.y = pk2(oacc[dt][2] * inv, oacc[dt][3] * inv); *(u32x2*)(op + 16 * dt) = o; }
            if (fq == 0) *lp = lse2;
        } else {
            const float lse1 = *lp; const float mn = fmaxf(lse1, lse2); const float w1 = __builtin_amdgcn_exp2f(lse1 - mn), w2 = __builtin_amdgcn_exp2f(lse2 - mn);
            const float wsum = w1 + w2; const float a1 = w1 / wsum, a2 = (w2 / wsum) * inv;
#pragma unroll
            for (int dt = 0; dt < 8; ++dt) { const u32x2 pv = *(const u32x2*)(op + 16 * dt);
                u32x2 o; o.x = pk2(a1 * bflo(pv.x) + a2 * oacc[dt][0], a1 * bfhi(pv.x) + a2 * oacc[dt][1]); o.y = pk2(a1 * bflo(pv.y) + a2 * oacc[dt][2], a1 * bfhi(pv.y) + a2 * oacc[dt][3]); *(u32x2*)(op + 16 * dt) = o; }
            if (fq == 0) *lp = mn + __builtin_amdgcn_logf(wsum);
        }
    }
    __syncthreads();
}

struct Args { const float* in[28]; float* out; unsigned char* ws; int ph_lo, ph_hi; };
enum { I_X = 0, I_EV_NORM_MIX, I_EV_W_IN, I_EV_LN_G, I_EV_LN_B, I_EV_W_S, I_EV_B_S, I_EV_W_OUT, I_EV_NORM_FFN, I_EV_FFN_GATE, I_EV_FFN_UP, I_EV_FFN_DOWN,
       I_OD_NORM_MIX, I_OD_W_IN, I_OD_CONV_W, I_OD_CONV_B, I_OD_W_A, I_OD_B_A, I_OD_W_X, I_OD_B_X, I_OD_LAM, I_OD_W_OUT, I_OD_NORM_FFN, I_OD_ROUTER,
       I_OD_EXP_GATE, I_OD_EXP_UP, I_OD_EXP_DOWN, I_FINAL_NORM };
constexpr int N_PHASES = 20;

#ifndef MFMA_MASK
#define MFMA_MASK 0x1ff
#endif
template <int ID, class Epi>
__device__ __forceinline__ void dense_gemm_phase(const Frame& F, const bf16* A, int lda, const bf16* Bt, int ldb, int K, int ncol, int nunits, const Epi& E) {
    if constexpr ((MFMA_MASK >> ID) & 1) {
        pg8::SchedDense S; S.so.init(nunits / ncol, ncol, F.G, F.bid); S.A = (const char*)A; S.B = (const char*)Bt; S.tstepA = (size_t)256 * lda * 2; S.tstepB = (size_t)256 * ldb * 2; S.acol_shift = -1; S.acol_bytes = 0; S.tok = nullptr;
        pg8::gemm_phase<Epi, pg8::SchedDense, false, true>(F.lds, S, E, K, lda, ldb);
    } else {
        const int wr = F.wave >> 2, wc = F.wave & 3, fr = F.lane & 15, fq = F.lane >> 4;
        ARowDense ar{A, lda};
        for (int i = F.bid; i < nunits; i += F.G) { Unit u; u.pm = i / ncol; u.pn = i % ncol; naive_gemm_unit(ar, Bt + (size_t)u.pn * 256 * ldb, ldb, K, u, E, wr, wc, fr, fq); }
    }
}

__global__ void __launch_bounds__(NTHR, 2) fwd(Args args) {
    extern __shared__ __attribute__((aligned(16))) unsigned char lds_raw[];
    const unsigned lds_base = (unsigned)(uintptr_t)lds_raw;
    Frame F; F.lds = (LAS unsigned char*)lds_raw; F.tid = threadIdx.x; F.lane = F.tid & 63; F.wave = __builtin_amdgcn_readfirstlane(F.tid >> 6); F.bid = blockIdx.x; F.G = gridDim.x;
    unsigned char* ws = args.ws;
    const int lo = args.ph_lo, hi = args.ph_hi;
#define IN(k) (lo <= (k) && (k) < hi)
#define SEAM(k) do { if (IN(k) && IN((k) + 1)) xcd_barrier(bar); } while (0)
    for (int u = F.tid; u < (LDS_BYTES - LDSCTL_OFF) / 4; u += NTHR) ((LAS unsigned*)(F.lds + LDSCTL_OFF))[u] = 0u;
    __syncthreads();
    XcdBarrier bar = xcd_barrier_post((unsigned*)(ws + WS_CTL) + CW_BAR, (volatile LAS unsigned*)(F.lds + LDSCTL_OFF));
    const int gw = F.bid * NWAVES + F.wave, NGW = F.G * NWAVES;
    const int gt = F.bid * NTHR + F.tid, NGT = F.G * NTHR;
    float* const xres = args.out;
    bf16* const XB = (bf16*)(ws + WS_XB);
    float* const SSQ0 = (float*)(ws + WS_SSQ0); float* const SSQ1 = (float*)(ws + WS_SSQ1); float* const SSQ2 = (float*)(ws + WS_SSQ2); float* const SSQ3 = (float*)(ws + WS_SSQ3);

    if (IN(0)) {
        LAS float* scr = (LAS float*)(F.lds + F.wave * 16384);
        constexpr int I0 = 32 * 176, I1 = 32 * 64, I2 = 32 * 176, I3 = 88 * 64, I4 = 32 * 160, I5 = 4 * 8, I6 = 40 * 64, I7 = 32 * 88, I8 = 44 * 64;
        constexpr int NITEMS = I0 + I1 + 2 * I2 + I3 + I4 + 20 * I5 + I6 + 16 * I7 + 8 * I8;
        for (int it = gw; it < NITEMS; it += NGW) {
            int r = it;
            if (r < I0) { MapEvIn mp{args.in[I_EV_W_IN], args.in[I_EV_NORM_MIX], (bf16*)(ws + WS_W_EVIN), D, NIN0}; cvt_item(mp, r, scr, F.lane); continue; } r -= I0;
            if (r < I1) { MapPlain mp{args.in[I_EV_W_OUT], nullptr, (bf16*)(ws + WS_W_EVOUT), D, D}; cvt_item(mp, r, scr, F.lane); continue; } r -= I1;
            if (r < I2) { MapHalf mp{args.in[I_EV_FFN_GATE], args.in[I_EV_NORM_FFN], (bf16*)(ws + WS_W_FGU), D, DFF, 0}; cvt_item(mp, r, scr, F.lane); continue; } r -= I2;
            if (r < I2) { MapHalf mp{args.in[I_EV_FFN_UP], args.in[I_EV_NORM_FFN], (bf16*)(ws + WS_W_FGU), D, DFF, 1}; cvt_item(mp, r, scr, F.lane); continue; } r -= I2;
            if (r < I3) { MapPlain mp{args.in[I_EV_FFN_DOWN], nullptr, (bf16*)(ws + WS_W_FDN), DFF, D}; cvt_item(mp, r, scr, F.lane); continue; } r -= I3;
            if (r < I4) { MapPlain mp{args.in[I_OD_W_IN], args.in[I_OD_NORM_MIX], (bf16*)(ws + WS_W_ODIN), D, 2 * DRNN}; cvt_item(mp, r, scr, F.lane); continue; } r -= I4;
            if (r < 10 * I5) { const int n = r / I5; MapHalf mp{args.in[I_OD_W_A] + (size_t)n * 65536, nullptr, (bf16*)(ws + WS_W_AX) + (size_t)n * 512 * 256, 256, 256, 0}; cvt_item(mp, r % I5, scr, F.lane); continue; } r -= 10 * I5;
            if (r < 10 * I5) { const int n = r / I5; MapHalf mp{args.in[I_OD_W_X] + (size_t)n * 65536, nullptr, (bf16*)(ws + WS_W_AX) + (size_t)n * 512 * 256, 256, 256, 1}; cvt_item(mp, r % I5, scr, F.lane); continue; } r -= 10 * I5;
            if (r < I6) { MapPlain mp{args.in[I_OD_W_OUT], nullptr, (bf16*)(ws + WS_W_ODOUT), DRNN, D}; cvt_item(mp, r, scr, F.lane); continue; } r -= I6;
            if (r < 8 * I7) { const int e = r / I7; MapHalf mp{args.in[I_OD_EXP_GATE] + (size_t)e * D * DFE, args.in[I_OD_NORM_FFN], (bf16*)(ws + WS_W_EGU) + (size_t)e * 2 * DFE * D, D, DFE, 0}; cvt_item(mp, r % I7, scr, F.lane); continue; } r -= 8 * I7;
            if (r < 8 * I7) { const int e = r / I7; MapHalf mp{args.in[I_OD_EXP_UP] + (size_t)e * D * DFE, args.in[I_OD_NORM_FFN], (bf16*)(ws + WS_W_EGU) + (size_t)e * 2 * DFE * D, D, DFE, 1}; cvt_item(mp, r % I7, scr, F.lane); continue; } r -= 8 * I7;
            { const int e = r / I8; MapPlain mp{args.in[I_OD_EXP_DOWN] + (size_t)e * DFE * D, nullptr, (bf16*)(ws + WS_W_EDN) + (size_t)e * D * DFE, DFE, D}; cvt_item(mp, r % I8, scr, F.lane); }
        }
        for (int c = gt; c < DRNN; c += NGT) ((float*)(ws + WS_SP8))[c] = -8.0f * log1pf(expf(-args.in[I_OD_LAM][c]));
        const float* x = args.in[I_X];
        for (int m = gw; m < M; m += NGW) {
            const f32x4* xr = (const f32x4*)(x + (size_t)m * D) + F.lane; u32x2* o8 = (u32x2*)(XB + (size_t)m * D) + F.lane; float s = 0.f;
#pragma unroll
            for (int j = 0; j < 8; ++j) { const f32x4 v = xr[64 * j]; s += (v.x * v.x + v.y * v.y) + (v.z * v.z + v.w * v.w); u32x2 w; w.x = pk2(v.x, v.y); w.y = pk2(v.z, v.w); o8[64 * j] = w; }
            s = wave_sum(s); if (F.lane == 0) SSQ0[m] = s;
        }
    }
    SEAM(0);
    if (IN(1)) {
        EpiEvIn E{SSQ0, (bf16*)(ws + WS_U), (bf16*)(ws + WS_VA), (bf16*)(ws + WS_Q), (bf16*)(ws + WS_K), (bf16*)(ws + WS_V)};
        dense_gemm_phase<0>(F, XB, D, (const bf16*)(ws + WS_W_EVIN), D, D, NIN0 / 256, (M / 256) * (NIN0 / 256), E);
    }
    SEAM(1);
    if (IN(2)) {
        const bf16* U = (const bf16*)(ws + WS_U); const bf16* VA = (const bf16*)(ws + WS_VA); bf16* CAT = (bf16*)(ws + WS_CAT);
        const float* ln_g = args.in[I_EV_LN_G]; const float* ln_b = args.in[I_EV_LN_B]; const float* Ws = args.in[I_EV_W_S]; const float* bs = args.in[I_EV_B_S];
        LAS float* stats = (LAS float*)F.lds;
        LAS float* vln = (LAS float*)(F.lds + 1024);
        for (int c = F.bid; c < M / 128; c += F.G) {
            const int r0 = c * 128;
            for (int rr = 0; rr < 16; ++rr) {
                const int s = F.wave * 16 + rr; const u32x4 w = *(const u32x4*)(VA + (size_t)(r0 + s) * DA + 8 * F.lane);
                const float v[8] = {bflo(w.x), bfhi(w.x), bflo(w.y), bfhi(w.y), bflo(w.z), bfhi(w.z), bflo(w.w), bfhi(w.w)};
                float sm = 0.f;
#pragma unroll
                for (int i = 0; i < 8; ++i) sm += v[i];
                const float mean = wave_sum(sm) * (1.0f / DA); float q = 0.f;
#pragma unroll
                for (int i = 0; i < 8; ++i) { const float d = v[i] - mean; q += d * d; }
                const float var = wave_sum(q) * (1.0f / DA);
                if (F.lane == 0) { stats[2 * s] = mean; stats[2 * s + 1] = 1.0f / sqrtf(var + LN_EPS); }
            }
            __syncthreads();
            for (int g = 0; g < 4; ++g) {
                { const int s = F.tid >> 2, cq = (F.tid & 3) * 32; const float mean = stats[2 * s], rstd = stats[2 * s + 1];
#pragma unroll
                  for (int i4 = 0; i4 < 4; ++i4) { const int col = g * 128 + cq + 8 * i4; const u32x4 w = *(const u32x4*)(VA + (size_t)(r0 + s) * DA + col);
                      const float v[8] = {bflo(w.x), bfhi(w.x), bflo(w.y), bfhi(w.y), bflo(w.z), bfhi(w.z), bflo(w.w), bfhi(w.w)};
#pragma unroll
                      for (int i = 0; i < 8; ++i) vln[s * 128 + cq + 8 * i4 + i] = (v[i] - mean) * rstd * ln_g[col + i] + ln_b[col + i]; } }
                __syncthreads();
                { const int t = F.tid >> 2, dq = (F.tid & 3) * 32; float a[32];
#pragma unroll
                  for (int i = 0; i < 32; ++i) a[i] = 0.f;
                  const float* wrow = Ws + (size_t)(g * 128 + t) * 128;
                  for (int s = 0; s <= t; ++s) { const float w = wrow[s]; const LAS f32x4* vp = (const LAS f32x4*)(vln + s * 128 + dq);
#pragma unroll
                      for (int i = 0; i < 8; ++i) { const f32x4 v = vp[i]; a[4 * i] += w * v.x; a[4 * i + 1] += w * v.y; a[4 * i + 2] += w * v.z; a[4 * i + 3] += w * v.w; } }
                  const float bias = bs[g * 128 + t];
#pragma unroll
                  for (int i4 = 0; i4 < 4; ++i4) { const int col = g * 128 + dq + 8 * i4; const u32x4 w = *(const u32x4*)(U + (size_t)(r0 + t) * DA + col);
                      const float uv[8] = {bflo(w.x), bfhi(w.x), bflo(w.y), bfhi(w.y), bflo(w.z), bfhi(w.z), bflo(w.w), bfhi(w.w)};
                      u32x4 o; o.x = pk2(uv[0] * (a[8 * i4] + bias), uv[1] * (a[8 * i4 + 1] + bias)); o.y = pk2(uv[2] * (a[8 * i4 + 2] + bias), uv[3] * (a[8 * i4 + 3] + bias));
                      o.z = pk2(uv[4] * (a[8 * i4 + 4] + bias), uv[5] * (a[8 * i4 + 5] + bias)); o.w = pk2(uv[6] * (a[8 * i4 + 6] + bias), uv[7] * (a[8 * i4 + 7] + bias));
                      *(u32x4*)(CAT + (size_t)(r0 + t) * D + col) = o; } }
                __syncthreads();
            }
        }
        __syncthreads();
        attn_pass<0>(F, lds_base, (const bf16*)(ws + WS_Q), (const bf16*)(ws + WS_K), (const bf16*)(ws + WS_V), CAT, (float*)(ws + WS_LSE));
    }
    SEAM(2);
    if (IN(3)) attn_pass<1>(F, lds_base, (const bf16*)(ws + WS_Q), (const bf16*)(ws + WS_K), (const bf16*)(ws + WS_V), (bf16*)(ws + WS_CAT), (float*)(ws + WS_LSE));
    SEAM(3);
    if (IN(4)) attn_pass<2>(F, lds_base, (const bf16*)(ws + WS_Q), (const bf16*)(ws + WS_K), (const bf16*)(ws + WS_V), (bf16*)(ws + WS_CAT), (float*)(ws + WS_LSE));
    SEAM(4);
    if (IN(5)) {
        EpiResid E{args.in[I_X], xres, XB, SSQ1};
        dense_gemm_phase<1>(F, (const bf16*)(ws + WS_CAT), D, (const bf16*)(ws + WS_W_EVOUT), D, D, D / 256, (M / 256) * (D / 256), E);
    }
    SEAM(5);
    if (IN(6)) {
        EpiGateUp<false> E{SSQ1, (bf16*)(ws + WS_H), DFF, nullptr, nullptr};
        dense_gemm_phase<2>(F, XB, D, (const bf16*)(ws + WS_W_FGU), D, D, 2 * DFF / 256, (M / 256) * (2 * DFF / 256), E);
    }
    SEAM(6);
    if (IN(7)) {
        EpiResid E{xres, xres, XB, SSQ2};
        dense_gemm_phase<3>(F, (const bf16*)(ws + WS_H), DFF, (const bf16*)(ws + WS_W_FDN), DFF, DFF, D / 256, (M / 256) * (D / 256), E);
    }
    SEAM(7);
    if (IN(8)) {
        EpiOdIn E{SSQ2, (bf16*)(ws + WS_G), (bf16*)(ws + WS_XR)};
        dense_gemm_phase<4>(F, XB, D, (const bf16*)(ws + WS_W_ODIN), D, D, 2 * DRNN / 256, (M / 256) * (2 * DRNN / 256), E);
    }
    SEAM(8);
    if (IN(9)) {
        const bf16* XR = (const bf16*)(ws + WS_XR); bf16* XC = (bf16*)(ws + WS_XC); const float* cw = args.in[I_OD_CONV_W]; const float* cb = args.in[I_OD_CONV_B];
        for (int idx = gt; idx < M * (DRNN / 8); idx += NGT) {
            const int row = idx / (DRNN / 8), cg = idx - row * (DRNN / 8), ch = cg * 8; const int pos = row & (S - 1);
            float y[8];
#pragma unroll
            for (int i = 0; i < 8; ++i) y[i] = cb[ch + i];
#pragma unroll
            for (int tap = 0; tap < 4; ++tap) { const int sp = pos - 3 + tap;
                if (sp >= 0) { const u32x4 w = *(const u32x4*)(XR + (size_t)(row - 3 + tap) * DRNN + ch);
                    const float v[8] = {bflo(w.x), bfhi(w.x), bflo(w.y), bfhi(w.y), bflo(w.z), bfhi(w.z), bflo(w.w), bfhi(w.w)};
#pragma unroll
                    for (int i = 0; i < 8; ++i) y[i] += v[i] * cw[tap * DRNN + ch + i]; } }
            u32x4 o; o.x = pk2(y[0], y[1]); o.y = pk2(y[2], y[3]); o.z = pk2(y[4], y[5]); o.w = pk2(y[6], y[7]);
            *(u32x4*)(XC + (size_t)row * DRNN + ch) = o;
        }
    }
    SEAM(9);
    if (IN(10)) {
        const bf16* XC = (const bf16*)(ws + WS_XC);
        EpiGates E{XC, args.in[I_OD_B_A], args.in[I_OD_B_X], (const float*)(ws + WS_SP8), (bf16*)(ws + WS_LA), (bf16*)(ws + WS_BT)};
        if constexpr ((MFMA_MASK >> 5) & 1) {
            pg8::SchedDense Sg; Sg.so.init(M / 256, 20, F.G, F.bid); Sg.A = (const char*)XC; Sg.B = (const char*)(ws + WS_W_AX); Sg.tstepA = (size_t)256 * DRNN * 2; Sg.tstepB = (size_t)256 * 256 * 2; Sg.acol_shift = 1; Sg.acol_bytes = 512; Sg.tok = nullptr;
            pg8::gemm_phase<EpiGates, pg8::SchedDense, false, true>(F.lds, Sg, E, 256, DRNN, 256);
        } else {
        const int wr = F.wave >> 2, wc = F.wave & 3, fr = F.lane & 15, fq = F.lane >> 4;
        for (int i = F.bid; i < (M / 256) * 20; i += F.G) { Unit u; u.pm = i / 20; u.pn = i % 20;
            ARowDense ar{XC + (u.pn >> 1) * 256, DRNN};
            naive_gemm_unit(ar, (const bf16*)(ws + WS_W_AX) + (size_t)u.pn * 256 * 256, 256, 256, u, E, wr, wc, fr, fq); }
        }
    }
    SEAM(10);
    const bf16* LA = (const bf16*)(ws + WS_LA); const bf16* BT = (const bf16*)(ws + WS_BT);
    float* CA = (float*)(ws + WS_CA); float* CBv = (float*)(ws + WS_CB); float* HIN = (float*)(ws + WS_HIN);
    if (IN(11)) {
        for (int idx = gt; idx < 2 * 64 * DRNN; idx += NGT) {
            const int ch = idx % DRNN, bc = idx / DRNN; const size_t base = (size_t)bc * 256 * DRNN + ch;
            float h = 0.f, P = 1.f;
            for (int t = 0; t < 256; ++t) { const float a = __builtin_amdgcn_exp2f(bf2f(LA[base + (size_t)t * DRNN])); const float bb = bf2f(BT[base + (size_t)t * DRNN]); h = a * h + bb; P *= a; }
            CA[idx] = P; CBv[idx] = h;
        }
    }
    SEAM(11);
    if (IN(12)) {
        for (int idx = gt; idx < 2 * DRNN; idx += NGT) {
            const int b = idx / DRNN, ch = idx - b * DRNN; float h = 0.f;
            for (int c = 0; c < 64; ++c) { const int k = (b * 64 + c) * DRNN + ch; HIN[k] = h; h = CA[k] * h + CBv[k]; }
        }
    }
    SEAM(12);
    if (IN(13)) {
        bf16* Gb = (bf16*)(ws + WS_G);
        for (int idx = gt; idx < 2 * 64 * DRNN; idx += NGT) {
            const int ch = idx % DRNN, bc = idx / DRNN; const size_t base = (size_t)bc * 256 * DRNN + ch;
            float h = HIN[idx];
            for (int t = 0; t < 256; ++t) { const size_t o = base + (size_t)t * DRNN; const float a = __builtin_amdgcn_exp2f(bf2f(LA[o])); const float bb = bf2f(BT[o]); h = a * h + bb; Gb[o] = (bf16)f2bf(bf2f(Gb[o]) * h); }
        }
    }
    SEAM(13);
    if (IN(14)) {
        EpiResid E{xres, xres, XB, SSQ3};
        dense_gemm_phase<6>(F, (const bf16*)(ws + WS_G), DRNN, (const bf16*)(ws + WS_W_ODOUT), DRNN, DRNN, D / 256, (M / 256) * (D / 256), E);
    }
    SEAM(14);
    int* TOPE = (int*)(ws + WS_TOPE); float* TOPG = (float*)(ws + WS_TOPG); int* CNT = (int*)(ws + WS_CNT); int* EOFF = (int*)(ws + WS_EOFF);
    int* TOK = (int*)(ws + WS_TOK); float* GWv = (float*)(ws + WS_GW); int* DEST = (int*)(ws + WS_DEST);
    const int TPW = (M + F.G - 1) / F.G;
    if (IN(15)) {
        const float* Wr = args.in[I_OD_ROUTER]; const float* gn = args.in[I_OD_NORM_FFN];
        LAS int* cnt8 = (LAS int*)F.lds;
        if (F.tid < 8) cnt8[F.tid] = 0;
        __syncthreads();
        int myc[8];
#pragma unroll
        for (int e = 0; e < 8; ++e) myc[e] = 0;
        for (int tl = F.wave; tl < TPW; tl += NWAVES) {
            const int t = F.bid * TPW + tl; if (t >= M) break;
            float a[8];
#pragma unroll
            for (int e = 0; e < 8; ++e) a[e] = 0.f;
            const f32x4* xr = (const f32x4*)(xres + (size_t)t * D) + F.lane;
#pragma unroll
            for (int j = 0; j < 8; ++j) { const int k0 = 4 * F.lane + 256 * j; const f32x4 xv = xr[64 * j]; const f32x4 gv = *(const f32x4*)(gn + k0);
#pragma unroll
                for (int kk = 0; kk < 4; ++kk) { const float xg = xv[kk] * gv[kk]; const f32x4 w0 = *(const f32x4*)(Wr + (size_t)(k0 + kk) * 8), w1 = *(const f32x4*)(Wr + (size_t)(k0 + kk) * 8 + 4);
                    a[0] += xg * w0.x; a[1] += xg * w0.y; a[2] += xg * w0.z; a[3] += xg * w0.w; a[4] += xg * w1.x; a[5] += xg * w1.y; a[6] += xg * w1.z; a[7] += xg * w1.w; } }
#pragma unroll
            for (int e = 0; e < 8; ++e) a[e] = wave_sum(a[e]);
            const float sq = (F.lane < 32) ? SSQ3[(size_t)t * 32 + F.lane] : 0.f; const float rs = 1.0f / sqrtf(wave_sum(sq) * (1.0f / D) + RMS_EPS);
            int e1 = 0; float l1 = a[0];
#pragma unroll
            for (int e = 1; e < 8; ++e) if (a[e] > l1) { l1 = a[e]; e1 = e; }
            int e2 = -1; float l2 = -INFINITY;
#pragma unroll
            for (int e = 0; e < 8; ++e) if (e != e1 && a[e] > l2) { l2 = a[e]; e2 = e; }
            const float g1 = 1.0f / (1.0f + expf((l2 - l1) * rs)), g2 = 1.0f - g1;
            if (F.lane == 0) { TOPE[2 * t] = e1; TOPE[2 * t + 1] = e2; TOPG[2 * t] = g1; TOPG[2 * t + 1] = g2; }
#pragma unroll
            for (int e = 0; e < 8; ++e) myc[e] += (e == e1) + (e == e2);
        }
        if (F.lane == 0) {
#pragma unroll
            for (int e = 0; e < 8; ++e) atomicAdd((int*)(lds_raw) + e, myc[e]);
        }
        __syncthreads();
        if (F.tid < 8) CNT[F.bid * 8 + F.tid] = cnt8[F.tid];
    }
    SEAM(15);
    if (IN(16)) {
        LAS int* tot = (LAS int*)F.lds;
        LAS int* bef = tot + 8;
        LAS int* eoff = tot + 16;
        LAS int* cntc = tot + 32;
        LAS int* run = tot + 32 + 8 * 64;
        if (F.tid < 8) { int t = 0, b = 0; for (int w = 0; w < F.G; ++w) { const int c = CNT[w * 8 + F.tid]; t += c; if (w < F.bid) b += c; } tot[F.tid] = t; bef[F.tid] = b; }
        __syncthreads();
        if (F.tid == 0) { int o = 0; for (int e = 0; e < 8; ++e) { eoff[e] = o; o += (tot[e] + 255) & ~255; } eoff[8] = o; }
        __syncthreads();
        if (F.bid == 0 && F.tid < 9) EOFF[F.tid] = eoff[F.tid];
        const int nslots = 2 * TPW, nchunk = (nslots + 63) / 64;
        for (int c = F.wave; c < nchunk; c += NWAVES) {
            const int sl = c * 64 + F.lane; const int t = F.bid * TPW + (sl >> 1); const int e = (sl < nslots && t < M) ? TOPE[2 * t + (sl & 1)] : -1;
#pragma unroll
            for (int x = 0; x < 8; ++x) { const unsigned long long mk = __ballot(e == x); if (F.lane == 0) cntc[c * 8 + x] = __popcll(mk); }
        }
        __syncthreads();
        if (F.tid < 8) { int r = 0; for (int c = 0; c < nchunk; ++c) { const int v = cntc[c * 8 + F.tid]; cntc[c * 8 + F.tid] = r; r += v; } }
        __syncthreads();
        for (int c = F.wave; c < nchunk; c += NWAVES) {
            const int sl = c * 64 + F.lane; const int t = F.bid * TPW + (sl >> 1); const bool ok = (sl < nslots && t < M); const int e = ok ? TOPE[2 * t + (sl & 1)] : -1;
            int posn = -1;
#pragma unroll
            for (int x = 0; x < 8; ++x) { const unsigned long long mk = __ballot(e == x); if (e == x) posn = eoff[x] + bef[x] + cntc[c * 8 + x] + __popcll(mk & ((1ull << F.lane) - 1ull)); }
            if (ok) { TOK[posn] = t; GWv[posn] = TOPG[2 * t + (sl & 1)]; DEST[posn] = (sl & 1) * M + t; }
        }
        if (F.bid < 8) { const int e = F.bid; for (int p = eoff[e] + tot[e] + F.tid; p < eoff[e + 1]; p += NTHR) { TOK[p] = 0; GWv[p] = 0.f; DEST[p] = -1; } }
        (void)run;
    }
    SEAM(16);
    if (IN(17)) {
        EpiGateUp<true> E{SSQ3, (bf16*)(ws + WS_HM), DFE, TOK, GWv};
        const int wr = F.wave >> 2, wc = F.wave & 3, fr = F.lane & 15, fq = F.lane >> 4;
        int eo[9];
#pragma unroll
        for (int e = 0; e < 9; ++e) eo[e] = EOFF[e];
        const int NT = eo[8] / 256;
        if constexpr ((MFMA_MASK >> 7) & 1) {
            pg8::SchedMoe Sm; Sm.so.init(NT, 22, F.G, F.bid); Sm.A = (const char*)XB; Sm.B = (const char*)(ws + WS_W_EGU); Sm.tstepA = 0; Sm.tstepB = (size_t)256 * D * 2; Sm.estrideB = (size_t)2 * DFE * D * 2;
#pragma unroll
            for (int e = 0; e < 9; ++e) Sm.eo[e] = eo[e];
            Sm.tok = TOK; Sm.gather = true;
            pg8::gemm_phase<EpiGateUp<true>, pg8::SchedMoe, true, true>(F.lds, Sm, E, D, D, D);
        } else {
        ARowGather ar{XB, D, TOK};
        for (int i = F.bid; i < NT * 22; i += F.G) { Unit u; u.pm = i / 22; u.pn = i % 22; int e = 0;
#pragma unroll
            for (int x = 1; x < 8; ++x) e += (u.pm * 256 >= eo[x]);
            naive_gemm_unit(ar, (const bf16*)(ws + WS_W_EGU) + (size_t)e * 2 * DFE * D + (size_t)u.pn * 256 * D, D, D, u, E, wr, wc, fr, fq); }
        }
    }
    SEAM(17);
    if (IN(18)) {
        EpiMoeDown E{DEST, (bf16*)(ws + WS_Y)};
        const int wr = F.wave >> 2, wc = F.wave & 3, fr = F.lane & 15, fq = F.lane >> 4;
        int eo[9];
#pragma unroll
        for (int e = 0; e < 9; ++e) eo[e] = EOFF[e];
        const int NT = eo[8] / 256;
        if constexpr ((MFMA_MASK >> 8) & 1) {
            pg8::SchedMoe Sm; Sm.so.init(NT, 8, F.G, F.bid); Sm.A = (const char*)(ws + WS_HM); Sm.B = (const char*)(ws + WS_W_EDN); Sm.tstepA = (size_t)256 * DFE * 2; Sm.tstepB = (size_t)256 * DFE * 2; Sm.estrideB = (size_t)D * DFE * 2;
#pragma unroll
            for (int e = 0; e < 9; ++e) Sm.eo[e] = eo[e];
            Sm.tok = nullptr; Sm.gather = false;
            pg8::gemm_phase<EpiMoeDown, pg8::SchedMoe, false, true>(F.lds, Sm, E, DFE, DFE, DFE);
        } else {
        ARowDense ar{(const bf16*)(ws + WS_HM), DFE};
        for (int i = F.bid; i < NT * 8; i += F.G) { Unit u; u.pm = i / 8; u.pn = i % 8; int e = 0;
#pragma unroll
            for (int x = 1; x < 8; ++x) e += (u.pm * 256 >= eo[x]);
            naive_gemm_unit(ar, (const bf16*)(ws + WS_W_EDN) + (size_t)e * D * DFE + (size_t)u.pn * 256 * DFE, DFE, DFE, u, E, wr, wc, fr, fq); }
        }
    }
    SEAM(18);
    if (IN(19)) {
        const bf16* Y = (const bf16*)(ws + WS_Y); const float* gf = args.in[I_FINAL_NORM];
        for (int m = gw; m < M; m += NGW) {
            f32x4* xr = (f32x4*)(xres + (size_t)m * D) + F.lane; const u32x2* y0 = (const u32x2*)(Y + (size_t)m * D) + F.lane; const u32x2* y1 = (const u32x2*)(Y + (size_t)(M + m) * D) + F.lane;
            f32x4 v[8]; float s = 0.f;
#pragma unroll
            for (int j = 0; j < 8; ++j) { const f32x4 x = xr[64 * j]; const u32x2 a = y0[64 * j], b = y1[64 * j];
                v[j] = (f32x4){x.x + bflo(a.x) + bflo(b.x), x.y + bfhi(a.x) + bfhi(b.x), x.z + bflo(a.y) + bflo(b.y), x.w + bfhi(a.y) + bfhi(b.y)};
                s += (v[j].x * v[j].x + v[j].y * v[j].y) + (v[j].z * v[j].z + v[j].w * v[j].w); }
            const float rs = 1.0f / sqrtf(wave_sum(s) * (1.0f / D) + RMS_EPS);
#pragma unroll
            for (int j = 0; j < 8; ++j) { const f32x4 g = *((const f32x4*)gf + F.lane + 64 * j); xr[64 * j] = v[j] * rs * g; }
        }
    }
#undef IN
#undef SEAM
}

extern "C" void kernel_launch(void* const* d_in, const int* in_sizes, int n_in, void* d_out, int out_size, void* d_ws, size_t ws_size, hipStream_t stream) {
    static int grid = 0;
    if (grid == 0) {
        if (n_in != 28 || in_sizes[0] != M * D || out_size != M * D || ws_size < WS_END) { fprintf(stderr, "kernel_launch: unexpected shapes (n_in %d, in0 %d, out %d, ws %zu); nothing launched\n", n_in, n_in > 0 ? in_sizes[0] : -1, out_size, ws_size); grid = -1; return; }
        int dev = 0, cus = 0;
        if (hipGetDevice(&dev) != hipSuccess || hipDeviceGetAttribute(&cus, hipDeviceAttributeMultiprocessorCount, dev) != hipSuccess) { grid = -1; return; }
        if (hipFuncSetAttribute((const void*)fwd, hipFuncAttributeMaxDynamicSharedMemorySize, LDS_BYTES) != hipSuccess) { grid = -1; return; }
        int per_cu = 0;
        if (hipOccupancyMaxActiveBlocksPerMultiprocessor(&per_cu, (const void*)fwd, NTHR, LDS_BYTES) != hipSuccess || per_cu < 1) { fprintf(stderr, "kernel_launch: occupancy query says %d blocks per CU\n", per_cu); (void)hipGetLastError(); }
        grid = cus;
    }
    if (grid < 0) return;
    (void)hipMemsetAsync((char*)d_ws + WS_CTL, 0, CTL_ZERO_BYTES, stream);
    Args a{};
    for (int i = 0; i < 28; ++i) a.in[i] = (const float*)d_in[i];
    a.out = (float*)d_out; a.ws = (unsigned char*)d_ws;
#if defined(MK_PER_PHASE)
    for (int ph = 0; ph < N_PHASES; ++ph) { a.ph_lo = ph; a.ph_hi = ph + 1; hipLaunchKernelGGL(fwd, dim3(grid), dim3(NTHR), LDS_BYTES, stream, a); }
#else
    a.ph_lo = 0; a.ph_hi = N_PHASES;
    hipLaunchKernelGGL(fwd, dim3(grid), dim3(NTHR), LDS_BYTES, stream, a);
#endif
}
```

```cpp
#include <hip/hip_runtime.h>
#include <cstdio>
#include <cstdint>

#define GAS __attribute__((address_space(1)))
#define LAS __attribute__((address_space(3)))
typedef unsigned short bf16;
typedef float f32x4 __attribute__((ext_vector_type(4)));
typedef float f32x2 __attribute__((ext_vector_type(2)));
typedef unsigned u32x4 __attribute__((ext_vector_type(4)));
typedef unsigned u32x2 __attribute__((ext_vector_type(2)));

constexpr int M = 32768, S = 16384, D = 2048;
constexpr int DA = 512, DB = 1536, NIN0 = 5632, DFF = 5632, DRNN = 2560, NEXP = 8, DFE = 2816;
constexpr int NWAVES = 8, NTHR = 512;
constexpr float RMS_EPS = 1e-6f, LN_EPS = 1e-5f;
constexpr int FGU_KB = 1536, FGU_P = 2 * FGU_KB + (D - FGU_KB);
constexpr int C2P = 2 * DA + DB;
constexpr int RMAX = 2 * M + NEXP * 256;

constexpr size_t MiB = 1u << 20, KiB = 1u << 10;
constexpr size_t WS_CTL = 0, CTL_ZERO_BYTES = 1 * MiB;
constexpr size_t WS_SSQ0 = 1 * MiB;
constexpr size_t WS_SSQ1 = WS_SSQ0 + 128 * KiB;
constexpr size_t WS_SSQ2 = WS_SSQ1 + 4 * MiB;
constexpr size_t WS_SSQ3 = WS_SSQ2 + 4 * MiB;
constexpr size_t WS_TOPE = WS_SSQ3 + 4 * MiB;
constexpr size_t WS_TOPG = WS_TOPE + 256 * KiB;
constexpr size_t WS_CNT  = WS_TOPG + 256 * KiB;
constexpr size_t WS_EOFF = WS_CNT + 64 * KiB;
constexpr size_t WS_TOK  = WS_EOFF + 4 * KiB;
constexpr size_t WS_GW   = WS_TOK + 272 * KiB;
constexpr size_t WS_DEST = WS_GW + 272 * KiB;
constexpr size_t WS_CA   = WS_DEST + 272 * KiB;
constexpr size_t WS_CB   = WS_CA + 1280 * KiB;
constexpr size_t WS_HIN  = WS_CB + 1280 * KiB;
constexpr size_t WS_SP8  = WS_HIN + 1280 * KiB;
constexpr size_t WS_LSE  = WS_SP8 + 16 * KiB;
constexpr size_t WS_WSM  = WS_LSE + 1536 * KiB;
constexpr size_t WS_SMALL_END = WS_WSM + 128 * KiB;
static_assert(WS_SMALL_END <= 20 * MiB, "small region");
constexpr size_t WS_WODD = 20 * MiB;
constexpr size_t WS_W_ODIN = WS_WODD, WS_W_AX = WS_WODD + 20 * MiB, WS_W_ODOUT = WS_W_AX + 3 * MiB;
constexpr size_t WS_WL0 = 53 * MiB;
constexpr size_t WS_W_EVIN = WS_WL0, WS_W_EVOUT = WS_WL0 + 22 * MiB, WS_W_FGU = WS_W_EVOUT + 8 * MiB, WS_W_FDN = WS_W_FGU + 44 * MiB;
constexpr size_t WS_XB = 149 * MiB;
constexpr size_t WS_WEXP = 277 * MiB;
constexpr size_t WS_W_EGU = WS_WEXP, WS_W_EDN = WS_WEXP + 176 * MiB;
constexpr size_t WS_ACT = 541 * MiB;
constexpr size_t WS_END = 1021 * MiB;
constexpr size_t WS_U = WS_ACT, WS_VA = WS_ACT + 32 * MiB, WS_Q = WS_ACT + 64 * MiB, WS_K = WS_ACT + 160 * MiB, WS_V = WS_ACT + 256 * MiB, WS_CAT = WS_ACT + 352 * MiB;
constexpr size_t WS_X18 = WS_CAT;
constexpr long X18_DELTA = (long)WS_X18 - (long)WS_XB;
constexpr size_t WS_H = WS_ACT;
constexpr size_t WS_G = WS_ACT, WS_XR = WS_ACT + 160 * MiB, WS_XC = WS_ACT + 320 * MiB, WS_LA = WS_XR;
constexpr size_t WS_HM = WS_ACT;
constexpr size_t WS_X8 = WS_ACT + 256 * MiB;
constexpr size_t WS_Y0 = WS_W_EGU, WS_Y1 = WS_WODD;
static_assert((size_t)M * DRNN * 2 <= (size_t)M * D * 4, "BT fits d_out");
static_assert(WS_Y1 + (size_t)M * D * 2 <= WS_XB && WS_Y0 + (size_t)M * D * 2 <= WS_W_EDN, "Y overlays");
static_assert((size_t)RMAX * DFE * 2 <= 480 * MiB, "HM fits ACT");

constexpr float F8_SX = 16.f, F8_SW = 256.f, F8_SH = 8.f;
#ifndef EVIN_QKV_FP8
#define EVIN_QKV_FP8 1
#endif
constexpr size_t EVIN8_OFF = 4 * MiB;
#ifndef FFN_DOWN_FP8
#define PG8_NOCLEAR 1
#define EVOUT_MIXED 1
#define FFN_GU_FP8 0
#define OD_IN_FP8 0
#define FFN_GU_MIX 0
#define SCAN_SQRT 1
#define FFN_DOWN_FP8 0
#endif
constexpr int LDS_BYTES = 147456;
constexpr int LDSCTL_OFF = 146432;
constexpr int CW_BAR = 4096;
static_assert((CW_BAR + 48 * 3456) * 4 <= (int)CTL_ZERO_BYTES, "barrier words inside the memset region");

#define LDS_WAIT() asm volatile("s_waitcnt lgkmcnt(0)" ::: "memory")
#define VM_WAIT() asm volatile("s_waitcnt vmcnt(0)" ::: "memory")
__device__ __forceinline__ unsigned f2bf(float f) { unsigned u = __builtin_bit_cast(unsigned, f); return (u + 0x7fffu + ((u >> 16) & 1u)) >> 16; }
typedef __bf16 bf16n2 __attribute__((ext_vector_type(2)));
__device__ __forceinline__ unsigned pk2(float lo, float hi) { const bf16n2 v = __builtin_convertvector((f32x2){lo, hi}, bf16n2); return __builtin_bit_cast(unsigned, v); }
__device__ __forceinline__ unsigned pk4_f8(float a, float b, float c, float d) {
    a = __builtin_amdgcn_fmed3f(a, -448.f, 448.f); b = __builtin_amdgcn_fmed3f(b, -448.f, 448.f); c = __builtin_amdgcn_fmed3f(c, -448.f, 448.f); d = __builtin_amdgcn_fmed3f(d, -448.f, 448.f);
    int w = 0; w = __builtin_amdgcn_cvt_pk_fp8_f32(a, b, w, false); w = __builtin_amdgcn_cvt_pk_fp8_f32(c, d, w, true); return (unsigned)w; }
__device__ __forceinline__ float bflo(unsigned w) { return __builtin_bit_cast(float, w << 16); }
__device__ __forceinline__ float bfhi(unsigned w) { return __builtin_bit_cast(float, w & 0xffff0000u); }
__device__ __forceinline__ float bf2f(bf16 b) { return __builtin_bit_cast(float, ((unsigned)b) << 16); }
__device__ __forceinline__ float wave_sum(float v) {
#pragma unroll
    for (int o = 1; o < 64; o <<= 1) v += __shfl_xor(v, o);
    return v;
}
__device__ __forceinline__ float wave_max(float v) {
#pragma unroll
    for (int o = 1; o < 64; o <<= 1) v = fmaxf(v, __shfl_xor(v, o));
    return v;
}
__device__ __forceinline__ float fast_exp(float x) { return __builtin_amdgcn_exp2f(x * 1.44269504089f); }
__device__ __forceinline__ float sigmoid_f(float x) { return __builtin_amdgcn_rcpf(1.0f + fast_exp(-x)); }
__device__ __forceinline__ float silu_f(float x) { return x * sigmoid_f(x); }
__device__ __forceinline__ float gelu_f(float x) { const float u = 0.7978845608f * (x + 0.044715f * x * x * x); return x * sigmoid_f(2.0f * u); }
__device__ __forceinline__ f32x2 gelu2(f32x2 x) {
    const f32x2 q = x * x;
    const f32x2 a = x * (q * (0.044715f * -2.0f * 1.44269504089f * 0.7978845608f) + (-2.0f * 1.44269504089f * 0.7978845608f));
    const f32x2 d = (f32x2){__builtin_amdgcn_exp2f(a.x), __builtin_amdgcn_exp2f(a.y)} + 1.0f;
    return x * (f32x2){__builtin_amdgcn_rcpf(d.x), __builtin_amdgcn_rcpf(d.y)};
}
__device__ __forceinline__ void gelu8(f32x4& v0, f32x4& v1) {
    const f32x2 a = gelu2((f32x2){v0[0], v0[1]}), b = gelu2((f32x2){v0[2], v0[3]}), c = gelu2((f32x2){v1[0], v1[1]}), d = gelu2((f32x2){v1[2], v1[3]});
    v0 = (f32x4){a.x, a.y, b.x, b.y}; v1 = (f32x4){c.x, c.y, d.x, d.y};
}

#define XB_TMO      128
#define XB_XCNT(j)  (256  + 64 * (j))
#define XB_XSUB(j)  (1280 + 64 * (j))
#define XB_XGEN(j)  (2304 + 64 * (j))
#define XB_TOP      3328
#define XB_TOPGEN   3392
#define XCD_BAR_WORDS 3456
#define XB_SPIN_CAP (1u << 18)

__device__ __forceinline__ unsigned xb_ld(unsigned* p)              { return __hip_atomic_load(p, __ATOMIC_RELAXED, __HIP_MEMORY_SCOPE_AGENT); }
__device__ __forceinline__ unsigned xb_add(unsigned* p, unsigned v) { return __hip_atomic_fetch_add(p, v, __ATOMIC_RELAXED, __HIP_MEMORY_SCOPE_AGENT); }
__device__ __forceinline__ unsigned xb_xcc_id() { return (unsigned)__builtin_amdgcn_s_getreg((3 << 11) | 20) & 0xFu; }
#define XB_SPIN(cond, bar) do { unsigned _sp = 0; while (cond) { __builtin_amdgcn_s_sleep(1); \
    if ((++_sp & 255u) == 0u) { if (xb_ld(&(bar)[XB_TMO])) break; if (_sp > XB_SPIN_CAP) { atomicAdd(&(bar)[XB_TMO], 1u); break; } } } } while (0)

struct XcdBarrier {
    unsigned* bar; unsigned x;
    volatile LAS unsigned* st;
};

__device__ __forceinline__ XcdBarrier xcd_barrier_post(unsigned* bar, volatile LAS unsigned* st) {
    XcdBarrier b; b.bar = bar; b.x = xb_xcc_id(); b.st = st;
    if (threadIdx.x == 0) (void)xb_add(&bar[XB_XCNT(b.x)], 1u);
    return b;
}
__device__ __forceinline__ void xcd_barrier_complete(unsigned* bar, unsigned x, unsigned& nloc, unsigned& nx) {
    const unsigned G = gridDim.x * gridDim.y * gridDim.z;
    unsigned sum, cnt, mine, sp = 0u;
    for (;;) {
        sum = 0u; cnt = 0u; mine = 0u;
#pragma unroll
        for (unsigned j = 0; j < 16; ++j) { const unsigned c = xb_ld(&bar[XB_XCNT(j)]); sum += c; cnt += (c > 0u) ? 1u : 0u; mine = (j == x) ? c : mine; }
        if (sum == G) break;
        __builtin_amdgcn_s_sleep(1);
        if ((++sp & 255u) == 0u) { if (xb_ld(&bar[XB_TMO])) break; if (sp > XB_SPIN_CAP) { atomicAdd(&bar[XB_TMO], 1u); break; } }
    }
    nloc = mine > 0u ? mine : 1u; nx = cnt > 0u ? cnt : 1u;
}

__device__ __forceinline__ void xcd_barrier(const XcdBarrier& b) {
    asm volatile("s_waitcnt vmcnt(0)" ::: "memory");
    __syncthreads();
    if (threadIdx.x == 0) {
        unsigned* bar = b.bar;
        __builtin_amdgcn_s_waitcnt(0);
        unsigned nloc = b.st[0], nx = b.st[1];
        if (nloc == 0u) { xcd_barrier_complete(bar, b.x, nloc, nx); b.st[0] = nloc; b.st[1] = nx; }
        const unsigned old = xb_add(&bar[XB_XSUB(b.x)], 1u);
        const unsigned gen = old / nloc;
        if (old + 1u == (gen + 1u) * nloc) {
            __builtin_amdgcn_fence(__ATOMIC_RELEASE, "agent");
            asm volatile("s_waitcnt vmcnt(0)" ::: "memory");
            const unsigned og = xb_add(&bar[XB_TOP], 1u);
            const unsigned tg = og / nx;
            if (og + 1u == (tg + 1u) * nx) xb_add(&bar[XB_TOPGEN], 1u);
            else XB_SPIN(xb_ld(&bar[XB_TOPGEN]) == tg, bar);
            __builtin_amdgcn_fence(__ATOMIC_ACQUIRE, "agent");
            xb_add(&bar[XB_XGEN(b.x)], 1u);
            asm volatile("s_waitcnt vmcnt(0)" ::: "memory");
        } else {
            XB_SPIN(xb_ld(&bar[XB_XGEN(b.x)]) == gen, bar);
            __builtin_amdgcn_fence(__ATOMIC_ACQUIRE, "agent");
            asm volatile("s_waitcnt vmcnt(0)" ::: "memory");
        }
    }
    __syncthreads();
}

struct Frame {
    LAS unsigned char* lds;
    int tid, lane, wave, bid, G;
};
struct Unit { int pm, pn, newpm; };
__device__ __forceinline__ bool frame_refresh(Frame& F, int& gw, int& gt) {
    int t = threadIdx.x; asm volatile("" : "+v"(t));
    F.tid = t; F.lane = t & 63; F.wave = __builtin_amdgcn_readfirstlane(t >> 6);
    gw = F.bid * NWAVES + F.wave; gt = F.bid * NTHR + t; return true;
}

struct MapV { const float* W; const float* gain; bf16* dst; int K, NP, mode, half; float f8scale; float bscale; };
__device__ __forceinline__ int mapv_drow(const MapV& mp, int n) {
    if (mp.mode == 1) return ((n >> 7) << 8) + mp.half * 128 + (n & 127);
    if (mp.mode == 2 && n >= 2 * DA && n < 2 * DA + 2 * DB) { const int base = (n < 2 * DA + DB) ? 2 * DA : 2 * DA + DB; const int cc = n - base, head = cc >> 7, i = cc & 127; return base + head * 128 + ((i < 64) ? 2 * i : 2 * (i - 64) + 1); }
    return n;
}
__device__ __forceinline__ void cvt_item64(const MapV& mp, int item, LAS float* scr, int lane) {
    const int nblk = mp.NP / 64, kb = item / nblk, nb = item - kb * nblk, k0 = 64 * kb, n0 = 64 * nb;
    const int lr = lane >> 4, lc = (lane & 15) * 4;
    const float* src = mp.W + (size_t)(k0 + lr) * mp.NP + n0 + lc;
    f32x4 v[16];
#pragma unroll
    for (int i = 0; i < 16; ++i) v[i] = *(const f32x4*)(src + (size_t)(4 * i) * mp.NP);
    float cs = (mp.bscale > 0.f) ? mp.bscale : 1.0f; if (mp.mode == 2 && n0 >= 2 * DA && n0 < 2 * DA + DB) cs = 0.08838834764831845f * 1.4426950408889634f;
    const bool f8 = mp.f8scale > 0.f || (EVIN_QKV_FP8 && mp.mode == 2 && n0 >= 2 * DA);
    if (f8) cs *= (mp.f8scale > 0.f ? mp.f8scale : F8_SW);
#pragma unroll
    for (int i = 0; i < 16; ++i) { const float g = mp.gain ? mp.gain[k0 + 4 * i + lr] * cs : cs; LAS float* d = scr + (4 * i + lr) * 65 + lc;
        d[0] = v[i].x * g; d[1] = v[i].y * g; d[2] = v[i].z * g; d[3] = v[i].w * g; }
    LDS_WAIT();
    const int c = lane & 7;
    if (f8) {
        unsigned char* d8 = (unsigned char*)mp.dst; if (mp.mode == 2) d8 += EVIN8_OFF - (size_t)(2 * DA) * mp.K;
#pragma unroll
        for (int j = 0; j < 8; ++j) { const int n = (lane >> 3) + 8 * j; const LAS float* q = scr + (8 * c) * 65 + n;
            u32x2 o; o.x = pk4_f8(q[0 * 65], q[1 * 65], q[2 * 65], q[3 * 65]); o.y = pk4_f8(q[4 * 65], q[5 * 65], q[6 * 65], q[7 * 65]);
            *(u32x2*)(d8 + (size_t)mapv_drow(mp, n0 + n) * mp.K + k0 + 8 * c) = o; }
    } else {
#pragma unroll
        for (int j = 0; j < 8; ++j) { const int n = (lane >> 3) + 8 * j; const LAS float* q = scr + (8 * c) * 65 + n;
            u32x4 o; o.x = pk2(q[0 * 65], q[1 * 65]); o.y = pk2(q[2 * 65], q[3 * 65]); o.z = pk2(q[4 * 65], q[5 * 65]); o.w = pk2(q[6 * 65], q[7 * 65]);
            *(u32x4*)(mp.dst + (size_t)mapv_drow(mp, n0 + n) * mp.K + k0 + 8 * c) = o; }
    }
    LDS_WAIT();
}

template <class AR, class Epi>
__device__ __forceinline__ void naive_gemm_unit(const AR& ar, const bf16* Bt, int ldb, int K, const Unit& u, const Epi& E, int wr, int wc, int fr, int fq) {
    f32x4 acc[2][2][4][2];
#pragma unroll
    for (int a = 0; a < 2; ++a)
#pragma unroll
        for (int b = 0; b < 2; ++b)
#pragma unroll
            for (int m = 0; m < 4; ++m)
#pragma unroll
                for (int n = 0; n < 2; ++n) acc[a][b][m][n] = (f32x4){0.f, 0.f, 0.f, 0.f};
    const bf16* ap[2][4];
#pragma unroll
    for (int a = 0; a < 2; ++a)
#pragma unroll
        for (int m = 0; m < 4; ++m) ap[a][m] = ar.row(u, a * 128 + wr * 64 + m * 16 + fr);
#pragma unroll
    for (int b = 0; b < 2; ++b)
#pragma unroll
        for (int n = 0; n < 2; ++n) {
            const bf16* bp = Bt + (size_t)(b * 128 + wc * 32 + 8 * fq + 4 * n) * ldb;
#pragma unroll 1
            for (int k = 0; k < K; k += 4) {
                f32x4 bv[4];
#pragma unroll
                for (int j = 0; j < 4; ++j) { const u32x2 w = *(const u32x2*)(bp + (size_t)j * ldb + k); bv[j] = (f32x4){bflo(w.x), bfhi(w.x), bflo(w.y), bfhi(w.y)}; }
#pragma unroll
                for (int a = 0; a < 2; ++a)
#pragma unroll
                    for (int m = 0; m < 4; ++m) {
                        const u32x2 w = *(const u32x2*)(ap[a][m] + k); const f32x4 av = (f32x4){bflo(w.x), bfhi(w.x), bflo(w.y), bfhi(w.y)};
#pragma unroll
                        for (int j = 0; j < 4; ++j) { const f32x4 p = av * bv[j]; acc[a][b][m][n][j] += (p.x + p.y) + (p.z + p.w); }
                    }
            }
        }
    E(acc, u, wr, wc, fr, fq);
}
struct ARowDense { const bf16* A; int lda; __device__ __forceinline__ const bf16* row(const Unit& u, int r) const { return A + (size_t)(u.pm * 256 + r) * lda; } };
struct ARowGather { const bf16* A; int lda; const int* tok; __device__ __forceinline__ const bf16* row(const Unit& u, int r) const { return A + (size_t)tok[u.pm * 256 + r] * lda; } };

namespace pg8 {
typedef short bf16x8 __attribute__((ext_vector_type(8)));
typedef int i32x4 __attribute__((ext_vector_type(4)));
typedef int i32x8 __attribute__((ext_vector_type(8)));
constexpr int BM = 256, BK = 64, HALF = 128, HTB = HALF * BK * 2, STAGE_BYTES = 8 * HTB, NXCD = 8, WGM = 4;
__host__ __device__ __forceinline__ int lds_byte(int r, int c) { const int st = (r >> 4) * 2 + (c >> 5), rr = r & 15, cc = c & 31, ob = rr * 64 + cc * 2; return st * 1024 + (ob ^ (((ob >> 9) & 1) << 5)); }
__host__ __device__ __forceinline__ void stage_rc(int b, int& R, int& C) { const int st = b / 1024, sb = b % 1024, swz = sb ^ (((sb >> 9) & 1) << 5); R = (st >> 1) * 16 + swz / 64; C = (st & 1) * 32 + (swz % 64) / 2; }
__host__ __device__ __forceinline__ int perm32(int rho) { const int n = rho >> 4, i = rho & 15; return 8 * (i >> 2) + 4 * n + (i & 3); }
struct StaticOrder {
    int nM, nN, nwg, G, c;
    __host__ __device__ void init(int nM_, int nN_, int G_, int c_) { nM = nM_; nN = nN_; nwg = nM * nN; G = G_; c = c_; }
    __host__ __device__ bool next(int i, Unit& u) const {
        const long L = (long)i * G + c; if (L >= nwg) return false;
        int wgid = (int)L; { const int q = nwg / NXCD, r = nwg % NXCD, xcd = wgid % NXCD, off = wgid / NXCD; wgid = (xcd < r ? xcd * (q + 1) : r * (q + 1) + (xcd - r) * q) + off; }
        const int nig = WGM * nN, gid = wgid / nig, fm = gid * WGM, gsz = (nM - fm) < WGM ? (nM - fm) : WGM;
        u.pm = fm + ((wgid % nig) % gsz); u.pn = (wgid % nig) / gsz; return true;
    }
};
template <class Epi, class Sched, bool GATHER, bool ALIGN_EPI, bool FP8 = false, int F8FROM = 0>
__device__ __forceinline__ void gemm_phase(LAS unsigned char* lds, const Sched& S, const Epi& E, const int K, const int lda, const int ldb, unsigned long long* probe = nullptr, const int noepi = 0, const long adelta = 0) {
    unsigned long long pr_t0 = 0, pr_k = 0, pr_e = 0, pr_a = 0, pr_b = 0; unsigned pr_n = 0;
    const int tid = threadIdx.x, wid = __builtin_amdgcn_readfirstlane(tid >> 6), lane = tid & 63, wr = wid >> 2, wc = wid & 3, fr = lane & 15, fq = lane >> 4;
    constexpr bool T0 = FP8 && F8FROM == 0, T1 = FP8;
    static_assert(F8FROM == 0 || (FP8 && F8FROM >= 4 && F8FROM % 2 == 0 && PG8_NOCLEAR), "mixed K range: fp8 tail behind an even number (>= 4) of bf16 K-tiles");
    int nt = K / BK; asm volatile("" : "+s"(nt));
    unsigned voffA[2][2], nvoffA[2][2], voffB[2]; int RA[2]; unsigned CA2[2];
#pragma unroll
    for (int i = 0; i < 2; ++i) { int R, C; stage_rc(tid * 16 + i * 8192, R, C); const int Rb = (R & ~31) + perm32(R & 31);
        voffB[i] = (unsigned)(Rb * ldb + C) * 2u; RA[i] = R; CA2[i] = (unsigned)C * 2u;
        voffA[0][i] = (unsigned)(R * lda + C) * 2u; voffA[1][i] = (unsigned)((R + HALF) * lda + C) * 2u; nvoffA[0][i] = voffA[0][i]; nvoffA[1][i] = voffA[1][i]; }
    const size_t kstep = (size_t)(BK * 2);
    const size_t hstepB = (size_t)HALF * ldb * 2;
    const unsigned ldsw = (unsigned)wid * 1024u;
    const int aoff = lds_byte(wr * 64 + fr, fq * 8), boff = lds_byte(wc * 32 + fr, fq * 8);
#define PG8_SA(b, h) (((b) * 2 + (h)) * HTB)
#define PG8_SB(b, h) ((4 + (b) * 2 + (h)) * HTB)
#define PG8_STAGE(bufoff, gbase, voff) do { _Pragma("unroll") for (int _i = 0; _i < 2; ++_i) \
        __builtin_amdgcn_global_load_lds((const unsigned*)((const char*)(gbase) + (voff)[_i]), (LAS unsigned*)(lds + (bufoff) + ldsw + _i * 8192), 16, 0, 0); } while (0)
#define PG8_LDA(dst, b, h) do { _Pragma("unroll") for (int m = 0; m < 4; ++m) _Pragma("unroll") for (int k = 0; k < 2; ++k) dst[m][k] = *(const LAS bf16x8*)(lds + PG8_SA(b, h) + aoff + m * 2048 + k * 1024); } while (0)
#define PG8_LDB(dst, b, h) do { _Pragma("unroll") for (int n = 0; n < 2; ++n) _Pragma("unroll") for (int k = 0; k < 2; ++k) dst[n][k] = *(const LAS bf16x8*)(lds + PG8_SB(b, h) + boff + n * 2048 + k * 1024); } while (0)
#define PG8_MMA_T(T8, ai, bj, At, Bt) do { __builtin_amdgcn_s_setprio(1); \
        if constexpr (T8) { _Pragma("unroll") for (int m = 0; m < 4; ++m) _Pragma("unroll") for (int n = 0; n < 2; ++n) { \
            const i32x4 b0_ = __builtin_bit_cast(i32x4, Bt[n][0]), b1_ = __builtin_bit_cast(i32x4, Bt[n][1]), a0_ = __builtin_bit_cast(i32x4, At[m][0]), a1_ = __builtin_bit_cast(i32x4, At[m][1]); \
            const i32x8 bb_ = __builtin_shufflevector(b0_, b1_, 0, 1, 2, 3, 4, 5, 6, 7), aa_ = __builtin_shufflevector(a0_, a1_, 0, 1, 2, 3, 4, 5, 6, 7); \
            asm volatile("v_mfma_scale_f32_16x16x128_f8f6f4 %0, %1, %2, %0, %3, %3 op_sel_hi:[0,0,0]" : "+v"(acc[ai][bj][m][n]) : "v"(bb_), "v"(aa_), "v"(f8one)); } } \
        else if constexpr (PG8_NOCLEAR) { _Pragma("unroll") for (int k = 0; k < 2; ++k) _Pragma("unroll") for (int m = 0; m < 4; ++m) _Pragma("unroll") for (int n = 0; n < 2; ++n) \
            asm volatile("v_mfma_f32_16x16x32_bf16 %0, %1, %2, %0" : "+v"(acc[ai][bj][m][n]) : "v"(Bt[n][k]), "v"(At[m][k])); } \
        else { _Pragma("unroll") for (int m = 0; m < 4; ++m) _Pragma("unroll") for (int n = 0; n < 2; ++n) _Pragma("unroll") for (int k = 0; k < 2; ++k) \
            acc[ai][bj][m][n] = __builtin_amdgcn_mfma_f32_16x16x32_bf16(Bt[n][k], At[m][k], acc[ai][bj][m][n], 0, 0, 0); } \
        __builtin_amdgcn_s_setprio(0); } while (0)
#define PG8_MMA0_T(T8, ai, bj, At, Bt) do { __builtin_amdgcn_s_setprio(1); \
        if constexpr (T8) { _Pragma("unroll") for (int m = 0; m < 4; ++m) _Pragma("unroll") for (int n = 0; n < 2; ++n) { \
            const i32x4 b0_ = __builtin_bit_cast(i32x4, Bt[n][0]), b1_ = __builtin_bit_cast(i32x4, Bt[n][1]), a0_ = __builtin_bit_cast(i32x4, At[m][0]), a1_ = __builtin_bit_cast(i32x4, At[m][1]); \
            const i32x8 bb_ = __builtin_shufflevector(b0_, b1_, 0, 1, 2, 3, 4, 5, 6, 7), aa_ = __builtin_shufflevector(a0_, a1_, 0, 1, 2, 3, 4, 5, 6, 7); \
            asm volatile("v_mfma_scale_f32_16x16x128_f8f6f4 %0, %1, %2, 0, %3, %3 op_sel_hi:[0,0,0]" : "=&v"(acc[ai][bj][m][n]) : "v"(bb_), "v"(aa_), "v"(f8one)); } } \
        else { _Pragma("unroll") for (int m = 0; m < 4; ++m) _Pragma("unroll") for (int n = 0; n < 2; ++n) \
                asm volatile("v_mfma_f32_16x16x32_bf16 %0, %1, %2, 0" : "=&v"(acc[ai][bj][m][n]) : "v"(Bt[n][0]), "v"(At[m][0])); \
            _Pragma("unroll") for (int m = 0; m < 4; ++m) _Pragma("unroll") for (int n = 0; n < 2; ++n) \
                asm volatile("v_mfma_f32_16x16x32_bf16 %0, %1, %2, %0" : "+v"(acc[ai][bj][m][n]) : "v"(Bt[n][1]), "v"(At[m][1])); } \
        __builtin_amdgcn_s_setprio(0); } while (0)
#define PG8_MMA_A(ai, bj, At, Bt) PG8_MMA_T(T0, ai, bj, At, Bt)
#define PG8_MMA0_A(ai, bj, At, Bt) PG8_MMA0_T(T0, ai, bj, At, Bt)
#define PG8_MMA_B(ai, bj, At, Bt) PG8_MMA_T(T1, ai, bj, At, Bt)
#define PG8_WAIT_V(n) asm volatile("s_waitcnt vmcnt(" #n ")" ::: "memory")
#define PG8_WAIT_L(n) asm volatile("s_waitcnt lgkmcnt(" #n ")" ::: "memory")
#define PG8_BAR __builtin_amdgcn_s_barrier()
#define PG8_SCHED __builtin_amdgcn_sched_barrier(0)
    Unit cur, nxt; int ui = 0;
    if (!S.next(0, cur)) return;
    cur.newpm = 1;
    if (probe) pr_t0 = __builtin_amdgcn_s_memrealtime();
    if constexpr (GATHER) {
#pragma unroll
        for (int h = 0; h < 2; ++h)
#pragma unroll
            for (int i = 0; i < 2; ++i) voffA[h][i] = (unsigned)S.tok[cur.pm * BM + h * HALF + RA[i]] * (unsigned)(lda * 2) + CA2[i];
    }
    f32x4 acc[2][2][4][2];
#pragma unroll
    for (int a = 0; a < 2; ++a)
#pragma unroll
        for (int b = 0; b < 2; ++b)
#pragma unroll
            for (int m = 0; m < 4; ++m)
#pragma unroll
                for (int n = 0; n < 2; ++n) acc[a][b][m][n] = (f32x4){0.f, 0.f, 0.f, 0.f};
    bf16x8 At[4][2], B0[2][2], B1[2][2]; const int f8one = 0x7f7f7f7f;
    const char* cA = S.a_base(cur); const char* cB = S.b_base(cur);
    PG8_STAGE(PG8_SB(0, 0), cB, voffB); PG8_STAGE(PG8_SB(0, 1), cB + hstepB, voffB); PG8_STAGE(PG8_SA(0, 0), cA, voffA[0]); PG8_STAGE(PG8_SA(0, 1), cA, voffA[1]);
    if (wr == 1) PG8_BAR;
    PG8_WAIT_V(2); PG8_BAR;
    PG8_STAGE(PG8_SB(1, 0), cB + kstep, voffB); PG8_STAGE(PG8_SA(1, 0), cA + kstep, voffA[0]); PG8_STAGE(PG8_SB(1, 1), cB + hstepB + kstep, voffB);
    PG8_WAIT_V(6); PG8_BAR;
    for (;;) {
        const bool has_next = S.next(ui + 1, nxt);
        const char* nA = has_next ? S.a_base(nxt) : cA; const char* nB = has_next ? S.b_base(nxt) : cB;
        if constexpr (GATHER) {
            if (has_next) {
#pragma unroll
                for (int h = 0; h < 2; ++h)
#pragma unroll
                    for (int i = 0; i < 2; ++i) nvoffA[h][i] = (unsigned)S.tok[nxt.pm * BM + h * HALF + RA[i]] * (unsigned)(lda * 2) + CA2[i];
            } else {
#pragma unroll
                for (int h = 0; h < 2; ++h)
#pragma unroll
                    for (int i = 0; i < 2; ++i) nvoffA[h][i] = voffA[h][i];
            }
        }
        if (probe) pr_a = __builtin_amdgcn_s_memrealtime();
#define PG8_ITER(MM0, MM1) { \
            const bool last = (t == nt - 2); \
            const char* a1 = cA + (size_t)(t + 1) * kstep + ((F8FROM > 0 && t >= F8FROM) ? adelta : 0); \
            const char* a2 = last ? nA : cA + (size_t)(t + 2) * kstep + ((F8FROM > 0 && t + 2 >= F8FROM) ? adelta : 0); const char* b2 = last ? nB : cB + (size_t)(t + 2) * kstep; \
            const char* a3 = a2 + kstep; const char* b3 = b2 + kstep; \
            unsigned v2[2][2]; \
            _Pragma("unroll") for (int h = 0; h < 2; ++h) _Pragma("unroll") for (int i = 0; i < 2; ++i) v2[h][i] = (GATHER && last) ? nvoffA[h][i] : voffA[h][i]; \
              \
            PG8_LDB(B0, 0, 0); PG8_LDB(B1, 0, 1); PG8_SCHED; PG8_LDA(At, 0, 0); PG8_STAGE(PG8_SA(1, 1), a1, voffA[1]); \
            PG8_WAIT_V(8); PG8_WAIT_L(0); PG8_BAR; MM0(0, 0, At, B0); MM0(0, 1, At, B1); PG8_BAR; PG8_SCHED; \
              \
            PG8_LDA(At, 0, 1); PG8_STAGE(PG8_SB(0, 0), b2, voffB); PG8_STAGE(PG8_SB(0, 1), b2 + hstepB, voffB); PG8_STAGE(PG8_SA(0, 0), a2, v2[0]); \
            PG8_WAIT_V(8); PG8_WAIT_L(0); PG8_BAR; MM0(1, 0, At, B0); MM0(1, 1, At, B1); PG8_BAR; PG8_SCHED; \
              \
            PG8_LDB(B0, 1, 0); PG8_LDB(B1, 1, 1); PG8_SCHED; PG8_LDA(At, 1, 0); PG8_STAGE(PG8_SA(0, 1), a2, v2[1]); \
            PG8_WAIT_V(8); PG8_WAIT_L(0); PG8_BAR; MM1(0, 0, At, B0); MM1(0, 1, At, B1); PG8_BAR; PG8_SCHED; \
              \
            PG8_LDA(At, 1, 1); PG8_STAGE(PG8_SB(1, 0), b3, voffB); PG8_STAGE(PG8_SB(1, 1), b3 + hstepB, voffB); PG8_STAGE(PG8_SA(1, 0), a3, v2[0]); \
            PG8_WAIT_V(8); PG8_WAIT_L(0); PG8_BAR; MM1(1, 0, At, B0); MM1(1, 1, At, B1); PG8_BAR; PG8_SCHED; }
        int t = 0;
        if constexpr (PG8_NOCLEAR) { PG8_ITER(PG8_MMA0_A, PG8_MMA_A) t = 2; }
        if constexpr (F8FROM > 0) { for (; t < F8FROM; t += 2) PG8_ITER(PG8_MMA_A, PG8_MMA_A) }
        for (; t < nt; t += 2) PG8_ITER(PG8_MMA_B, PG8_MMA_B)
#undef PG8_ITER
        if constexpr (FP8 || PG8_NOCLEAR) asm volatile("s_nop 15\n\ts_nop 7" ::: "memory");
        if (probe) { pr_b = __builtin_amdgcn_s_memrealtime(); pr_k += pr_b - pr_a; }
        if constexpr (ALIGN_EPI) { if (wr == 0) PG8_BAR; }
        if (!noepi) { int fr_o = fr, fq_o = fq; asm volatile("" : "+v"(fr_o), "+v"(fq_o));
            E(acc, cur, wr, wc, fr_o, fq_o); }
        if (probe) { asm volatile("s_waitcnt vmcnt(0)" ::: "memory"); pr_e += __builtin_amdgcn_s_memrealtime() - pr_b; ++pr_n; }
        if (!has_next) break;
        if constexpr (!PG8_NOCLEAR) {
#pragma unroll
        for (int a = 0; a < 2; ++a)
#pragma unroll
            for (int b = 0; b < 2; ++b)
#pragma unroll
                for (int m = 0; m < 4; ++m)
#pragma unroll
                    for (int n = 0; n < 2; ++n) acc[a][b][m][n] = (f32x4){0.f, 0.f, 0.f, 0.f};
        }
        nxt.newpm = (nxt.pm != cur.pm); cur = nxt; cA = nA; cB = nB; ++ui;
        if constexpr (GATHER) {
#pragma unroll
            for (int h = 0; h < 2; ++h)
#pragma unroll
                for (int i = 0; i < 2; ++i) voffA[h][i] = nvoffA[h][i];
        }
        if constexpr (ALIGN_EPI) { if (wr == 1) PG8_BAR; }
    }
    PG8_WAIT_V(0);
    if constexpr (!ALIGN_EPI) { if (wr == 0) PG8_BAR; }
    PG8_BAR;
    if (probe && blockIdx.x == 0 && tid == 0) { probe[0] = pr_k; probe[1] = pr_e; probe[2] = __builtin_amdgcn_s_memrealtime() - pr_t0; probe[3] = pr_n; }
#undef PG8_SA
#undef PG8_SB
#undef PG8_STAGE
#undef PG8_LDA
#undef PG8_LDB
#undef PG8_MMA_T
#undef PG8_MMA0_T
#undef PG8_MMA_A
#undef PG8_MMA0_A
#undef PG8_MMA_B
#undef PG8_WAIT_V
#undef PG8_WAIT_L
#undef PG8_BAR
#undef PG8_SCHED
}
struct SchedDense {
    StaticOrder so; const char* A; const char* B; size_t tstepA, tstepB; int acol_shift; size_t acol_bytes; const int* tok;
    __device__ __forceinline__ bool next(int i, Unit& u) const { return so.next(i, u); }
    __device__ __forceinline__ const char* a_base(const Unit& u) const { return A + (size_t)u.pm * tstepA + (acol_shift >= 0 ? (size_t)(u.pn >> acol_shift) * acol_bytes : 0); }
    __device__ __forceinline__ const char* b_base(const Unit& u) const { return B + (size_t)u.pn * tstepB; }
};
struct SchedMoe {
    StaticOrder so; const char* A; const char* B; size_t tstepA, tstepB, estrideB; int eo[9]; const int* tok; bool gather;
    __device__ __forceinline__ bool next(int i, Unit& u) const { return so.next(i, u); }
    __device__ __forceinline__ int expert(int pm) const { int e = 0;
#pragma unroll
        for (int x = 1; x < 8; ++x) e += (pm * 256 >= eo[x]); return e; }
    __device__ __forceinline__ const char* a_base(const Unit& u) const { return gather ? A : A + (size_t)u.pm * tstepA; }
    __device__ __forceinline__ const char* b_base(const Unit& u) const { return B + (size_t)expert(u.pm) * estrideB + (size_t)u.pn * tstepB; }
};
}

__device__ __forceinline__ float rsq_mean(float ssum) { return __builtin_amdgcn_rsqf(ssum * (1.0f / D) + RMS_EPS); }
__device__ __forceinline__ void rs_tile_to_lds(const float* ssq, int pm, LAS float* rsl) {
    const int tid = threadIdx.x;
    if (tid < 256) {
        const f32x4* p = (const f32x4*)(ssq + (size_t)(pm * 256 + tid) * 32); f32x4 v[8];
#pragma unroll
        for (int i = 0; i < 8; ++i) v[i] = p[i];
        float sm = 0.f;
#pragma unroll
        for (int i = 0; i < 8; ++i) sm += (v[i].x + v[i].y) + (v[i].z + v[i].w);
        rsl[tid] = rsq_mean(sm);
    }
    asm volatile("s_waitcnt lgkmcnt(0)" ::: "memory"); __builtin_amdgcn_s_barrier(); asm volatile("" ::: "memory");
}
__device__ __forceinline__ void store8(bf16* p, const f32x4 v0, const f32x4 v1) {
    u32x4 w; w.x = pk2(v0[0], v0[1]); w.y = pk2(v0[2], v0[3]); w.z = pk2(v1[0], v1[1]); w.w = pk2(v1[2], v1[3]); *(u32x4*)p = w;
}
struct EpiEvIn {
    const float* ssq0; bf16 *U, *VA, *Q, *Kb, *V; int pn_off; float cs;
    __device__ __forceinline__ void operator()(const f32x4 (&acc)[2][2][4][2], const Unit& u, int wr, int wc, int fr, int fq) const {
        const int row0 = u.pm * 256 + wr * 64 + fr, cw = wc * 32 + 8 * fq;
        const int pn = u.pn + pn_off;
        float rs8[2][4];
#pragma unroll
        for (int ai = 0; ai < 2; ++ai)
#pragma unroll
            for (int m = 0; m < 4; ++m) rs8[ai][m] = ssq0[row0 + ai * 128 + m * 16];
        float invf[2][2];
#pragma unroll
        for (int n = 0; n < 2; ++n)
#pragma unroll
            for (int jj = 0; jj < 2; ++jj) { const int i = 16 * wc + 4 * fq + 2 * n + jj; invf[n][jj] = __builtin_amdgcn_exp2f(-13.287712379549449f * (float)i * (1.0f / 64.0f)) * 0.15915494309189535f; }
#pragma unroll
        for (int ai = 0; ai < 2; ++ai)
#pragma unroll
            for (int m = 0; m < 4; ++m) {
                const int r = row0 + ai * 128 + m * 16;
                const float rs = rsq_mean(rs8[ai][m]) * cs;
                const float pos = (float)(r & (S - 1));
#pragma unroll
                for (int bj = 0; bj < 2; ++bj) {
                    f32x4 v0 = acc[ai][bj][m][0] * rs, v1 = acc[ai][bj][m][1] * rs;
                    if (pn < 4) {
                        gelu8(v0, v1);
                        bf16* dst = (pn < 2 ? U : VA) + (size_t)r * DA + (pn & 1) * 256 + bj * 128 + cw;
                        store8(dst, v0, v1);
                    } else if (pn < 16) {
#pragma unroll
                        for (int n = 0; n < 2; ++n) {
                            f32x4& v = n ? v1 : v0;
                            const f32x2 c2 = (f32x2){invf[n][0], invf[n][1]}, p2 = (f32x2){pos, pos};
                            const f32x2 hi = p2 * c2; const f32x2 lo = (f32x2){__builtin_fmaf(pos, c2.x, -hi.x), __builtin_fmaf(pos, c2.y, -hi.y)};
                            const f32x2 fr2 = (hi - (f32x2){floorf(hi.x), floorf(hi.y)}) + lo;
#pragma unroll
                            for (int jj = 0; jj < 2; ++jj) {
                                const float fr_ = jj ? fr2.y : fr2.x;
                                const float sn = __builtin_amdgcn_sinf(fr_), cs = __builtin_amdgcn_cosf(fr_);
                                const f32x2 x = (f32x2){v[2 * jj], v[2 * jj + 1]}, xs = (f32x2){-v[2 * jj + 1], v[2 * jj]};
                                const f32x2 y = x * cs + xs * sn;
                                v[2 * jj] = y.x; v[2 * jj + 1] = y.y;
                            }
                        }
                        const int t = (pn < 10) ? pn - 4 : pn - 10;
                        bf16* dst = (pn < 10 ? Q : Kb) + (size_t)r * DB + t * 256 + bj * 128 + cw;
                        store8(dst, v0, v1);
                    } else {
                        bf16* dst = V + (size_t)r * DB + (pn - 16) * 256 + bj * 128 + cw;
                        store8(dst, v0, v1);
                    }
                }
            }
    }
};
template <bool F32IN, int X8OUT = 0> struct EpiResid {
    const float* xi; bf16* XB; float* ssq; float cs;
    __device__ __forceinline__ void operator()(const f32x4 (&acc)[2][2][4][2], const Unit& u, int wr, int wc, int fr, int fq) const {
        const int row0 = u.pm * 256 + wr * 64 + fr, col0 = u.pn * 256 + wc * 32 + 8 * fq;
        if constexpr (!F32IN) {
            u32x4 xin[4][2][2];
#define ER_LOAD(G) do { _Pragma("unroll") for (int mm = 0; mm < 2; ++mm) _Pragma("unroll") for (int bj = 0; bj < 2; ++bj) \
                xin[G][mm][bj] = *(const u32x4*)(XB + (size_t)(row0 + ((G) >> 1) * 128 + (2 * ((G) & 1) + mm) * 16) * D + col0 + bj * 128); } while (0)
#define ER_USE(G) do { _Pragma("unroll") for (int mm = 0; mm < 2; ++mm) { const int ai = (G) >> 1, m = 2 * ((G) & 1) + mm; const int r = row0 + ai * 128 + m * 16; float sq; f32x2 sq2 = (f32x2){0.f, 0.f}; \
                _Pragma("unroll") for (int bj = 0; bj < 2; ++bj) { const size_t off = (size_t)r * D + col0 + bj * 128; const u32x4 w = xin[G][mm][bj]; \
                    const f32x4 x0 = (f32x4){bflo(w.x), bfhi(w.x), bflo(w.y), bfhi(w.y)}, x1 = (f32x4){bflo(w.z), bfhi(w.z), bflo(w.w), bfhi(w.w)}; \
                    const f32x4 v0 = x0 + acc[ai][bj][m][0] * cs, v1 = x1 + acc[ai][bj][m][1] * cs; \
                    store8(XB + off, v0, v1); \
                    if constexpr (X8OUT == 1) { u32x2 o8_; o8_.x = pk4_f8(v0.x * F8_SX, v0.y * F8_SX, v0.z * F8_SX, v0.w * F8_SX); o8_.y = pk4_f8(v1.x * F8_SX, v1.y * F8_SX, v1.z * F8_SX, v1.w * F8_SX); *(u32x2*)((unsigned char*)XB + X18_DELTA + off) = o8_; } \
                    sq2 = (f32x2){v0.x, v0.y} * (f32x2){v0.x, v0.y} + sq2; sq2 = (f32x2){v0.z, v0.w} * (f32x2){v0.z, v0.w} + sq2; \
                    sq2 = (f32x2){v1.x, v1.y} * (f32x2){v1.x, v1.y} + sq2; sq2 = (f32x2){v1.z, v1.w} * (f32x2){v1.z, v1.w} + sq2; } \
                sq = sq2.x + sq2.y; sq += __shfl_xor(sq, 16); sq += __shfl_xor(sq, 32); \
                if (fq == 0) ssq[(size_t)r * 32 + u.pn * 4 + wc] = sq; } } while (0)
            ER_LOAD(0); ER_LOAD(1); ER_LOAD(2); asm volatile("" ::: "memory");
            ER_USE(0); asm volatile("" ::: "memory"); ER_LOAD(3); asm volatile("" ::: "memory");
            ER_USE(1); ER_USE(2); ER_USE(3);
#undef ER_LOAD
#undef ER_USE
        } else {
#pragma unroll
        for (int ai = 0; ai < 2; ++ai) {
            f32x4 xin[4][2][2];
#pragma unroll
            for (int m = 0; m < 4; ++m)
#pragma unroll
                for (int bj = 0; bj < 2; ++bj) {
                    const size_t off = (size_t)(row0 + ai * 128 + m * 16) * D + col0 + bj * 128;
                    xin[m][bj][0] = *(const f32x4*)(xi + off); xin[m][bj][1] = *(const f32x4*)(xi + off + 4);
                }
            asm volatile("" ::: "memory");
#pragma unroll
            for (int m = 0; m < 4; ++m) {
                const int r = row0 + ai * 128 + m * 16; float sq = 0.f;
#pragma unroll
                for (int bj = 0; bj < 2; ++bj) {
                    const size_t off = (size_t)r * D + col0 + bj * 128;
                    const f32x4 v0 = xin[m][bj][0] + acc[ai][bj][m][0] * cs, v1 = xin[m][bj][1] + acc[ai][bj][m][1] * cs;
                    store8(XB + off, v0, v1);
                    if constexpr (X8OUT == 1) { u32x2 o; o.x = pk4_f8(v0.x * F8_SX, v0.y * F8_SX, v0.z * F8_SX, v0.w * F8_SX); o.y = pk4_f8(v1.x * F8_SX, v1.y * F8_SX, v1.z * F8_SX, v1.w * F8_SX); *(u32x2*)((unsigned char*)XB + X18_DELTA + off) = o; }
                    if constexpr (X8OUT == 2) { if (u.pn * 256 >= FGU_KB) { u32x2 o; o.x = pk4_f8(v0.x, v0.y, v0.z, v0.w); o.y = pk4_f8(v1.x, v1.y, v1.z, v1.w);
                        *(u32x2*)((unsigned char*)XB + X18_DELTA + (size_t)r * (2 * D) + 2 * FGU_KB + (col0 + bj * 128 - FGU_KB)) = o; } }
                    sq += (v0.x * v0.x + v0.y * v0.y) + (v0.z * v0.z + v0.w * v0.w) + (v1.x * v1.x + v1.y * v1.y) + (v1.z * v1.z + v1.w * v1.w);
                }
                sq += __shfl_xor(sq, 16); sq += __shfl_xor(sq, 32);
                if (fq == 0) ssq[(size_t)r * 32 + u.pn * 4 + wc] = sq;
            }
            asm volatile("" ::: "memory");
        }
        }
    }
};
template <bool MOE, bool F8OUT = MOE> struct EpiGateUp {
    const float* ssq; bf16* H; int ldh; const float* rsr; const float* gw; LAS float* rsl; float ascale;
    __device__ __forceinline__ void operator()(const f32x4 (&acc)[2][2][4][2], const Unit& u, int wr, int wc, int fr, int fq) const {
        const int rl0 = wr * 64 + fr, row0 = u.pm * 256 + rl0, col0 = u.pn * 128 + wc * 32 + 8 * fq;
        float rs8[2][4], w8[2][4];
        if (MOE) {
#pragma unroll
            for (int ai = 0; ai < 2; ++ai)
#pragma unroll
                for (int m = 0; m < 4; ++m) { rs8[ai][m] = rsr[row0 + ai * 128 + m * 16] * (1.0f / (F8_SX * F8_SW)); w8[ai][m] = gw[row0 + ai * 128 + m * 16] * F8_SH; }
        } else {
            if (u.newpm) rs_tile_to_lds(ssq, u.pm, rsl);
#pragma unroll
            for (int ai = 0; ai < 2; ++ai)
#pragma unroll
                for (int m = 0; m < 4; ++m) { rs8[ai][m] = rsl[rl0 + ai * 128 + m * 16] * ascale; w8[ai][m] = F8OUT ? F8_SH : 1.0f; }
        }
#pragma unroll
        for (int ai = 0; ai < 2; ++ai)
#pragma unroll
            for (int m = 0; m < 4; ++m) {
                const int r = row0 + ai * 128 + m * 16; const float rs = rs8[ai][m];
                const float nrs = rs * -1.44269504089f, kk = rs * rs * w8[ai][m];
                f32x4 h0, h1;
#pragma unroll
                for (int n = 0; n < 2; ++n)
#pragma unroll
                    for (int jp = 0; jp < 2; ++jp) {
                        const f32x2 g2 = (f32x2){acc[ai][0][m][n][2 * jp], acc[ai][0][m][n][2 * jp + 1]}, u2 = (f32x2){acc[ai][1][m][n][2 * jp], acc[ai][1][m][n][2 * jp + 1]};
                        const f32x2 t2 = g2 * nrs;
                        const f32x2 d2 = (f32x2){__builtin_amdgcn_exp2f(t2.x), __builtin_amdgcn_exp2f(t2.y)} + 1.0f;
                        const f32x2 r2 = (f32x2){__builtin_amdgcn_rcpf(d2.x), __builtin_amdgcn_rcpf(d2.y)};
                        const f32x2 h2 = ((g2 * u2) * kk) * r2;
                        if (n == 0) { h0[2 * jp] = h2.x; h0[2 * jp + 1] = h2.y; } else { h1[2 * jp] = h2.x; h1[2 * jp + 1] = h2.y; }
                    }
                if (F8OUT) { u32x2 o; o.x = pk4_f8(h0[0], h0[1], h0[2], h0[3]); o.y = pk4_f8(h1[0], h1[1], h1[2], h1[3]); *(u32x2*)((unsigned char*)H + (size_t)r * ldh + col0) = o; }
                else store8(H + (size_t)r * ldh + col0, h0, h1);
            }
    }
};
struct EpiOdIn {
    const float* ssq; bf16 *Gb, *XR; LAS float* rsl; float ascale;
    __device__ __forceinline__ void operator()(const f32x4 (&acc)[2][2][4][2], const Unit& u, int wr, int wc, int fr, int fq) const {
        const int rl0 = wr * 64 + fr, row0 = u.pm * 256 + rl0, cw = wc * 32 + 8 * fq;
        const bool isg = u.pn < 10; const int cb = (isg ? u.pn : u.pn - 10) * 256;
        if (u.newpm) rs_tile_to_lds(ssq, u.pm, rsl);
        float rs8[2][4];
#pragma unroll
        for (int ai = 0; ai < 2; ++ai)
#pragma unroll
            for (int m = 0; m < 4; ++m) rs8[ai][m] = rsl[rl0 + ai * 128 + m * 16] * ascale;
#pragma unroll
        for (int ai = 0; ai < 2; ++ai)
#pragma unroll
            for (int m = 0; m < 4; ++m) {
                const int r = row0 + ai * 128 + m * 16;
                const float rs = rs8[ai][m];
#pragma unroll
                for (int bj = 0; bj < 2; ++bj) {
                    f32x4 v0 = acc[ai][bj][m][0] * rs, v1 = acc[ai][bj][m][1] * rs;
                    if (isg) gelu8(v0, v1);
                    store8((isg ? Gb : XR) + (size_t)r * DRNN + cb + bj * 128 + cw, v0, v1);
                }
            }
    }
};
struct EpiGates {
    const bf16* XC; const float *b_a, *b_x, *sp8; bf16 *LA, *BT;
    __device__ __forceinline__ void operator()(const f32x4 (&acc)[2][2][4][2], const Unit& u, int wr, int wc, int fr, int fq) const {
        const int row0 = u.pm * 256 + wr * 64 + fr, ch0 = u.pn * 128 + wc * 32 + 8 * fq;
        f32x4 ba[2], bx[2], sp[2];
#pragma unroll
        for (int n = 0; n < 2; ++n) { ba[n] = *(const f32x4*)(b_a + ch0 + 4 * n); bx[n] = *(const f32x4*)(b_x + ch0 + 4 * n); sp[n] = *(const f32x4*)(sp8 + ch0 + 4 * n); }
        f32x4 nba[2], nbx[2], sp2[2];
#pragma unroll
        for (int n = 0; n < 2; ++n) { nba[n] = ba[n] * -1.44269504089f; nbx[n] = bx[n] * -1.44269504089f; sp2[n] = sp[n] * 2.0f; }
#pragma unroll
        for (int ai = 0; ai < 2; ++ai) {
            u32x4 xw[4];
#pragma unroll
            for (int m = 0; m < 4; ++m) xw[m] = *(const u32x4*)(XC + (size_t)(row0 + ai * 128 + m * 16) * DRNN + ch0);
            asm volatile("" ::: "memory");
#pragma unroll
            for (int m = 0; m < 4; ++m) {
                const size_t o = (size_t)(row0 + ai * 128 + m * 16) * DRNN + ch0;
                const float xc[8] = {bflo(xw[m].x), bfhi(xw[m].x), bflo(xw[m].y), bfhi(xw[m].y), bflo(xw[m].z), bfhi(xw[m].z), bflo(xw[m].w), bfhi(xw[m].w)};
                f32x4 la[2], bt[2];
#pragma unroll
                for (int n = 0; n < 2; ++n)
#pragma unroll
                    for (int jp = 0; jp < 2; ++jp) {
                        const f32x2 pa = (f32x2){acc[ai][0][m][n][2 * jp], acc[ai][0][m][n][2 * jp + 1]}, px = (f32x2){acc[ai][1][m][n][2 * jp], acc[ai][1][m][n][2 * jp + 1]};
                        const f32x2 ta = pa * -1.44269504089f + (f32x2){nba[n][2 * jp], nba[n][2 * jp + 1]}, tx = px * -1.44269504089f + (f32x2){nbx[n][2 * jp], nbx[n][2 * jp + 1]};
                        const f32x2 ea = (f32x2){__builtin_amdgcn_exp2f(ta.x), __builtin_amdgcn_exp2f(ta.y)} + 1.0f, ex = (f32x2){__builtin_amdgcn_exp2f(tx.x), __builtin_amdgcn_exp2f(tx.y)} + 1.0f;
                        const f32x2 rg = (f32x2){__builtin_amdgcn_rcpf(ea.x), __builtin_amdgcn_rcpf(ea.y)}, ig = (f32x2){__builtin_amdgcn_rcpf(ex.x), __builtin_amdgcn_rcpf(ex.y)};
                        const f32x2 y = rg * (f32x2){sp2[n][2 * jp], sp2[n][2 * jp + 1]};
                        f32x2 b2; const f32x2 l2 = y * (0.5f * 1.4426950408889634f);
                        if constexpr (SCAN_SQRT) b2 = ig * (f32x2){xc[4 * n + 2 * jp], xc[4 * n + 2 * jp + 1]};
                        else {
                        f32x2 t = y * (1.0f / 720.0f) + (1.0f / 120.0f); t = t * y + (1.0f / 24.0f); t = t * y + (1.0f / 6.0f); t = t * y + 0.5f; t = t * y + 1.0f;
                        f32x2 om = t * -y;
                        if (__any(fminf(y.x, y.y) < -1.0f)) { asm volatile("" ::: "memory"); om.x = (y.x < -1.0f) ? 1.0f - fast_exp(y.x) : om.x; om.y = (y.y < -1.0f) ? 1.0f - fast_exp(y.y) : om.y; }
                        const f32x2 sq = (f32x2){__builtin_amdgcn_sqrtf(fmaxf(om.x, 0.f)), __builtin_amdgcn_sqrtf(fmaxf(om.y, 0.f))};
                        b2 = (sq * ig) * (f32x2){xc[4 * n + 2 * jp], xc[4 * n + 2 * jp + 1]};
                        }
                        bt[n][2 * jp] = b2.x; bt[n][2 * jp + 1] = b2.y; la[n][2 * jp] = l2.x; la[n][2 * jp + 1] = l2.y;
                    }
                store8(LA + o, la[0], la[1]); store8(BT + o, bt[0], bt[1]);
            }
            asm volatile("" ::: "memory");
        }
    }
};
struct EpiMoeDown {
    const int* dest; bf16 *Y0, *Y1;
    __device__ __forceinline__ void operator()(const f32x4 (&acc)[2][2][4][2], const Unit& u, int wr, int wc, int fr, int fq) const {
        const int row0 = u.pm * 256 + wr * 64 + fr, col0 = u.pn * 256 + wc * 32 + 8 * fq;
        int d8[2][4];
#pragma unroll
        for (int ai = 0; ai < 2; ++ai)
#pragma unroll
            for (int m = 0; m < 4; ++m) d8[ai][m] = dest[row0 + ai * 128 + m * 16];
#pragma unroll
        for (int ai = 0; ai < 2; ++ai)
#pragma unroll
            for (int m = 0; m < 4; ++m) {
                const int d = d8[ai][m];
                if (d >= 0) {
                    bf16* yp = (d >= M) ? Y1 + (size_t)(d - M) * D : Y0 + (size_t)d * D;
#pragma unroll
                    for (int bj = 0; bj < 2; ++bj) store8(yp + col0 + bj * 128, acc[ai][bj][m][0] * (1.0f / (F8_SH * F8_SW)), acc[ai][bj][m][1] * (1.0f / (F8_SH * F8_SW)));
                }
            }
    }
};

typedef short s16x4 __attribute__((ext_vector_type(4)));
template <int OFF> __device__ __forceinline__ s16x4 tr_read(unsigned vb) { s16x4 r; asm volatile("ds_read_b64_tr_b16 %0, %1 offset:%2" : "=&v"(r) : "v"(vb), "i"(OFF) : "memory"); return r; }
template <int P>
__device__ __forceinline__ void attn_pass(const Frame& F, unsigned lds_base, const bf16* Qb, const bf16* Kb, const bf16* Vb, bf16* CAT, float* LSE, unsigned char* CAT2 = nullptr) {
    typedef pg8::bf16x8 bf16x8;
    constexpr int d = (P == 0) ? 1 : (P == 1 ? 4 : 16);
    constexpr int NBLK = 128 / d;
    constexpr int KP = 272, VP = 288, VOFF = 256 * KP;
    LAS unsigned char* Kl = F.lds; LAS unsigned char* Vl = F.lds + VOFF;
    const int w = F.wave, lane = F.lane, fr = lane & 15, fq = lane >> 4;
    const unsigned vb = lds_base + VOFF + (unsigned)((16 * w + 4 * fq + ((lane & 15) >> 2)) * VP + (lane & 3) * 8);
    constexpr int NU = 2 * 12 * 128;
    u32x4 kreg[8], vreg[8];
#define ATT_FETCH(UU) do { const int bh_ = (UU) >> 7, rem_ = (UU) & 127; const int b_ = bh_ / 12, h_ = bh_ - b_ * 12; const int r_ = rem_ / NBLK, l0_ = (rem_ - r_ * NBLK) * 128; \
        const size_t rb_ = (size_t)b_ * S + r_; \
        _Pragma("unroll") for (int j = 0; j < 8; ++j) { const int pc = F.tid + NTHR * j, wi = pc >> 4, piece = pc & 15, lw = l0_ - 128 + wi; \
            kreg[j] = (u32x4){0u, 0u, 0u, 0u}; vreg[j] = (u32x4){0u, 0u, 0u, 0u}; \
            if (lw >= 0) { const size_t o = (rb_ + (size_t)lw * d) * DB + h_ * 128 + piece * 8; kreg[j] = *(const u32x4*)(Kb + o); vreg[j] = *(const u32x4*)(Vb + o); } } } while (0)
    if (F.bid < NU) ATT_FETCH(F.bid);
    for (int u = F.bid; u < NU; u += F.G) {
        const int bh = u >> 7, rem = u & 127; const int b = bh / 12, h = bh - b * 12; const int r = rem / NBLK, blk = rem - r * NBLK; const int l0 = blk * 128;
        const size_t rowbase = (size_t)b * S + r;
        const int lq = l0 + 16 * w + fr;
        const size_t qrow = rowbase + (size_t)lq * d;
        bf16x8 qf[4];
        { const bf16* qp = Qb + qrow * DB + h * 128 + 8 * fq;
#pragma unroll
          for (int kk = 0; kk < 4; ++kk) qf[kk] = *(const bf16x8*)(qp + 32 * kk); }
        bf16* op = CAT + qrow * D + DA + h * 128 + 4 * fq; float* lp = LSE + qrow * 12 + h;
        u32x2 pvo[8]; float lse1 = 0.f;
        if (P != 0) {
#pragma unroll
            for (int dt = 0; dt < 8; ++dt) pvo[dt] = *(const u32x2*)(op + 16 * dt);
            lse1 = *lp;
        }
        __syncthreads();
#pragma unroll
        for (int j = 0; j < 8; ++j) { const int pc = F.tid + NTHR * j, wi = pc >> 4, piece = pc & 15;
            *(LAS u32x4*)(Kl + wi * KP + piece * 16) = kreg[j]; *(LAS u32x4*)(Vl + wi * VP + piece * 16) = vreg[j]; }
        if (u + F.G < NU) ATT_FETCH(u + F.G);
        __syncthreads();
        f32x4 sacc[9];
        const LAS unsigned char* kb = Kl + (16 * w + fr) * KP + fq * 16;
#pragma unroll
        for (int t = 0; t < 9; ++t) { sacc[t] = (f32x4){0.f, 0.f, 0.f, 0.f};
#pragma unroll
            for (int kk = 0; kk < 4; ++kk) { const bf16x8 kf = *(const LAS bf16x8*)(kb + t * 16 * KP + kk * 64); sacc[t] = __builtin_amdgcn_mfma_f32_16x16x32_bf16(kf, qf[kk], sacc[t], 0, 0, 0); } }
#pragma unroll
        for (int i = 0; i < 4; ++i) { if (fr > 4 * fq + i) sacc[0][i] = -INFINITY; if (fr < 4 * fq + i) sacc[8][i] = -INFINITY; }
        if (l0 == 0) {
#pragma unroll
            for (int t = 0; t < 8; ++t)
#pragma unroll
                for (int i = 0; i < 4; ++i) if (16 * w + 16 * t + 4 * fq + i < 128) sacc[t][i] = -INFINITY;
        }
        float mx = -INFINITY;
#pragma unroll
        for (int t = 0; t < 9; ++t)
#pragma unroll
            for (int i = 0; i < 4; ++i) mx = fmaxf(mx, sacc[t][i]);
        mx = fmaxf(mx, __shfl_xor(mx, 16)); mx = fmaxf(mx, __shfl_xor(mx, 32));
        float l = 0.f;
#pragma unroll
        for (int t = 0; t < 9; ++t)
#pragma unroll
            for (int i = 0; i < 4; ++i) { const float pv = __builtin_amdgcn_exp2f(sacc[t][i] - mx); sacc[t][i] = pv; l += pv; }
        l += __shfl_xor(l, 16); l += __shfl_xor(l, 32);
        f32x4 oacc[8];
#pragma unroll
        for (int dt = 0; dt < 8; ++dt) oacc[dt] = (f32x4){0.f, 0.f, 0.f, 0.f};
#define ATT_PV(T0, T1, HAS1) do { \
            bf16x8 pk; { const unsigned a0 = pk2(sacc[T0][0], sacc[T0][1]), a1 = pk2(sacc[T0][2], sacc[T0][3]); \
                unsigned b0 = 0u, b1 = 0u; if (HAS1) { b0 = pk2(sacc[(HAS1) ? (T1) : 0][0], sacc[(HAS1) ? (T1) : 0][1]); b1 = pk2(sacc[(HAS1) ? (T1) : 0][2], sacc[(HAS1) ? (T1) : 0][3]); } \
                const u32x4 pw = (u32x4){a0, a1, b0, b1}; pk = __builtin_bit_cast(bf16x8, pw); } \
            s16x4 va[8], vc[8]; \
            va[0] = tr_read<(T0) * 16 * VP + 0 * 32>(vb); vc[0] = tr_read<((HAS1) ? (T1) : (T0)) * 16 * VP + 0 * 32>(vb); \
            va[1] = tr_read<(T0) * 16 * VP + 1 * 32>(vb); vc[1] = tr_read<((HAS1) ? (T1) : (T0)) * 16 * VP + 1 * 32>(vb); \
            va[2] = tr_read<(T0) * 16 * VP + 2 * 32>(vb); vc[2] = tr_read<((HAS1) ? (T1) : (T0)) * 16 * VP + 2 * 32>(vb); \
            va[3] = tr_read<(T0) * 16 * VP + 3 * 32>(vb); vc[3] = tr_read<((HAS1) ? (T1) : (T0)) * 16 * VP + 3 * 32>(vb); \
            va[4] = tr_read<(T0) * 16 * VP + 4 * 32>(vb); vc[4] = tr_read<((HAS1) ? (T1) : (T0)) * 16 * VP + 4 * 32>(vb); \
            va[5] = tr_read<(T0) * 16 * VP + 5 * 32>(vb); vc[5] = tr_read<((HAS1) ? (T1) : (T0)) * 16 * VP + 5 * 32>(vb); \
            va[6] = tr_read<(T0) * 16 * VP + 6 * 32>(vb); vc[6] = tr_read<((HAS1) ? (T1) : (T0)) * 16 * VP + 6 * 32>(vb); \
            va[7] = tr_read<(T0) * 16 * VP + 7 * 32>(vb); vc[7] = tr_read<((HAS1) ? (T1) : (T0)) * 16 * VP + 7 * 32>(vb); \
            asm volatile("s_waitcnt lgkmcnt(0)" ::: "memory"); __builtin_amdgcn_sched_barrier(0); \
            _Pragma("unroll") for (int dt = 0; dt < 8; ++dt) { const bf16x8 vf = (bf16x8){va[dt][0], va[dt][1], va[dt][2], va[dt][3], vc[dt][0], vc[dt][1], vc[dt][2], vc[dt][3]}; \
                oacc[dt] = __builtin_amdgcn_mfma_f32_16x16x32_bf16(vf, pk, oacc[dt], 0, 0, 0); } \
            __builtin_amdgcn_sched_barrier(0); } while (0)
        ATT_PV(0, 1, 1); ATT_PV(2, 3, 1); ATT_PV(4, 5, 1); ATT_PV(6, 7, 1); ATT_PV(8, 8, 0);
#undef ATT_PV
        const float inv = 1.0f / l; const float lse2 = mx + __builtin_amdgcn_logf(l);
        if (P == 0) {
#pragma unroll
            for (int dt = 0; dt < 8; ++dt) { u32x2 o; o.x = pk2(oacc[dt][0] * inv, oacc[dt][1] * inv); o.y = pk2(oacc[dt][2] * inv, oacc[dt][3] * inv); *(u32x2*)(op + 16 * dt) = o; }
            if (fq == 0) *lp = lse2;
        } else {
            const float mn = fmaxf(lse1, lse2); const float w1 = __builtin_amdgcn_exp2f(lse1 - mn), w2 = __builtin_amdgcn_exp2f(lse2 - mn);
            const float wsum = w1 + w2; const float a1 = w1 / wsum, a2 = (w2 / wsum) * inv;
            if (P == 2 && EVOUT_MIXED) {
                unsigned char* o8 = CAT2 + qrow * C2P + 2 * DA + h * 128 + 4 * fq; const float b1 = a1 * F8_SX, b2 = a2 * F8_SX;
#pragma unroll
                for (int dt = 0; dt < 8; ++dt) { const u32x2 pv = pvo[dt];
                    *(unsigned*)(o8 + 16 * dt) = pk4_f8(b1 * bflo(pv.x) + b2 * oacc[dt][0], b1 * bfhi(pv.x) + b2 * oacc[dt][1], b1 * bflo(pv.y) + b2 * oacc[dt][2], b1 * bfhi(pv.y) + b2 * oacc[dt][3]); }
            } else {
#pragma unroll
            for (int dt = 0; dt < 8; ++dt) { const u32x2 pv = pvo[dt];
                u32x2 o; o.x = pk2(a1 * bflo(pv.x) + a2 * oacc[dt][0], a1 * bfhi(pv.x) + a2 * oacc[dt][1]); o.y = pk2(a1 * bflo(pv.y) + a2 * oacc[dt][2], a1 * bfhi(pv.y) + a2 * oacc[dt][3]); *(u32x2*)(op + 16 * dt) = o; }
            if (fq == 0) *lp = mn + __builtin_amdgcn_logf(wsum);
            }
        }
    }
#undef ATT_FETCH
    __syncthreads();
}

struct Args { const float* in[28]; float* out; unsigned char* ws; int ph_lo, ph_hi, li, noepi; };
enum { I_X = 0, I_EV_NORM_MIX, I_EV_W_IN, I_EV_LN_G, I_EV_LN_B, I_EV_W_S, I_EV_B_S, I_EV_W_OUT, I_EV_NORM_FFN, I_EV_FFN_GATE, I_EV_FFN_UP, I_EV_FFN_DOWN,
       I_OD_NORM_MIX, I_OD_W_IN, I_OD_CONV_W, I_OD_CONV_B, I_OD_W_A, I_OD_B_A, I_OD_W_X, I_OD_B_X, I_OD_LAM, I_OD_W_OUT, I_OD_NORM_FFN, I_OD_ROUTER,
       I_OD_EXP_GATE, I_OD_EXP_UP, I_OD_EXP_DOWN, I_FINAL_NORM };
constexpr int N_PHASES = 20;

#ifndef PROBE_ID
#define PROBE_ID (-1)
#define PROBE_IDX 0
#define PROBE_DIV 1.0e6f
#endif
#define PROBE_PTR(id) ((PROBE_ID == (id)) ? (unsigned long long*)(ws + WS_CTL) + 512 : (unsigned long long*)nullptr)
#ifndef MFMA_MASK
#define MFMA_MASK 0x1ff
#endif
static_assert(((MFMA_MASK >> 7) & 3) == 3, "the MoE expert GEMMs are fp8: MFMA path only");
static_assert(!(FFN_GU_FP8 || FFN_GU_MIX) || EVOUT_MIXED, "the e4m3 copy of x1 overlays CAT: the out-projection must read CAT2");
template <int ID, class Epi, bool FP8 = false, int F8FROM = 0>
__device__ __forceinline__ void dense_gemm_phase(const Frame& F, const bf16* A, int lda, const bf16* Bt, int ldb, int K, int ncol, int nunits, const Epi& E, unsigned long long* probe = nullptr, const int noepi = 0, const long adelta = 0) {
    if constexpr ((MFMA_MASK >> ID) & 1) {
        pg8::SchedDense S; S.so.init(nunits / ncol, ncol, F.G, F.bid); S.A = (const char*)A; S.B = (const char*)Bt; S.tstepA = (size_t)256 * lda * 2; S.tstepB = (size_t)256 * ldb * 2; S.acol_shift = -1; S.acol_bytes = 0; S.tok = nullptr;
        pg8::gemm_phase<Epi, pg8::SchedDense, false, true, FP8, F8FROM>(F.lds, S, E, K, lda, ldb, probe, noepi, adelta);
    } else {
        const int wr = F.wave >> 2, wc = F.wave & 3, fr = F.lane & 15, fq = F.lane >> 4;
        ARowDense ar{A, lda};
        for (int i = F.bid; i < nunits; i += F.G) { Unit u; u.pm = i / ncol; u.pn = i % ncol; u.newpm = 1; naive_gemm_unit(ar, Bt + (size_t)u.pn * 256 * ldb, ldb, K, u, E, wr, wc, fr, fq); }
    }
}

__global__ void __launch_bounds__(NTHR, 2) fwd(Args args) {
    extern __shared__ __attribute__((aligned(16))) unsigned char lds_raw[];
    const unsigned lds_base = (unsigned)(uintptr_t)lds_raw;
    Frame F; F.lds = (LAS unsigned char*)lds_raw; F.tid = threadIdx.x; F.lane = F.tid & 63; F.wave = __builtin_amdgcn_readfirstlane(F.tid >> 6); F.bid = blockIdx.x; F.G = gridDim.x;
    unsigned char* ws = args.ws;
    const int lo = args.ph_lo, hi = args.ph_hi;
#define IN(k) (lo <= (k) && (k) < hi)
#define SEAM(k) do { if (IN(k) && IN((k) + 1)) xcd_barrier(bar); } while (0)
#ifndef REPEAT_MASK
#define REPEAT_NOEPI 0
#define REPEAT_MASK 0
#endif
#define PHASE(k) if (IN(k) && frame_refresh(F, gw, gt))
    for (int u = F.tid; u < (LDS_BYTES - LDSCTL_OFF) / 4; u += NTHR) ((LAS unsigned*)(F.lds + LDSCTL_OFF))[u] = 0u;
    __syncthreads();
    XcdBarrier bar = xcd_barrier_post((unsigned*)(ws + WS_CTL) + CW_BAR + args.li * XCD_BAR_WORDS, (volatile LAS unsigned*)(F.lds + LDSCTL_OFF));
    int gw = F.bid * NWAVES + F.wave; const int NGW = F.G * NWAVES;
    int gt = F.bid * NTHR + F.tid; const int NGT = F.G * NTHR;
    float* const xres = args.out;
    bf16* const XB = (bf16*)(ws + WS_XB);
    float* const SSQ0 = (float*)(ws + WS_SSQ0); float* const SSQ1 = (float*)(ws + WS_SSQ1); float* const SSQ2 = (float*)(ws + WS_SSQ2); float* const SSQ3 = (float*)(ws + WS_SSQ3);

    PHASE(0) {
        LAS float* scr = (LAS float*)(F.lds + F.wave * 16640);
        constexpr int I0 = 32 * 88, I1 = 32 * 32, I2 = 32 * 88, I3 = 88 * 32, I4 = 32 * 80, I5 = 4 * 4, I6 = 40 * 32, I7 = 32 * 44, I8 = 44 * 32;
        constexpr int NITEMS = I0 + I1 + 2 * I2 + I3 + I4 + 20 * I5 + I6 + 16 * I7 + 8 * I8;
        for (int it = gw; it < NITEMS; it += NGW) {
            int r = it; MapV mp;
            if (r < I0) { mp = MapV{args.in[I_EV_W_IN], args.in[I_EV_NORM_MIX], (bf16*)(ws + WS_W_EVIN), D, NIN0, 2, 0, 0.f}; }
            else if ((r -= I0) < I1) {
                if (!EVOUT_MIXED) mp = MapV{args.in[I_EV_W_OUT], nullptr, (bf16*)(ws + WS_W_EVOUT), D, D, 0, 0, 0.f};
                else if (r < (DA / 64) * (D / 64)) mp = MapV{args.in[I_EV_W_OUT], nullptr, (bf16*)(ws + WS_W_EVOUT), C2P / 2, D, 0, 0, 0.f, F8_SW};
                else { r -= (DA / 64) * (D / 64); mp = MapV{args.in[I_EV_W_OUT] + (size_t)DA * D, nullptr, (bf16*)(ws + WS_W_EVOUT + 2 * DA), C2P, D, 0, 0, F8_SW}; }
            }
            else if ((r -= I1) < 2 * I2) { const int hf = r >= I2; r -= hf * I2; const float* Wg = hf ? args.in[I_EV_FFN_UP] : args.in[I_EV_FFN_GATE];
                if (!FFN_GU_MIX) mp = MapV{Wg, args.in[I_EV_NORM_FFN], (bf16*)(ws + WS_W_FGU), D, DFF, 1, hf, FFN_GU_FP8 ? F8_SW : 0.f};
                else if (r < (FGU_KB / 64) * (DFF / 64)) mp = MapV{Wg, args.in[I_EV_NORM_FFN], (bf16*)(ws + WS_W_FGU), FGU_P / 2, DFF, 1, hf, 0.f, F8_SW};
                else { r -= (FGU_KB / 64) * (DFF / 64); mp = MapV{Wg + (size_t)FGU_KB * DFF, args.in[I_EV_NORM_FFN] + FGU_KB, (bf16*)(ws + WS_W_FGU + 2 * FGU_KB), FGU_P, DFF, 1, hf, F8_SW}; }
            }
            else if ((r -= 2 * I2) < I3) { mp = MapV{args.in[I_EV_FFN_DOWN], nullptr, (bf16*)(ws + WS_W_FDN), DFF, D, 0, 0, FFN_DOWN_FP8 ? F8_SW : 0.f}; }
            else if ((r -= I3) < I4) { mp = MapV{args.in[I_OD_W_IN], args.in[I_OD_NORM_MIX], (bf16*)(ws + WS_W_ODIN), D, 2 * DRNN, 0, 0, OD_IN_FP8 ? F8_SW : 0.f}; }
            else if ((r -= I4) < 10 * I5) { const int n = r / I5; r -= n * I5; mp = MapV{args.in[I_OD_W_A] + (size_t)n * 65536, nullptr, (bf16*)(ws + WS_W_AX) + (size_t)n * 512 * 256, 256, 256, 1, 0, 0.f}; }
            else if ((r -= 10 * I5) < 10 * I5) { const int n = r / I5; r -= n * I5; mp = MapV{args.in[I_OD_W_X] + (size_t)n * 65536, nullptr, (bf16*)(ws + WS_W_AX) + (size_t)n * 512 * 256, 256, 256, 1, 1, 0.f}; }
            else if ((r -= 10 * I5) < I6) { mp = MapV{args.in[I_OD_W_OUT], nullptr, (bf16*)(ws + WS_W_ODOUT), DRNN, D, 0, 0, 0.f}; }
            else if ((r -= I6) < 8 * I7) { const int e = r / I7; r -= e * I7; mp = MapV{args.in[I_OD_EXP_GATE] + (size_t)e * D * DFE, args.in[I_OD_NORM_FFN], (bf16*)(ws + WS_W_EGU + (size_t)e * 2 * DFE * D), D, DFE, 1, 0, F8_SW}; }
            else if ((r -= 8 * I7) < 8 * I7) { const int e = r / I7; r -= e * I7; mp = MapV{args.in[I_OD_EXP_UP] + (size_t)e * D * DFE, args.in[I_OD_NORM_FFN], (bf16*)(ws + WS_W_EGU + (size_t)e * 2 * DFE * D), D, DFE, 1, 1, F8_SW}; }
            else { r -= 8 * I7; const int e = r / I8; r -= e * I8; mp = MapV{args.in[I_OD_EXP_DOWN] + (size_t)e * DFE * D, nullptr, (bf16*)(ws + WS_W_EDN + (size_t)e * D * DFE), DFE, D, 0, 0, F8_SW}; }
            cvt_item64(mp, r, scr, F.lane);
        }
        { const float* Ws = args.in[I_EV_W_S]; bf16* WSM = (bf16*)(ws + WS_WSM);
          for (int i = gt; i < 4 * 128 * 128; i += NGT) { const int t = (i >> 7) & 127, sidx = i & 127; WSM[i] = (bf16)f2bf(sidx <= t ? Ws[i] : 0.f); } }
        for (int c = gt; c < DRNN; c += NGT) ((float*)(ws + WS_SP8))[c] = -8.0f * log1pf(expf(-args.in[I_OD_LAM][c]));
        const float* x = args.in[I_X];
        for (int m = gw; m < M; m += NGW) {
            const f32x4* xr = (const f32x4*)(x + (size_t)m * D) + F.lane; u32x2* o8 = (u32x2*)(XB + (size_t)m * D) + F.lane; float s = 0.f;
#pragma unroll
            for (int j = 0; j < 8; ++j) { const f32x4 v = xr[64 * j]; s += (v.x * v.x + v.y * v.y) + (v.z * v.z + v.w * v.w); u32x2 w; w.x = pk2(v.x, v.y); w.y = pk2(v.z, v.w); o8[64 * j] = w;
                if (EVIN_QKV_FP8) *((unsigned*)((unsigned char*)args.out + (size_t)m * D) + F.lane + 64 * j) = pk4_f8(v.x * F8_SX, v.y * F8_SX, v.z * F8_SX, v.w * F8_SX); }
            s = wave_sum(s); if (F.lane == 0) SSQ0[m] = s;
        }
    }
    SEAM(0);
    PHASE(1) {
        if constexpr (EVIN_QKV_FP8) {
            EpiEvIn E1{SSQ0, (bf16*)(ws + WS_U), (bf16*)(ws + WS_VA), (bf16*)(ws + WS_Q), (bf16*)(ws + WS_K), (bf16*)(ws + WS_V), 0, 1.0f};
            dense_gemm_phase<0>(F, XB, D, (const bf16*)(ws + WS_W_EVIN), D, D, 4, (M / 256) * 4, E1, PROBE_PTR(0), (REPEAT_NOEPI ? args.noepi : 0));
            EpiEvIn E2{SSQ0, (bf16*)(ws + WS_U), (bf16*)(ws + WS_VA), (bf16*)(ws + WS_Q), (bf16*)(ws + WS_K), (bf16*)(ws + WS_V), 4, 1.0f / (F8_SX * F8_SW)};
            dense_gemm_phase<0, EpiEvIn, true>(F, (const bf16*)args.out, D / 2, (const bf16*)(ws + WS_W_EVIN + EVIN8_OFF), D / 2, D / 2, 18, (M / 256) * 18, E2, nullptr, (REPEAT_NOEPI ? args.noepi : 0));
        } else {
            EpiEvIn E{SSQ0, (bf16*)(ws + WS_U), (bf16*)(ws + WS_VA), (bf16*)(ws + WS_Q), (bf16*)(ws + WS_K), (bf16*)(ws + WS_V), 0, 1.0f};
            dense_gemm_phase<0>(F, XB, D, (const bf16*)(ws + WS_W_EVIN), D, D, NIN0 / 256, (M / 256) * (NIN0 / 256), E, PROBE_PTR(0), (REPEAT_NOEPI ? args.noepi : 0));
        }
    }
    SEAM(1);
    PHASE(2) {
        const bf16* U = (const bf16*)(ws + WS_U); const bf16* VA = (const bf16*)(ws + WS_VA); bf16* CAT = (bf16*)(ws + WS_CAT);
        const float* ln_g = args.in[I_EV_LN_G]; const float* ln_b = args.in[I_EV_LN_B]; const float* bs = args.in[I_EV_B_S]; const bf16* WSM = (const bf16*)(ws + WS_WSM);
        typedef pg8::bf16x8 bf16x8;
        constexpr int WP = 272, VP = 288, WOFF = 1024, VOFF2 = WOFF + 128 * WP;
        LAS float* stats = (LAS float*)F.lds;
        LAS unsigned char* Wl = F.lds + WOFF; LAS unsigned char* Vl = F.lds + VOFF2;
        const int fr = F.lane & 15, fq = F.lane >> 4;
        const unsigned vbg = lds_base + VOFF2 + (unsigned)((8 * fq + ((F.lane & 15) >> 2)) * VP + (16 * F.wave + 4 * (F.lane & 3)) * 2);
        for (int c = F.bid; c < M / 128; c += F.G) {
            const int r0 = c * 128;
            __syncthreads();
            for (int rr = 0; rr < 16; ++rr) {
                const int sr = F.wave * 16 + rr; const u32x4 w = *(const u32x4*)(VA + (size_t)(r0 + sr) * DA + 8 * F.lane);
                const float v[8] = {bflo(w.x), bfhi(w.x), bflo(w.y), bfhi(w.y), bflo(w.z), bfhi(w.z), bflo(w.w), bfhi(w.w)};
                float sm = 0.f;
#pragma unroll
                for (int i = 0; i < 8; ++i) sm += v[i];
                const float mean = wave_sum(sm) * (1.0f / DA); float q = 0.f;
#pragma unroll
                for (int i = 0; i < 8; ++i) { const float dd = v[i] - mean; q += dd * dd; }
                const float var = wave_sum(q) * (1.0f / DA);
                if (F.lane == 0) { stats[2 * sr] = mean; stats[2 * sr + 1] = 1.0f / sqrtf(var + LN_EPS); }
            }
            __syncthreads();
            for (int g = 0; g < 4; ++g) {
#pragma unroll
                for (int j = 0; j < 4; ++j) { const int pc = F.tid + NTHR * j, t = pc >> 4, piece = pc & 15;
                    *(LAS u32x4*)(Wl + t * WP + piece * 16) = *(const u32x4*)(WSM + (size_t)(g * 128 + t) * 128 + piece * 8); }
                { const int sr = F.tid >> 2, cq = (F.tid & 3) * 32; const float mean = stats[2 * sr], rstd = stats[2 * sr + 1];
#pragma unroll
                  for (int i4 = 0; i4 < 4; ++i4) { const int col = g * 128 + cq + 8 * i4; const u32x4 w = *(const u32x4*)(VA + (size_t)(r0 + sr) * DA + col);
                      const float v[8] = {bflo(w.x), bfhi(w.x), bflo(w.y), bfhi(w.y), bflo(w.z), bfhi(w.z), bflo(w.w), bfhi(w.w)};
                      const f32x4 g0 = *(const f32x4*)(ln_g + col), g1 = *(const f32x4*)(ln_g + col + 4), b0 = *(const f32x4*)(ln_b + col), b1 = *(const f32x4*)(ln_b + col + 4);
                      u32x4 o; o.x = pk2((v[0] - mean) * rstd * g0.x + b0.x, (v[1] - mean) * rstd * g0.y + b0.y); o.y = pk2((v[2] - mean) * rstd * g0.z + b0.z, (v[3] - mean) * rstd * g0.w + b0.w);
                      o.z = pk2((v[4] - mean) * rstd * g1.x + b1.x, (v[5] - mean) * rstd * g1.y + b1.y); o.w = pk2((v[6] - mean) * rstd * g1.z + b1.z, (v[7] - mean) * rstd * g1.w + b1.w);
                      *(LAS u32x4*)(Vl + sr * VP + (cq + 8 * i4) * 2) = o; } }
                __syncthreads();
                bf16x8 xf[4];
                { s16x4 a0 = tr_read<(0 * 32 + 0) * VP>(vbg), a1 = tr_read<(0 * 32 + 4) * VP>(vbg), b0 = tr_read<(1 * 32 + 0) * VP>(vbg), b1 = tr_read<(1 * 32 + 4) * VP>(vbg);
                  s16x4 c0 = tr_read<(2 * 32 + 0) * VP>(vbg), c1 = tr_read<(2 * 32 + 4) * VP>(vbg), d0 = tr_read<(3 * 32 + 0) * VP>(vbg), d1 = tr_read<(3 * 32 + 4) * VP>(vbg);
                  asm volatile("s_waitcnt lgkmcnt(0)" ::: "memory"); __builtin_amdgcn_sched_barrier(0);
                  xf[0] = (bf16x8){a0[0], a0[1], a0[2], a0[3], a1[0], a1[1], a1[2], a1[3]}; xf[1] = (bf16x8){b0[0], b0[1], b0[2], b0[3], b1[0], b1[1], b1[2], b1[3]};
                  xf[2] = (bf16x8){c0[0], c0[1], c0[2], c0[3], c1[0], c1[1], c1[2], c1[3]}; xf[3] = (bf16x8){d0[0], d0[1], d0[2], d0[3], d1[0], d1[1], d1[2], d1[3]}; }
                const LAS unsigned char* wb = Wl + fr * WP + fq * 16;
#pragma unroll
                for (int tt = 0; tt < 8; ++tt) {
                    f32x4 a = (f32x4){0.f, 0.f, 0.f, 0.f};
#pragma unroll
                    for (int ks = 0; ks < (tt >> 1) + 1; ++ks) { const bf16x8 yf = *(const LAS bf16x8*)(wb + tt * 16 * WP + ks * 64); a = __builtin_amdgcn_mfma_f32_16x16x32_bf16(xf[ks], yf, a, 0, 0, 0); }
                    const int t = 16 * tt + fr; const int col = g * 128 + 16 * F.wave + 4 * fq; const float bias = bs[g * 128 + t];
                    const u32x2 uw = *(const u32x2*)(U + (size_t)(r0 + t) * DA + col);
                    u32x2 o;
                    if (EVOUT_MIXED) { o.x = pk2(bflo(uw.x) * (a[0] + bias) * F8_SX, bfhi(uw.x) * (a[1] + bias) * F8_SX); o.y = pk2(bflo(uw.y) * (a[2] + bias) * F8_SX, bfhi(uw.y) * (a[3] + bias) * F8_SX);
                        *(u32x2*)((unsigned char*)args.out + (size_t)(r0 + t) * C2P + col * 2) = o; }
                    else { o.x = pk2(bflo(uw.x) * (a[0] + bias), bfhi(uw.x) * (a[1] + bias)); o.y = pk2(bflo(uw.y) * (a[2] + bias), bfhi(uw.y) * (a[3] + bias));
                        *(u32x2*)(CAT + (size_t)(r0 + t) * D + col) = o; }
                }
                __syncthreads();
            }
        }
        __syncthreads();
        attn_pass<0>(F, lds_base, (const bf16*)(ws + WS_Q), (const bf16*)(ws + WS_K), (const bf16*)(ws + WS_V), CAT, (float*)(ws + WS_LSE));
    }
    SEAM(2);
    PHASE(3) attn_pass<1>(F, lds_base, (const bf16*)(ws + WS_Q), (const bf16*)(ws + WS_K), (const bf16*)(ws + WS_V), (bf16*)(ws + WS_CAT), (float*)(ws + WS_LSE));
    SEAM(3);
    PHASE(4) attn_pass<2>(F, lds_base, (const bf16*)(ws + WS_Q), (const bf16*)(ws + WS_K), (const bf16*)(ws + WS_V), (bf16*)(ws + WS_CAT), (float*)(ws + WS_LSE), (unsigned char*)args.out);
    SEAM(4);
    PHASE(5) {
        EpiResid<true, (FFN_GU_MIX ? 2 : (FFN_GU_FP8 ? 1 : 0))> E{args.in[I_X], XB, SSQ1, EVOUT_MIXED ? 1.0f / (F8_SX * F8_SW) : 1.0f};
        if constexpr (EVOUT_MIXED) dense_gemm_phase<1, EpiResid<true, (FFN_GU_MIX ? 2 : (FFN_GU_FP8 ? 1 : 0))>, true, 2 * DA / 128>(F, (const bf16*)args.out, C2P / 2, (const bf16*)(ws + WS_W_EVOUT), C2P / 2, C2P / 2, D / 256, (M / 256) * (D / 256), E, PROBE_PTR(1), (REPEAT_NOEPI ? args.noepi : 0));
        else dense_gemm_phase<1>(F, (const bf16*)(ws + WS_CAT), D, (const bf16*)(ws + WS_W_EVOUT), D, D, D / 256, (M / 256) * (D / 256), E, PROBE_PTR(1), (REPEAT_NOEPI ? args.noepi : 0));
    }
    SEAM(5);
    PHASE(6) {
        EpiGateUp<false, FFN_DOWN_FP8 != 0> E{SSQ1, (bf16*)(ws + WS_H), DFF, nullptr, nullptr, (LAS float*)(F.lds + 131072), FFN_GU_MIX ? 1.0f / F8_SW : (FFN_GU_FP8 ? 1.0f / (F8_SX * F8_SW) : 1.0f)};
        if constexpr (FFN_GU_MIX) dense_gemm_phase<2, EpiGateUp<false, FFN_DOWN_FP8 != 0>, true, 2 * FGU_KB / 128>(F, XB, D, (const bf16*)(ws + WS_W_FGU), FGU_P / 2, FGU_P / 2, 2 * DFF / 256, (M / 256) * (2 * DFF / 256), E, PROBE_PTR(2), (REPEAT_NOEPI ? args.noepi : 0), X18_DELTA);
        else if constexpr (FFN_GU_FP8) dense_gemm_phase<2, EpiGateUp<false, FFN_DOWN_FP8 != 0>, true>(F, (const bf16*)(ws + WS_X18), D / 2, (const bf16*)(ws + WS_W_FGU), D / 2, D / 2, 2 * DFF / 256, (M / 256) * (2 * DFF / 256), E, PROBE_PTR(2), (REPEAT_NOEPI ? args.noepi : 0));
        else dense_gemm_phase<2>(F, XB, D, (const bf16*)(ws + WS_W_FGU), D, D, 2 * DFF / 256, (M / 256) * (2 * DFF / 256), E, PROBE_PTR(2), (REPEAT_NOEPI ? args.noepi : 0));
    }
    SEAM(6);
    PHASE(7) {
        EpiResid<false, (OD_IN_FP8 ? 1 : 0)> E{nullptr, XB, SSQ2, FFN_DOWN_FP8 ? 1.0f / (F8_SH * F8_SW) : 1.0f};
        if constexpr (FFN_DOWN_FP8) dense_gemm_phase<3, EpiResid<false, (OD_IN_FP8 ? 1 : 0)>, true>(F, (const bf16*)(ws + WS_H), DFF / 2, (const bf16*)(ws + WS_W_FDN), DFF / 2, DFF / 2, D / 256, (M / 256) * (D / 256), E, PROBE_PTR(3), (REPEAT_NOEPI ? args.noepi : 0));
        else dense_gemm_phase<3>(F, (const bf16*)(ws + WS_H), DFF, (const bf16*)(ws + WS_W_FDN), DFF, DFF, D / 256, (M / 256) * (D / 256), E, PROBE_PTR(3), (REPEAT_NOEPI ? args.noepi : 0));
    }
    SEAM(7);
    PHASE(8) {
        EpiOdIn E{SSQ2, (bf16*)(ws + WS_G), (bf16*)(ws + WS_XR), (LAS float*)(F.lds + 131072), OD_IN_FP8 ? 1.0f / (F8_SX * F8_SW) : 1.0f};
        if constexpr (OD_IN_FP8) dense_gemm_phase<4, EpiOdIn, true>(F, (const bf16*)(ws + WS_X18), D / 2, (const bf16*)(ws + WS_W_ODIN), D / 2, D / 2, 2 * DRNN / 256, (M / 256) * (2 * DRNN / 256), E, PROBE_PTR(4), (REPEAT_NOEPI ? args.noepi : 0));
        else dense_gemm_phase<4>(F, XB, D, (const bf16*)(ws + WS_W_ODIN), D, D, 2 * DRNN / 256, (M / 256) * (2 * DRNN / 256), E, PROBE_PTR(4), (REPEAT_NOEPI ? args.noepi : 0));
    }
    SEAM(8);
    PHASE(9) {
        const bf16* XR = (const bf16*)(ws + WS_XR); bf16* XC = (bf16*)(ws + WS_XC); const float* cw = args.in[I_OD_CONV_W]; const float* cb = args.in[I_OD_CONV_B];
        for (int it = gt; it < (M / 16) * (DRNN / 8); it += NGT) {
            const int rb = it / (DRNN / 8), cg = it - rb * (DRNN / 8), ch = cg * 8, r0 = rb * 16;
            f32x4 w[4][2], bias[2];
#pragma unroll
            for (int tap = 0; tap < 4; ++tap) { w[tap][0] = *(const f32x4*)(cw + tap * DRNN + ch); w[tap][1] = *(const f32x4*)(cw + tap * DRNN + ch + 4); }
            bias[0] = *(const f32x4*)(cb + ch); bias[1] = *(const f32x4*)(cb + ch + 4);
            const bf16* xp = XR + (size_t)r0 * DRNN + ch; bf16* op = XC + (size_t)r0 * DRNN + ch;
            u32x4 h1 = (u32x4){0u, 0u, 0u, 0u}, h2 = h1, h3 = h1;
            if ((r0 & (S - 1)) != 0) { h1 = *(const u32x4*)(xp - DRNN); h2 = *(const u32x4*)(xp - 2 * DRNN); h3 = *(const u32x4*)(xp - 3 * DRNN); }
            f32x4 x1[2] = {(f32x4){bflo(h1.x), bfhi(h1.x), bflo(h1.y), bfhi(h1.y)}, (f32x4){bflo(h1.z), bfhi(h1.z), bflo(h1.w), bfhi(h1.w)}};
            f32x4 x2[2] = {(f32x4){bflo(h2.x), bfhi(h2.x), bflo(h2.y), bfhi(h2.y)}, (f32x4){bflo(h2.z), bfhi(h2.z), bflo(h2.w), bfhi(h2.w)}};
            f32x4 x3[2] = {(f32x4){bflo(h3.x), bfhi(h3.x), bflo(h3.y), bfhi(h3.y)}, (f32x4){bflo(h3.z), bfhi(h3.z), bflo(h3.w), bfhi(h3.w)}};
#pragma unroll
            for (int t = 0; t < 16; ++t) {
                const u32x4 h0 = *(const u32x4*)(xp + (size_t)t * DRNN);
                const f32x4 x0[2] = {(f32x4){bflo(h0.x), bfhi(h0.x), bflo(h0.y), bfhi(h0.y)}, (f32x4){bflo(h0.z), bfhi(h0.z), bflo(h0.w), bfhi(h0.w)}};
                const f32x4 y0 = bias[0] + x3[0] * w[0][0] + x2[0] * w[1][0] + x1[0] * w[2][0] + x0[0] * w[3][0];
                const f32x4 y1 = bias[1] + x3[1] * w[0][1] + x2[1] * w[1][1] + x1[1] * w[2][1] + x0[1] * w[3][1];
                store8(op + (size_t)t * DRNN, y0, y1);
                x3[0] = x2[0]; x3[1] = x2[1]; x2[0] = x1[0]; x2[1] = x1[1]; x1[0] = x0[0]; x1[1] = x0[1];
            }
        }
    }
    SEAM(9);
    PHASE(10) {
        const bf16* XC = (const bf16*)(ws + WS_XC);
        EpiGates E{XC, args.in[I_OD_B_A], args.in[I_OD_B_X], (const float*)(ws + WS_SP8), (bf16*)(ws + WS_LA), (bf16*)args.out};
        if constexpr ((MFMA_MASK >> 5) & 1) {
            pg8::SchedDense Sg; Sg.so.init(M / 256, 20, F.G, F.bid); Sg.A = (const char*)XC; Sg.B = (const char*)(ws + WS_W_AX); Sg.tstepA = (size_t)256 * DRNN * 2; Sg.tstepB = (size_t)256 * 256 * 2; Sg.acol_shift = 1; Sg.acol_bytes = 512; Sg.tok = nullptr;
            pg8::gemm_phase<EpiGates, pg8::SchedDense, false, true>(F.lds, Sg, E, 256, DRNN, 256, nullptr, (REPEAT_NOEPI ? args.noepi : 0));
        } else {
        const int wr = F.wave >> 2, wc = F.wave & 3, fr = F.lane & 15, fq = F.lane >> 4;
        for (int i = F.bid; i < (M / 256) * 20; i += F.G) { Unit u; u.pm = i / 20; u.pn = i % 20; u.newpm = 1;
            ARowDense ar{XC + (u.pn >> 1) * 256, DRNN};
            naive_gemm_unit(ar, (const bf16*)(ws + WS_W_AX) + (size_t)u.pn * 256 * 256, 256, 256, u, E, wr, wc, fr, fq); }
        }
    }
    SEAM(10);
    const bf16* LA = (const bf16*)(ws + WS_LA); const bf16* BT = (const bf16*)args.out;
    constexpr int SCL = 16, NCHK = S / SCL;
    float* CA = (float*)(ws + WS_XC); float* CBv = CA + (size_t)2 * DRNN * NCHK; float* HIN = CBv + (size_t)2 * DRNN * NCHK;
    PHASE(11) {
        for (int it = gt; it < 2 * NCHK * (DRNN / 8); it += NGT) {
            const int cg = it % (DRNN / 8), bc = it / (DRNN / 8), ch = cg * 8;
            const size_t base = (size_t)bc * SCL * DRNN + ch;
            u32x4 lw[SCL], bw[SCL];
#pragma unroll
            for (int t = 0; t < SCL; ++t) { lw[t] = *(const u32x4*)(LA + base + (size_t)t * DRNN); bw[t] = *(const u32x4*)(BT + base + (size_t)t * DRNN); }
            float h[8], P[8];
#pragma unroll
            for (int i = 0; i < 8; ++i) { h[i] = 0.f; P[i] = 1.f; }
#pragma unroll
            for (int t = 0; t < SCL; ++t) {
                const float la[8] = {bflo(lw[t].x), bfhi(lw[t].x), bflo(lw[t].y), bfhi(lw[t].y), bflo(lw[t].z), bfhi(lw[t].z), bflo(lw[t].w), bfhi(lw[t].w)};
                const float bb[8] = {bflo(bw[t].x), bfhi(bw[t].x), bflo(bw[t].y), bfhi(bw[t].y), bflo(bw[t].z), bfhi(bw[t].z), bflo(bw[t].w), bfhi(bw[t].w)};
#pragma unroll
                for (int i = 0; i < 8; ++i) { const float a = __builtin_amdgcn_exp2f(la[i]); const float b = SCAN_SQRT ? __builtin_amdgcn_sqrtf(fmaxf(__builtin_fmaf(-a, a, 1.0f), 0.f)) * bb[i] : bb[i]; h[i] = a * h[i] + b; P[i] *= a; }
            }
            const size_t k = (size_t)bc * DRNN + ch;
            *(f32x4*)(CA + k) = (f32x4){P[0], P[1], P[2], P[3]}; *(f32x4*)(CA + k + 4) = (f32x4){P[4], P[5], P[6], P[7]};
            *(f32x4*)(CBv + k) = (f32x4){h[0], h[1], h[2], h[3]}; *(f32x4*)(CBv + k + 4) = (f32x4){h[4], h[5], h[6], h[7]};
        }
    }
    SEAM(11);
    PHASE(12) {
        for (int it = gw; it < 2 * (DRNN / 4); it += NGW) {
            const int b = it / (DRNN / 4), c4 = it - b * (DRNN / 4);
            const size_t k0 = ((size_t)b * NCHK + 16 * F.lane) * DRNN + 4 * c4;
            f32x4 a4[16], b4[16];
#pragma unroll
            for (int q = 0; q < 16; ++q) { a4[q] = *(const f32x4*)(CA + k0 + (size_t)q * DRNN); b4[q] = *(const f32x4*)(CBv + k0 + (size_t)q * DRNN); }
            f32x4 A = a4[0], B = b4[0];
#pragma unroll
            for (int q = 1; q < 16; ++q) { B = a4[q] * B + b4[q]; A = A * a4[q]; }
#pragma unroll
            for (int o = 1; o < 64; o <<= 1) {
                f32x4 Ap, Bp;
#pragma unroll
                for (int c = 0; c < 4; ++c) { Ap[c] = __shfl_up(A[c], o); Bp[c] = __shfl_up(B[c], o); }
                if (F.lane >= o) { B = A * Bp + B; A = A * Ap; }
            }
            f32x4 hin;
#pragma unroll
            for (int c = 0; c < 4; ++c) hin[c] = __shfl_up(B[c], 1);
            if (F.lane == 0) hin = (f32x4){0.f, 0.f, 0.f, 0.f};
#pragma unroll
            for (int q = 0; q < 16; ++q) { *(f32x4*)(HIN + k0 + (size_t)q * DRNN) = hin; hin = a4[q] * hin + b4[q]; }
        }
    }
    SEAM(12);
    PHASE(13) {
        bf16* Gb = (bf16*)(ws + WS_G);
        for (int it = gt; it < 2 * NCHK * (DRNN / 8); it += NGT) {
            const int cg = it % (DRNN / 8), bc = it / (DRNN / 8), ch = cg * 8;
            const size_t base = (size_t)bc * SCL * DRNN + ch;
            const size_t k = (size_t)bc * DRNN + ch;
            const f32x4 h0 = *(const f32x4*)(HIN + k), h1 = *(const f32x4*)(HIN + k + 4);
            float h[8] = {h0.x, h0.y, h0.z, h0.w, h1.x, h1.y, h1.z, h1.w};
#pragma unroll 8
            for (int t = 0; t < SCL; ++t) {
                const size_t o = base + (size_t)t * DRNN;
                const u32x4 lw = *(const u32x4*)(LA + o), bw = *(const u32x4*)(BT + o), gwv = *(const u32x4*)(Gb + o);
                const float la[8] = {bflo(lw.x), bfhi(lw.x), bflo(lw.y), bfhi(lw.y), bflo(lw.z), bfhi(lw.z), bflo(lw.w), bfhi(lw.w)};
                const float bb[8] = {bflo(bw.x), bfhi(bw.x), bflo(bw.y), bfhi(bw.y), bflo(bw.z), bfhi(bw.z), bflo(bw.w), bfhi(bw.w)};
                const float gg[8] = {bflo(gwv.x), bfhi(gwv.x), bflo(gwv.y), bfhi(gwv.y), bflo(gwv.z), bfhi(gwv.z), bflo(gwv.w), bfhi(gwv.w)};
                float y[8];
#pragma unroll
                for (int i = 0; i < 8; ++i) { const float a = __builtin_amdgcn_exp2f(la[i]); const float b = SCAN_SQRT ? __builtin_amdgcn_sqrtf(fmaxf(__builtin_fmaf(-a, a, 1.0f), 0.f)) * bb[i] : bb[i]; h[i] = a * h[i] + b; y[i] = gg[i] * h[i]; }
                u32x4 ow; ow.x = pk2(y[0], y[1]); ow.y = pk2(y[2], y[3]); ow.z = pk2(y[4], y[5]); ow.w = pk2(y[6], y[7]);
                *(u32x4*)(Gb + o) = ow;
            }
        }
    }
    SEAM(13);
    PHASE(14) {
        EpiResid<false> E{nullptr, XB, SSQ3, 1.0f};
        dense_gemm_phase<6>(F, (const bf16*)(ws + WS_G), DRNN, (const bf16*)(ws + WS_W_ODOUT), DRNN, DRNN, D / 256, (M / 256) * (D / 256), E, PROBE_PTR(6), (REPEAT_NOEPI ? args.noepi : 0));
    }
    SEAM(14);
    int* TOPE = (int*)(ws + WS_TOPE); float* TOPG = (float*)(ws + WS_TOPG); int* CNT = (int*)(ws + WS_CNT); int* EOFF = (int*)(ws + WS_EOFF);
    int* TOK = (int*)(ws + WS_TOK); float* GWv = (float*)(ws + WS_GW); int* DEST = (int*)(ws + WS_DEST);
    unsigned char* X8 = ws + WS_X8;
    float* RS3 = (float*)(ws + WS_SSQ0);
    float* RSR = (float*)(ws + WS_CA);
    const int TPW = (M + F.G - 1) / F.G;
    PHASE(15) {
        const float* Wr = args.in[I_OD_ROUTER]; const float* gn = args.in[I_OD_NORM_FFN];
        LAS int* cnt8 = (LAS int*)F.lds;
        if (F.tid < 8) cnt8[F.tid] = 0;
        __syncthreads();
        int myc[8];
#pragma unroll
        for (int e = 0; e < 8; ++e) myc[e] = 0;
        for (int tg = F.wave; 4 * tg < TPW; tg += NWAVES) {
            const int t0 = F.bid * TPW + 4 * tg; if (t0 >= M) break;
            float a[4][8];
#pragma unroll
            for (int q = 0; q < 4; ++q)
#pragma unroll
                for (int e = 0; e < 8; ++e) a[q][e] = 0.f;
#pragma unroll 2
            for (int j = 0; j < 8; ++j) { const int k0 = 4 * F.lane + 256 * j; const f32x4 gv = *(const f32x4*)(gn + k0);
                f32x4 xv[4];
#pragma unroll
                for (int q = 0; q < 4; ++q) { const int tq = (t0 + q < M) ? t0 + q : M - 1; const u32x2 xw = *((const u32x2*)(XB + (size_t)tq * D) + F.lane + 64 * j);
                    const f32x4 xr4 = (f32x4){bflo(xw.x), bfhi(xw.x), bflo(xw.y), bfhi(xw.y)};
                    *((unsigned*)(X8 + (size_t)tq * D) + F.lane + 64 * j) = pk4_f8(xr4.x * F8_SX, xr4.y * F8_SX, xr4.z * F8_SX, xr4.w * F8_SX);
                    xv[q] = xr4 * gv; }
#pragma unroll
                for (int kk = 0; kk < 4; ++kk) { const f32x4 w0 = *(const f32x4*)(Wr + (size_t)(k0 + kk) * 8), w1 = *(const f32x4*)(Wr + (size_t)(k0 + kk) * 8 + 4);
#pragma unroll
                    for (int q = 0; q < 4; ++q) { const float xg = xv[q][kk];
                        a[q][0] += xg * w0.x; a[q][1] += xg * w0.y; a[q][2] += xg * w0.z; a[q][3] += xg * w0.w; a[q][4] += xg * w1.x; a[q][5] += xg * w1.y; a[q][6] += xg * w1.z; a[q][7] += xg * w1.w; } } }
#pragma unroll
            for (int q = 0; q < 4; ++q) {
                const int t = t0 + q; if (t >= M) break;
#pragma unroll
                for (int e = 0; e < 8; ++e) a[q][e] = wave_sum(a[q][e]);
                const float sq = (F.lane < 32) ? SSQ3[(size_t)t * 32 + F.lane] : 0.f; const float rs = rsq_mean(wave_sum(sq));
                int e1 = 0; float l1 = a[q][0];
#pragma unroll
                for (int e = 1; e < 8; ++e) if (a[q][e] > l1) { l1 = a[q][e]; e1 = e; }
                int e2 = -1; float l2 = -INFINITY;
#pragma unroll
                for (int e = 0; e < 8; ++e) if (e != e1 && a[q][e] > l2) { l2 = a[q][e]; e2 = e; }
                const float g1 = 1.0f / (1.0f + expf((l2 - l1) * rs)), g2 = 1.0f - g1;
                if (F.lane == 0) { TOPE[2 * t] = e1; TOPE[2 * t + 1] = e2; TOPG[2 * t] = g1; TOPG[2 * t + 1] = g2; RS3[t] = rs; }
#pragma unroll
                for (int e = 0; e < 8; ++e) myc[e] += (e == e1) + (e == e2);
            }
        }
        if (F.lane == 0) {
#pragma unroll
            for (int e = 0; e < 8; ++e) atomicAdd((int*)(lds_raw) + e, myc[e]);
        }
        __syncthreads();
        if (F.tid < 8) CNT[F.bid * 8 + F.tid] = cnt8[F.tid];
    }
    SEAM(15);
    PHASE(16) {
        LAS int* tot = (LAS int*)F.lds;
        LAS int* bef = tot + 8;
        LAS int* eoff = tot + 16;
        LAS int* cntc = tot + 32;
        LAS int* run = tot + 32 + 8 * 64;
        { LAS int* pt = tot + 1024; LAS int* pb = pt + 512;
          const int e = F.tid & 7, wc0 = F.tid >> 3; int t = 0, b = 0;
          for (int w = wc0; w < F.G; w += 64) { const int c = CNT[w * 8 + e]; t += c; if (w < F.bid) b += c; }
          pt[F.tid] = t; pb[F.tid] = b;
          __syncthreads();
          if (F.tid < 8) { int tt = 0, bb = 0; for (int q = 0; q < 64; ++q) { tt += pt[q * 8 + F.tid]; bb += pb[q * 8 + F.tid]; } tot[F.tid] = tt; bef[F.tid] = bb; } }
        __syncthreads();
        if (F.tid == 0) { int o = 0; for (int e = 0; e < 8; ++e) { eoff[e] = o; o += (tot[e] + 255) & ~255; } eoff[8] = o; }
        __syncthreads();
        if (F.bid == 0 && F.tid < 9) EOFF[F.tid] = eoff[F.tid];
        const int nslots = 2 * TPW, nchunk = (nslots + 63) / 64;
        for (int c = F.wave; c < nchunk; c += NWAVES) {
            const int sl = c * 64 + F.lane; const int t = F.bid * TPW + (sl >> 1); const int e = (sl < nslots && t < M) ? TOPE[2 * t + (sl & 1)] : -1;
#pragma unroll
            for (int x = 0; x < 8; ++x) { const unsigned long long mk = __ballot(e == x); if (F.lane == 0) cntc[c * 8 + x] = __popcll(mk); }
        }
        __syncthreads();
        if (F.tid < 8) { int r = 0; for (int c = 0; c < nchunk; ++c) { const int v = cntc[c * 8 + F.tid]; cntc[c * 8 + F.tid] = r; r += v; } }
        __syncthreads();
        for (int c = F.wave; c < nchunk; c += NWAVES) {
            const int sl = c * 64 + F.lane; const int t = F.bid * TPW + (sl >> 1); const bool ok = (sl < nslots && t < M); const int e = ok ? TOPE[2 * t + (sl & 1)] : -1;
            int posn = -1;
#pragma unroll
            for (int x = 0; x < 8; ++x) { const unsigned long long mk = __ballot(e == x); if (e == x) posn = eoff[x] + bef[x] + cntc[c * 8 + x] + __popcll(mk & ((1ull << F.lane) - 1ull)); }
            if (ok) { TOK[posn] = t; GWv[posn] = TOPG[2 * t + (sl & 1)]; DEST[posn] = (sl & 1) * M + t; RSR[posn] = RS3[t]; }
        }
        if (F.bid < 8) { const int e = F.bid; for (int p = eoff[e] + tot[e] + F.tid; p < eoff[e + 1]; p += NTHR) { TOK[p] = 0; GWv[p] = 0.f; DEST[p] = -1; RSR[p] = 0.f; } }
        (void)run;
    }
    SEAM(16);
    PHASE(17) {
        EpiGateUp<true> E{nullptr, (bf16*)(ws + WS_HM), DFE, RSR, GWv, nullptr};
        const int wr = F.wave >> 2, wc = F.wave & 3, fr = F.lane & 15, fq = F.lane >> 4;
        int eo[9];
#pragma unroll
        for (int e = 0; e < 9; ++e) eo[e] = EOFF[e];
        const int NT = eo[8] / 256;
        if constexpr ((MFMA_MASK >> 7) & 1) {
            pg8::SchedMoe Sm; Sm.so.init(NT, 22, F.G, F.bid); Sm.A = (const char*)X8; Sm.B = (const char*)(ws + WS_W_EGU); Sm.tstepA = 0; Sm.tstepB = (size_t)256 * D; Sm.estrideB = (size_t)2 * DFE * D;
#pragma unroll
            for (int e = 0; e < 9; ++e) Sm.eo[e] = eo[e];
            Sm.tok = TOK; Sm.gather = true;
            pg8::gemm_phase<EpiGateUp<true>, pg8::SchedMoe, true, true, true>(F.lds, Sm, E, D / 2, D / 2, D / 2, nullptr, (REPEAT_NOEPI ? args.noepi : 0));
        } else {
        ARowGather ar{XB, D, TOK};
        for (int i = F.bid; i < NT * 22; i += F.G) { Unit u; u.pm = i / 22; u.pn = i % 22; int e = 0;
#pragma unroll
            for (int x = 1; x < 8; ++x) e += (u.pm * 256 >= eo[x]);
            naive_gemm_unit(ar, (const bf16*)(ws + WS_W_EGU) + (size_t)e * 2 * DFE * D + (size_t)u.pn * 256 * D, D, D, u, E, wr, wc, fr, fq); }
        }
    }
    SEAM(17);
    PHASE(18) {
        EpiMoeDown E{DEST, (bf16*)(ws + WS_Y0), (bf16*)(ws + WS_Y1)};
        const int wr = F.wave >> 2, wc = F.wave & 3, fr = F.lane & 15, fq = F.lane >> 4;
        int eo[9];
#pragma unroll
        for (int e = 0; e < 9; ++e) eo[e] = EOFF[e];
        const int NT = eo[8] / 256;
        if constexpr ((MFMA_MASK >> 8) & 1) {
            pg8::SchedMoe Sm; Sm.so.init(NT, 8, F.G, F.bid); Sm.A = (const char*)(ws + WS_HM); Sm.B = (const char*)(ws + WS_W_EDN); Sm.tstepA = (size_t)256 * DFE; Sm.tstepB = (size_t)256 * DFE; Sm.estrideB = (size_t)D * DFE;
#pragma unroll
            for (int e = 0; e < 9; ++e) Sm.eo[e] = eo[e];
            Sm.tok = nullptr; Sm.gather = false;
            pg8::gemm_phase<EpiMoeDown, pg8::SchedMoe, false, true, true>(F.lds, Sm, E, DFE / 2, DFE / 2, DFE / 2, nullptr, (REPEAT_NOEPI ? args.noepi : 0));
        } else {
        ARowDense ar{(const bf16*)(ws + WS_HM), DFE};
        for (int i = F.bid; i < NT * 8; i += F.G) { Unit u; u.pm = i / 8; u.pn = i % 8; int e = 0;
#pragma unroll
            for (int x = 1; x < 8; ++x) e += (u.pm * 256 >= eo[x]);
            naive_gemm_unit(ar, (const bf16*)(ws + WS_W_EDN) + (size_t)e * D * DFE + (size_t)u.pn * 256 * DFE, DFE, DFE, u, E, wr, wc, fr, fq); }
        }
    }
    SEAM(18);
    PHASE(19) {
        const bf16* Y0 = (const bf16*)(ws + WS_Y0); const bf16* Y1 = (const bf16*)(ws + WS_Y1); const float* gf = args.in[I_FINAL_NORM];
        for (int m = gw; m < M; m += NGW) {
            f32x4* orow = (f32x4*)(xres + (size_t)m * D) + F.lane; const u32x2* xb = (const u32x2*)(XB + (size_t)m * D) + F.lane;
            const u32x2* y0 = (const u32x2*)(Y0 + (size_t)m * D) + F.lane; const u32x2* y1 = (const u32x2*)(Y1 + (size_t)m * D) + F.lane;
            f32x4 v[8]; float s = 0.f;
#pragma unroll
            for (int j = 0; j < 8; ++j) { const u32x2 x = xb[64 * j]; const u32x2 a = y0[64 * j], b = y1[64 * j];
                v[j] = (f32x4){bflo(x.x) + bflo(a.x) + bflo(b.x), bfhi(x.x) + bfhi(a.x) + bfhi(b.x), bflo(x.y) + bflo(a.y) + bflo(b.y), bfhi(x.y) + bfhi(a.y) + bfhi(b.y)};
                s += (v[j].x * v[j].x + v[j].y * v[j].y) + (v[j].z * v[j].z + v[j].w * v[j].w); }
            float rs = 1.0f / sqrtf(wave_sum(s) * (1.0f / D) + RMS_EPS);
            if (PROBE_ID >= 0) rs *= 1.0f + (float)((const unsigned long long*)(ws + WS_CTL))[512 + PROBE_IDX] * (1.0f / PROBE_DIV);
#pragma unroll
            for (int j = 0; j < 8; ++j) { const f32x4 g = *((const f32x4*)gf + F.lane + 64 * j); orow[64 * j] = v[j] * rs * g; }
        }
    }
#undef IN
#undef SEAM
#undef PHASE
}

extern "C" void kernel_launch(void* const* d_in, const int* in_sizes, int n_in, void* d_out, int out_size, void* d_ws, size_t ws_size, hipStream_t stream) {
    static int grid = 0;
    if (grid == 0) {
        if (n_in != 28 || in_sizes[0] != M * D || out_size != M * D || ws_size < WS_END) { fprintf(stderr, "kernel_launch: unexpected shapes (n_in %d, in0 %d, out %d, ws %zu); nothing launched\n", n_in, n_in > 0 ? in_sizes[0] : -1, out_size, ws_size); grid = -1; return; }
        int dev = 0, cus = 0;
        if (hipGetDevice(&dev) != hipSuccess || hipDeviceGetAttribute(&cus, hipDeviceAttributeMultiprocessorCount, dev) != hipSuccess) { grid = -1; return; }
        if (hipFuncSetAttribute((const void*)fwd, hipFuncAttributeMaxDynamicSharedMemorySize, LDS_BYTES) != hipSuccess) { grid = -1; return; }
        int per_cu = 0;
        if (hipOccupancyMaxActiveBlocksPerMultiprocessor(&per_cu, (const void*)fwd, NTHR, LDS_BYTES) != hipSuccess || per_cu < 1) { fprintf(stderr, "kernel_launch: occupancy query says %d blocks per CU\n", per_cu); (void)hipGetLastError(); }
        grid = cus;
    }
    if (grid < 0) return;
    (void)hipMemsetAsync((char*)d_ws + WS_CTL, 0, CTL_ZERO_BYTES, stream);
    Args a{};
    for (int i = 0; i < 28; ++i) a.in[i] = (const float*)d_in[i];
    a.out = (float*)d_out; a.ws = (unsigned char*)d_ws;
#if defined(MK_PER_PHASE)
    for (int ph = 0; ph < N_PHASES; ++ph) { a.ph_lo = ph; a.ph_hi = ph + 1; a.li = ph; hipLaunchKernelGGL(fwd, dim3(grid), dim3(NTHR), LDS_BYTES, stream, a); }
#else
    if (REPEAT_MASK == 0) {
        a.ph_lo = 0; a.ph_hi = N_PHASES;
        hipLaunchKernelGGL(fwd, dim3(grid), dim3(NTHR), LDS_BYTES, stream, a);
    } else {
        int lo = 0, li = 0;
        for (int k = 0; k < N_PHASES; ++k) if ((REPEAT_MASK >> k) & 1) {
            a.ph_lo = lo; a.ph_hi = k + 1; a.li = li++; hipLaunchKernelGGL(fwd, dim3(grid), dim3(NTHR), LDS_BYTES, stream, a);
            a.ph_lo = k; a.ph_hi = k + 1; a.li = li++; a.noepi = REPEAT_NOEPI; hipLaunchKernelGGL(fwd, dim3(grid), dim3(NTHR), LDS_BYTES, stream, a); a.noepi = 0;
            lo = k + 1; }
        if (lo < N_PHASES) { a.ph_lo = lo; a.ph_hi = N_PHASES; a.li = li++; hipLaunchKernelGGL(fwd, dim3(grid), dim3(NTHR), LDS_BYTES, stream, a); }
    }
#endif
}
```

```cpp
#include <hip/hip_runtime.h>
#include <cstdio>
#include <cstdint>

#define GAS __attribute__((address_space(1)))
#define LAS __attribute__((address_space(3)))
typedef unsigned short bf16;
typedef float f32x4 __attribute__((ext_vector_type(4)));
typedef float f32x2 __attribute__((ext_vector_type(2)));
typedef unsigned u32x4 __attribute__((ext_vector_type(4)));
typedef unsigned u32x2 __attribute__((ext_vector_type(2)));

constexpr int M = 32768, S = 16384, D = 2048;
constexpr int DA = 512, DB = 1536, NIN0 = 5632, DFF = 5632, DRNN = 2560, NEXP = 8, DFE = 2816;
constexpr int NWAVES = 8, NTHR = 512;
constexpr float RMS_EPS = 1e-6f, LN_EPS = 1e-5f;
constexpr int FGU_KB = 1280, FGU_P = 2 * FGU_KB + (D - FGU_KB);
constexpr int C2P = 2 * DA + DB;
constexpr int RMAX = 2 * M + NEXP * 256;

constexpr size_t MiB = 1u << 20, KiB = 1u << 10;
constexpr size_t WS_CTL = 0, CTL_ZERO_BYTES = 1 * MiB;
constexpr size_t WS_SSQ0 = 1 * MiB;
constexpr size_t WS_SSQ1 = WS_SSQ0 + 128 * KiB;
constexpr size_t WS_SSQ2 = WS_SSQ1 + 4 * MiB;
constexpr size_t WS_SSQ3 = WS_SSQ2 + 4 * MiB;
constexpr size_t WS_TOPE = WS_SSQ3 + 4 * MiB;
constexpr size_t WS_TOPG = WS_TOPE + 256 * KiB;
constexpr size_t WS_CNT  = WS_TOPG + 256 * KiB;
constexpr size_t WS_EOFF = WS_CNT + 64 * KiB;
constexpr size_t WS_TOK  = WS_EOFF + 4 * KiB;
constexpr size_t WS_GW   = WS_TOK + 272 * KiB;
constexpr size_t WS_DEST = WS_GW + 272 * KiB;
constexpr size_t WS_CA   = WS_DEST + 272 * KiB;
constexpr size_t WS_CB   = WS_CA + 1280 * KiB;
constexpr size_t WS_HIN  = WS_CB + 1280 * KiB;
constexpr size_t WS_SP8  = WS_HIN + 1280 * KiB;
constexpr size_t WS_LSE  = WS_SP8 + 16 * KiB;
constexpr size_t WS_WSM  = WS_LSE + 1536 * KiB;
constexpr size_t WS_SMALL_END = WS_WSM + 128 * KiB;
static_assert(WS_SMALL_END <= 20 * MiB, "small region");
constexpr size_t WS_WODD = 20 * MiB;
constexpr size_t WS_W_ODIN = WS_WODD, WS_W_AX = WS_WODD + 20 * MiB, WS_W_ODOUT = WS_W_AX + 3 * MiB;
constexpr size_t WS_WL0 = 53 * MiB;
constexpr size_t WS_W_EVIN = WS_WL0, WS_W_EVOUT = WS_WL0 + 22 * MiB, WS_W_FGU = WS_W_EVOUT + 8 * MiB, WS_W_FDN = WS_W_FGU + 44 * MiB;
constexpr size_t WS_XB = 149 * MiB;
constexpr size_t WS_WEXP = 277 * MiB;
constexpr size_t WS_W_EGU = WS_WEXP, WS_W_EDN = WS_WEXP + 176 * MiB;
constexpr size_t WS_ACT = 541 * MiB;
constexpr size_t WS_END = 1021 * MiB;
constexpr size_t WS_U = WS_ACT, WS_VA = WS_ACT + 32 * MiB, WS_Q = WS_ACT + 64 * MiB, WS_K = WS_ACT + 160 * MiB, WS_V = WS_ACT + 256 * MiB, WS_CAT = WS_ACT + 352 * MiB;
constexpr size_t WS_X18 = WS_CAT;
constexpr long X18_DELTA = (long)WS_X18 - (long)WS_XB;
constexpr size_t WS_H = WS_ACT;
constexpr size_t WS_G = WS_ACT, WS_XR = WS_ACT + 160 * MiB, WS_XC = WS_ACT + 320 * MiB, WS_LA = WS_XR;
constexpr size_t WS_HM = WS_ACT;
constexpr size_t WS_X8 = WS_ACT + 256 * MiB;
constexpr size_t WS_Y0 = WS_W_EGU, WS_Y1 = WS_WODD;
static_assert((size_t)M * DRNN * 2 <= (size_t)M * D * 4, "BT fits d_out");
static_assert(WS_Y1 + (size_t)M * D * 2 <= WS_XB && WS_Y0 + (size_t)M * D * 2 <= WS_W_EDN, "Y overlays");
static_assert((size_t)RMAX * DFE * 2 <= 480 * MiB, "HM fits ACT");

constexpr float F8_SX = 16.f, F8_SW = 256.f, F8_SH = 8.f;
#ifndef EVIN_QKV_FP8
#define EVIN_QKV_FP8 1
#endif
constexpr size_t EVIN8_OFF = 4 * MiB;
#ifndef FFN_DOWN_FP8
#define PG8_NOCLEAR 1
#define EVOUT_MIXED 1
#define FFN_GU_FP8 0
#define OD_IN_FP8 0
#define FFN_GU_MIX 1
#define SCAN_SQRT 1
#define FFN_DOWN_FP8 1
#endif
constexpr int LDS_BYTES = 147456;
constexpr int LDSCTL_OFF = 146432;
constexpr int CW_BAR = 4096;
static_assert((CW_BAR + 48 * 3456) * 4 <= (int)CTL_ZERO_BYTES, "barrier words inside the memset region");

#define LDS_WAIT() asm volatile("s_waitcnt lgkmcnt(0)" ::: "memory")
#define VM_WAIT() asm volatile("s_waitcnt vmcnt(0)" ::: "memory")
__device__ __forceinline__ unsigned f2bf(float f) { unsigned u = __builtin_bit_cast(unsigned, f); return (u + 0x7fffu + ((u >> 16) & 1u)) >> 16; }
typedef __bf16 bf16n2 __attribute__((ext_vector_type(2)));
__device__ __forceinline__ unsigned pk2(float lo, float hi) { const bf16n2 v = __builtin_convertvector((f32x2){lo, hi}, bf16n2); return __builtin_bit_cast(unsigned, v); }
__device__ __forceinline__ unsigned pk4_f8(float a, float b, float c, float d) {
    a = __builtin_amdgcn_fmed3f(a, -448.f, 448.f); b = __builtin_amdgcn_fmed3f(b, -448.f, 448.f); c = __builtin_amdgcn_fmed3f(c, -448.f, 448.f); d = __builtin_amdgcn_fmed3f(d, -448.f, 448.f);
    int w = 0; w = __builtin_amdgcn_cvt_pk_fp8_f32(a, b, w, false); w = __builtin_amdgcn_cvt_pk_fp8_f32(c, d, w, true); return (unsigned)w; }
__device__ __forceinline__ float bflo(unsigned w) { return __builtin_bit_cast(float, w << 16); }
__device__ __forceinline__ float bfhi(unsigned w) { return __builtin_bit_cast(float, w & 0xffff0000u); }
__device__ __forceinline__ float bf2f(bf16 b) { return __builtin_bit_cast(float, ((unsigned)b) << 16); }
__device__ __forceinline__ float wave_sum(float v) {
#pragma unroll
    for (int o = 1; o < 64; o <<= 1) v += __shfl_xor(v, o);
    return v;
}
__device__ __forceinline__ float wave_max(float v) {
#pragma unroll
    for (int o = 1; o < 64; o <<= 1) v = fmaxf(v, __shfl_xor(v, o));
    return v;
}
__device__ __forceinline__ float fast_exp(float x) { return __builtin_amdgcn_exp2f(x * 1.44269504089f); }
__device__ __forceinline__ float sigmoid_f(float x) { return __builtin_amdgcn_rcpf(1.0f + fast_exp(-x)); }
__device__ __forceinline__ float silu_f(float x) { return x * sigmoid_f(x); }
__device__ __forceinline__ float gelu_f(float x) { const float u = 0.7978845608f * (x + 0.044715f * x * x * x); return x * sigmoid_f(2.0f * u); }
__device__ __forceinline__ f32x2 gelu2(f32x2 x) {
    const f32x2 q = x * x;
    const f32x2 a = x * (q * (0.044715f * -2.0f * 1.44269504089f * 0.7978845608f) + (-2.0f * 1.44269504089f * 0.7978845608f));
    const f32x2 d = (f32x2){__builtin_amdgcn_exp2f(a.x), __builtin_amdgcn_exp2f(a.y)} + 1.0f;
    return x * (f32x2){__builtin_amdgcn_rcpf(d.x), __builtin_amdgcn_rcpf(d.y)};
}
__device__ __forceinline__ void gelu8(f32x4& v0, f32x4& v1) {
    const f32x2 a = gelu2((f32x2){v0[0], v0[1]}), b = gelu2((f32x2){v0[2], v0[3]}), c = gelu2((f32x2){v1[0], v1[1]}), d = gelu2((f32x2){v1[2], v1[3]});
    v0 = (f32x4){a.x, a.y, b.x, b.y}; v1 = (f32x4){c.x, c.y, d.x, d.y};
}

#define XB_TMO      128
#define XB_XCNT(j)  (256  + 64 * (j))
#define XB_XSUB(j)  (1280 + 64 * (j))
#define XB_XGEN(j)  (2304 + 64 * (j))
#define XB_TOP      3328
#define XB_TOPGEN   3392
#define XCD_BAR_WORDS 3456
#define XB_SPIN_CAP (1u << 18)

__device__ __forceinline__ unsigned xb_ld(unsigned* p)              { return __hip_atomic_load(p, __ATOMIC_RELAXED, __HIP_MEMORY_SCOPE_AGENT); }
__device__ __forceinline__ unsigned xb_add(unsigned* p, unsigned v) { return __hip_atomic_fetch_add(p, v, __ATOMIC_RELAXED, __HIP_MEMORY_SCOPE_AGENT); }
__device__ __forceinline__ unsigned xb_xcc_id() { return (unsigned)__builtin_amdgcn_s_getreg((3 << 11) | 20) & 0xFu; }
#define XB_SPIN(cond, bar) do { unsigned _sp = 0; while (cond) { __builtin_amdgcn_s_sleep(1); \
    if ((++_sp & 255u) == 0u) { if (xb_ld(&(bar)[XB_TMO])) break; if (_sp > XB_SPIN_CAP) { atomicAdd(&(bar)[XB_TMO], 1u); break; } } } } while (0)

struct XcdBarrier {
    unsigned* bar; unsigned x;
    volatile LAS unsigned* st;
};

__device__ __forceinline__ XcdBarrier xcd_barrier_post(unsigned* bar, volatile LAS unsigned* st) {
    XcdBarrier b; b.bar = bar; b.x = xb_xcc_id(); b.st = st;
    if (threadIdx.x == 0) (void)xb_add(&bar[XB_XCNT(b.x)], 1u);
    return b;
}
__device__ __forceinline__ void xcd_barrier_complete(unsigned* bar, unsigned x, unsigned& nloc, unsigned& nx) {
    const unsigned G = gridDim.x * gridDim.y * gridDim.z;
    unsigned sum, cnt, mine, sp = 0u;
    for (;;) {
        sum = 0u; cnt = 0u; mine = 0u;
#pragma unroll
        for (unsigned j = 0; j < 16; ++j) { const unsigned c = xb_ld(&bar[XB_XCNT(j)]); sum += c; cnt += (c > 0u) ? 1u : 0u; mine = (j == x) ? c : mine; }
        if (sum == G) break;
        __builtin_amdgcn_s_sleep(1);
        if ((++sp & 255u) == 0u) { if (xb_ld(&bar[XB_TMO])) break; if (sp > XB_SPIN_CAP) { atomicAdd(&bar[XB_TMO], 1u); break; } }
    }
    nloc = mine > 0u ? mine : 1u; nx = cnt > 0u ? cnt : 1u;
}

__device__ __forceinline__ void xcd_barrier(const XcdBarrier& b) {
    asm volatile("s_waitcnt vmcnt(0)" ::: "memory");
    __syncthreads();
    if (threadIdx.x == 0) {
        unsigned* bar = b.bar;
        __builtin_amdgcn_s_waitcnt(0);
        unsigned nloc = b.st[0], nx = b.st[1];
        if (nloc == 0u) { xcd_barrier_complete(bar, b.x, nloc, nx); b.st[0] = nloc; b.st[1] = nx; }
        const unsigned old = xb_add(&bar[XB_XSUB(b.x)], 1u);
        const unsigned gen = old / nloc;
        if (old + 1u == (gen + 1u) * nloc) {
            __builtin_amdgcn_fence(__ATOMIC_RELEASE, "agent");
            asm volatile("s_waitcnt vmcnt(0)" ::: "memory");
            const unsigned og = xb_add(&bar[XB_TOP], 1u);
            const unsigned tg = og / nx;
            if (og + 1u == (tg + 1u) * nx) xb_add(&bar[XB_TOPGEN], 1u);
            else XB_SPIN(xb_ld(&bar[XB_TOPGEN]) == tg, bar);
            __builtin_amdgcn_fence(__ATOMIC_ACQUIRE, "agent");
            xb_add(&bar[XB_XGEN(b.x)], 1u);
            asm volatile("s_waitcnt vmcnt(0)" ::: "memory");
        } else {
            XB_SPIN(xb_ld(&bar[XB_XGEN(b.x)]) == gen, bar);
            __builtin_amdgcn_fence(__ATOMIC_ACQUIRE, "agent");
            asm volatile("s_waitcnt vmcnt(0)" ::: "memory");
        }
    }
    __syncthreads();
}

struct Frame {
    LAS unsigned char* lds;
    int tid, lane, wave, bid, G;
};
struct Unit { int pm, pn, newpm; };
__device__ __forceinline__ bool frame_refresh(Frame& F, int& gw, int& gt) {
    int t = threadIdx.x; asm volatile("" : "+v"(t));
    F.tid = t; F.lane = t & 63; F.wave = __builtin_amdgcn_readfirstlane(t >> 6);
    gw = F.bid * NWAVES + F.wave; gt = F.bid * NTHR + t; return true;
}

struct MapV { const float* W; const float* gain; bf16* dst; int K, NP, mode, half; float f8scale; float bscale; };
__device__ __forceinline__ int mapv_drow(const MapV& mp, int n) {
    if (mp.mode == 1) return ((n >> 7) << 8) + mp.half * 128 + (n & 127);
    if (mp.mode == 2 && n >= 2 * DA && n < 2 * DA + 2 * DB) { const int base = (n < 2 * DA + DB) ? 2 * DA : 2 * DA + DB; const int cc = n - base, head = cc >> 7, i = cc & 127; return base + head * 128 + ((i < 64) ? 2 * i : 2 * (i - 64) + 1); }
    return n;
}
__device__ __forceinline__ void cvt_item64(const MapV& mp, int item, LAS float* scr, int lane) {
    const int nblk = mp.NP / 64, kb = item / nblk, nb = item - kb * nblk, k0 = 64 * kb, n0 = 64 * nb;
    const int lr = lane >> 4, lc = (lane & 15) * 4;
    const float* src = mp.W + (size_t)(k0 + lr) * mp.NP + n0 + lc;
    f32x4 v[16];
#pragma unroll
    for (int i = 0; i < 16; ++i) v[i] = *(const f32x4*)(src + (size_t)(4 * i) * mp.NP);
    float cs = (mp.bscale > 0.f) ? mp.bscale : 1.0f; if (mp.mode == 2 && n0 >= 2 * DA && n0 < 2 * DA + DB) cs = 0.08838834764831845f * 1.4426950408889634f;
    const bool f8 = mp.f8scale > 0.f || (EVIN_QKV_FP8 && mp.mode == 2 && n0 >= 2 * DA);
    if (f8) cs *= (mp.f8scale > 0.f ? mp.f8scale : F8_SW);
#pragma unroll
    for (int i = 0; i < 16; ++i) { const float g = mp.gain ? mp.gain[k0 + 4 * i + lr] * cs : cs; LAS float* d = scr + (4 * i + lr) * 65 + lc;
        d[0] = v[i].x * g; d[1] = v[i].y * g; d[2] = v[i].z * g; d[3] = v[i].w * g; }
    LDS_WAIT();
    const int c = lane & 7;
    if (f8) {
        unsigned char* d8 = (unsigned char*)mp.dst; if (mp.mode == 2) d8 += EVIN8_OFF - (size_t)(2 * DA) * mp.K;
#pragma unroll
        for (int j = 0; j < 8; ++j) { const int n = (lane >> 3) + 8 * j; const LAS float* q = scr + (8 * c) * 65 + n;
            u32x2 o; o.x = pk4_f8(q[0 * 65], q[1 * 65], q[2 * 65], q[3 * 65]); o.y = pk4_f8(q[4 * 65], q[5 * 65], q[6 * 65], q[7 * 65]);
            *(u32x2*)(d8 + (size_t)mapv_drow(mp, n0 + n) * mp.K + k0 + 8 * c) = o; }
    } else {
#pragma unroll
        for (int j = 0; j < 8; ++j) { const int n = (lane >> 3) + 8 * j; const LAS float* q = scr + (8 * c) * 65 + n;
            u32x4 o; o.x = pk2(q[0 * 65], q[1 * 65]); o.y = pk2(q[2 * 65], q[3 * 65]); o.z = pk2(q[4 * 65], q[5 * 65]); o.w = pk2(q[6 * 65], q[7 * 65]);
            *(u32x4*)(mp.dst + (size_t)mapv_drow(mp, n0 + n) * mp.K + k0 + 8 * c) = o; }
    }
    LDS_WAIT();
}

template <class AR, class Epi>
__device__ __forceinline__ void naive_gemm_unit(const AR& ar, const bf16* Bt, int ldb, int K, const Unit& u, const Epi& E, int wr, int wc, int fr, int fq) {
    f32x4 acc[2][2][4][2];
#pragma unroll
    for (int a = 0; a < 2; ++a)
#pragma unroll
        for (int b = 0; b < 2; ++b)
#pragma unroll
            for (int m = 0; m < 4; ++m)
#pragma unroll
                for (int n = 0; n < 2; ++n) acc[a][b][m][n] = (f32x4){0.f, 0.f, 0.f, 0.f};
    const bf16* ap[2][4];
#pragma unroll
    for (int a = 0; a < 2; ++a)
#pragma unroll
        for (int m = 0; m < 4; ++m) ap[a][m] = ar.row(u, a * 128 + wr * 64 + m * 16 + fr);
#pragma unroll
    for (int b = 0; b < 2; ++b)
#pragma unroll
        for (int n = 0; n < 2; ++n) {
            const bf16* bp = Bt + (size_t)(b * 128 + wc * 32 + 8 * fq + 4 * n) * ldb;
#pragma unroll 1
            for (int k = 0; k < K; k += 4) {
                f32x4 bv[4];
#pragma unroll
                for (int j = 0; j < 4; ++j) { const u32x2 w = *(const u32x2*)(bp + (size_t)j * ldb + k); bv[j] = (f32x4){bflo(w.x), bfhi(w.x), bflo(w.y), bfhi(w.y)}; }
#pragma unroll
                for (int a = 0; a < 2; ++a)
#pragma unroll
                    for (int m = 0; m < 4; ++m) {
                        const u32x2 w = *(const u32x2*)(ap[a][m] + k); const f32x4 av = (f32x4){bflo(w.x), bfhi(w.x), bflo(w.y), bfhi(w.y)};
#pragma unroll
                        for (int j = 0; j < 4; ++j) { const f32x4 p = av * bv[j]; acc[a][b][m][n][j] += (p.x + p.y) + (p.z + p.w); }
                    }
            }
        }
    E(acc, u, wr, wc, fr, fq);
}
struct ARowDense { const bf16* A; int lda; __device__ __forceinline__ const bf16* row(const Unit& u, int r) const { return A + (size_t)(u.pm * 256 + r) * lda; } };
struct ARowGather { const bf16* A; int lda; const int* tok; __device__ __forceinline__ const bf16* row(const Unit& u, int r) const { return A + (size_t)tok[u.pm * 256 + r] * lda; } };

namespace pg8 {
typedef short bf16x8 __attribute__((ext_vector_type(8)));
typedef int i32x4 __attribute__((ext_vector_type(4)));
typedef int i32x8 __attribute__((ext_vector_type(8)));
constexpr int BM = 256, BK = 64, HALF = 128, HTB = HALF * BK * 2, STAGE_BYTES = 8 * HTB, NXCD = 8, WGM = 4;
__host__ __device__ __forceinline__ int lds_byte(int r, int c) { const int st = (r >> 4) * 2 + (c >> 5), rr = r & 15, cc = c & 31, ob = rr * 64 + cc * 2; return st * 1024 + (ob ^ (((ob >> 9) & 1) << 5)); }
__host__ __device__ __forceinline__ void stage_rc(int b, int& R, int& C) { const int st = b / 1024, sb = b % 1024, swz = sb ^ (((sb >> 9) & 1) << 5); R = (st >> 1) * 16 + swz / 64; C = (st & 1) * 32 + (swz % 64) / 2; }
__host__ __device__ __forceinline__ int perm32(int rho) { const int n = rho >> 4, i = rho & 15; return 8 * (i >> 2) + 4 * n + (i & 3); }
struct StaticOrder {
    int nM, nN, nwg, G, c;
    __host__ __device__ void init(int nM_, int nN_, int G_, int c_) { nM = nM_; nN = nN_; nwg = nM * nN; G = G_; c = c_; }
    __host__ __device__ bool next(int i, Unit& u) const {
        const long L = (long)i * G + c; if (L >= nwg) return false;
        int wgid = (int)L; { const int q = nwg / NXCD, r = nwg % NXCD, xcd = wgid % NXCD, off = wgid / NXCD; wgid = (xcd < r ? xcd * (q + 1) : r * (q + 1) + (xcd - r) * q) + off; }
        const int nig = WGM * nN, gid = wgid / nig, fm = gid * WGM, gsz = (nM - fm) < WGM ? (nM - fm) : WGM;
        u.pm = fm + ((wgid % nig) % gsz); u.pn = (wgid % nig) / gsz; return true;
    }
};
template <class Epi, class Sched, bool GATHER, bool ALIGN_EPI, bool FP8 = false, int F8FROM = 0>
__device__ __forceinline__ void gemm_phase(LAS unsigned char* lds, const Sched& S, const Epi& E, const int K, const int lda, const int ldb, unsigned long long* probe = nullptr, const int noepi = 0, const long adelta = 0) {
    unsigned long long pr_t0 = 0, pr_k = 0, pr_e = 0, pr_a = 0, pr_b = 0; unsigned pr_n = 0;
    const int tid = threadIdx.x, wid = __builtin_amdgcn_readfirstlane(tid >> 6), lane = tid & 63, wr = wid >> 2, wc = wid & 3, fr = lane & 15, fq = lane >> 4;
    constexpr bool T0 = FP8 && F8FROM == 0, T1 = FP8;
    static_assert(F8FROM == 0 || (FP8 && F8FROM >= 4 && F8FROM % 2 == 0 && PG8_NOCLEAR), "mixed K range: fp8 tail behind an even number (>= 4) of bf16 K-tiles");
    int nt = K / BK; asm volatile("" : "+s"(nt));
    unsigned voffA[2][2], nvoffA[2][2], voffB[2]; int RA[2]; unsigned CA2[2];
#pragma unroll
    for (int i = 0; i < 2; ++i) { int R, C; stage_rc(tid * 16 + i * 8192, R, C); const int Rb = (R & ~31) + perm32(R & 31);
        voffB[i] = (unsigned)(Rb * ldb + C) * 2u; RA[i] = R; CA2[i] = (unsigned)C * 2u;
        voffA[0][i] = (unsigned)(R * lda + C) * 2u; voffA[1][i] = (unsigned)((R + HALF) * lda + C) * 2u; nvoffA[0][i] = voffA[0][i]; nvoffA[1][i] = voffA[1][i]; }
    const size_t kstep = (size_t)(BK * 2);
    const size_t hstepB = (size_t)HALF * ldb * 2;
    const unsigned ldsw = (unsigned)wid * 1024u;
    const int aoff = lds_byte(wr * 64 + fr, fq * 8), boff = lds_byte(wc * 32 + fr, fq * 8);
#define PG8_SA(b, h) (((b) * 2 + (h)) * HTB)
#define PG8_SB(b, h) ((4 + (b) * 2 + (h)) * HTB)
#define PG8_STAGE(bufoff, gbase, voff) do { _Pragma("unroll") for (int _i = 0; _i < 2; ++_i) \
        __builtin_amdgcn_global_load_lds((const unsigned*)((const char*)(gbase) + (voff)[_i]), (LAS unsigned*)(lds + (bufoff) + ldsw + _i * 8192), 16, 0, 0); } while (0)
#define PG8_LDA(dst, b, h) do { _Pragma("unroll") for (int m = 0; m < 4; ++m) _Pragma("unroll") for (int k = 0; k < 2; ++k) dst[m][k] = *(const LAS bf16x8*)(lds + PG8_SA(b, h) + aoff + m * 2048 + k * 1024); } while (0)
#define PG8_LDB(dst, b, h) do { _Pragma("unroll") for (int n = 0; n < 2; ++n) _Pragma("unroll") for (int k = 0; k < 2; ++k) dst[n][k] = *(const LAS bf16x8*)(lds + PG8_SB(b, h) + boff + n * 2048 + k * 1024); } while (0)
#define PG8_MMA_T(T8, ai, bj, At, Bt) do { __builtin_amdgcn_s_setprio(1); \
        if constexpr (T8) { _Pragma("unroll") for (int m = 0; m < 4; ++m) _Pragma("unroll") for (int n = 0; n < 2; ++n) { \
            const i32x4 b0_ = __builtin_bit_cast(i32x4, Bt[n][0]), b1_ = __builtin_bit_cast(i32x4, Bt[n][1]), a0_ = __builtin_bit_cast(i32x4, At[m][0]), a1_ = __builtin_bit_cast(i32x4, At[m][1]); \
            const i32x8 bb_ = __builtin_shufflevector(b0_, b1_, 0, 1, 2, 3, 4, 5, 6, 7), aa_ = __builtin_shufflevector(a0_, a1_, 0, 1, 2, 3, 4, 5, 6, 7); \
            asm volatile("v_mfma_scale_f32_16x16x128_f8f6f4 %0, %1, %2, %0, %3, %3 op_sel_hi:[0,0,0]" : "+v"(acc[ai][bj][m][n]) : "v"(bb_), "v"(aa_), "v"(f8one)); } } \
        else if constexpr (PG8_NOCLEAR) { _Pragma("unroll") for (int k = 0; k < 2; ++k) _Pragma("unroll") for (int m = 0; m < 4; ++m) _Pragma("unroll") for (int n = 0; n < 2; ++n) \
            asm volatile("v_mfma_f32_16x16x32_bf16 %0, %1, %2, %0" : "+v"(acc[ai][bj][m][n]) : "v"(Bt[n][k]), "v"(At[m][k])); } \
        else { _Pragma("unroll") for (int m = 0; m < 4; ++m) _Pragma("unroll") for (int n = 0; n < 2; ++n) _Pragma("unroll") for (int k = 0; k < 2; ++k) \
            acc[ai][bj][m][n] = __builtin_amdgcn_mfma_f32_16x16x32_bf16(Bt[n][k], At[m][k], acc[ai][bj][m][n], 0, 0, 0); } \
        __builtin_amdgcn_s_setprio(0); } while (0)
#define PG8_MMA0_T(T8, ai, bj, At, Bt) do { __builtin_amdgcn_s_setprio(1); \
        if constexpr (T8) { _Pragma("unroll") for (int m = 0; m < 4; ++m) _Pragma("unroll") for (int n = 0; n < 2; ++n) { \
            const i32x4 b0_ = __builtin_bit_cast(i32x4, Bt[n][0]), b1_ = __builtin_bit_cast(i32x4, Bt[n][1]), a0_ = __builtin_bit_cast(i32x4, At[m][0]), a1_ = __builtin_bit_cast(i32x4, At[m][1]); \
            const i32x8 bb_ = __builtin_shufflevector(b0_, b1_, 0, 1, 2, 3, 4, 5, 6, 7), aa_ = __builtin_shufflevector(a0_, a1_, 0, 1, 2, 3, 4, 5, 6, 7); \
            asm volatile("v_mfma_scale_f32_16x16x128_f8f6f4 %0, %1, %2, 0, %3, %3 op_sel_hi:[0,0,0]" : "=&v"(acc[ai][bj][m][n]) : "v"(bb_), "v"(aa_), "v"(f8one)); } } \
        else { _Pragma("unroll") for (int m = 0; m < 4; ++m) _Pragma("unroll") for (int n = 0; n < 2; ++n) \
                asm volatile("v_mfma_f32_16x16x32_bf16 %0, %1, %2, 0" : "=&v"(acc[ai][bj][m][n]) : "v"(Bt[n][0]), "v"(At[m][0])); \
            _Pragma("unroll") for (int m = 0; m < 4; ++m) _Pragma("unroll") for (int n = 0; n < 2; ++n) \
                asm volatile("v_mfma_f32_16x16x32_bf16 %0, %1, %2, %0" : "+v"(acc[ai][bj][m][n]) : "v"(Bt[n][1]), "v"(At[m][1])); } \
        __builtin_amdgcn_s_setprio(0); } while (0)
#define PG8_MMA_A(ai, bj, At, Bt) PG8_MMA_T(T0, ai, bj, At, Bt)
#define PG8_MMA0_A(ai, bj, At, Bt) PG8_MMA0_T(T0, ai, bj, At, Bt)
#define PG8_MMA_B(ai, bj, At, Bt) PG8_MMA_T(T1, ai, bj, At, Bt)
#define PG8_WAIT_V(n) asm volatile("s_waitcnt vmcnt(" #n ")" ::: "memory")
#define PG8_WAIT_L(n) asm volatile("s_waitcnt lgkmcnt(" #n ")" ::: "memory")
#define PG8_BAR __builtin_amdgcn_s_barrier()
#define PG8_SCHED __builtin_amdgcn_sched_barrier(0)
    Unit cur, nxt; int ui = 0;
    if (!S.next(0, cur)) return;
    cur.newpm = 1;
    if (probe) pr_t0 = __builtin_amdgcn_s_memrealtime();
    if constexpr (GATHER) {
#pragma unroll
        for (int h = 0; h < 2; ++h)
#pragma unroll
            for (int i = 0; i < 2; ++i) voffA[h][i] = (unsigned)S.tok[cur.pm * BM + h * HALF + RA[i]] * (unsigned)(lda * 2) + CA2[i];
    }
    f32x4 acc[2][2][4][2];
#pragma unroll
    for (int a = 0; a < 2; ++a)
#pragma unroll
        for (int b = 0; b < 2; ++b)
#pragma unroll
            for (int m = 0; m < 4; ++m)
#pragma unroll
                for (int n = 0; n < 2; ++n) acc[a][b][m][n] = (f32x4){0.f, 0.f, 0.f, 0.f};
    bf16x8 At[4][2], B0[2][2], B1[2][2]; const int f8one = 0x7f7f7f7f;
    const char* cA = S.a_base(cur); const char* cB = S.b_base(cur);
    PG8_STAGE(PG8_SB(0, 0), cB, voffB); PG8_STAGE(PG8_SB(0, 1), cB + hstepB, voffB); PG8_STAGE(PG8_SA(0, 0), cA, voffA[0]); PG8_STAGE(PG8_SA(0, 1), cA, voffA[1]);
    if (wr == 1) PG8_BAR;
    PG8_WAIT_V(2); PG8_BAR;
    PG8_STAGE(PG8_SB(1, 0), cB + kstep, voffB); PG8_STAGE(PG8_SA(1, 0), cA + kstep, voffA[0]); PG8_STAGE(PG8_SB(1, 1), cB + hstepB + kstep, voffB);
    PG8_WAIT_V(6); PG8_BAR;
    for (;;) {
        const bool has_next = S.next(ui + 1, nxt);
        const char* nA = has_next ? S.a_base(nxt) : cA; const char* nB = has_next ? S.b_base(nxt) : cB;
        if constexpr (GATHER) {
            if (has_next) {
#pragma unroll
                for (int h = 0; h < 2; ++h)
#pragma unroll
                    for (int i = 0; i < 2; ++i) nvoffA[h][i] = (unsigned)S.tok[nxt.pm * BM + h * HALF + RA[i]] * (unsigned)(lda * 2) + CA2[i];
            } else {
#pragma unroll
                for (int h = 0; h < 2; ++h)
#pragma unroll
                    for (int i = 0; i < 2; ++i) nvoffA[h][i] = voffA[h][i];
            }
        }
        if (probe) pr_a = __builtin_amdgcn_s_memrealtime();
#define PG8_ITER(MM0, MM1) { \
            const bool last = (t == nt - 2); \
            const char* a1 = cA + (size_t)(t + 1) * kstep + ((F8FROM > 0 && t >= F8FROM) ? adelta : 0); \
            const char* a2 = last ? nA : cA + (size_t)(t + 2) * kstep + ((F8FROM > 0 && t + 2 >= F8FROM) ? adelta : 0); const char* b2 = last ? nB : cB + (size_t)(t + 2) * kstep; \
            const char* a3 = a2 + kstep; const char* b3 = b2 + kstep; \
            unsigned v2[2][2]; \
            _Pragma("unroll") for (int h = 0; h < 2; ++h) _Pragma("unroll") for (int i = 0; i < 2; ++i) v2[h][i] = (GATHER && last) ? nvoffA[h][i] : voffA[h][i]; \
              \
            PG8_LDB(B0, 0, 0); PG8_LDB(B1, 0, 1); PG8_SCHED; PG8_LDA(At, 0, 0); PG8_STAGE(PG8_SA(1, 1), a1, voffA[1]); \
            PG8_WAIT_V(8); PG8_WAIT_L(0); PG8_BAR; MM0(0, 0, At, B0); MM0(0, 1, At, B1); PG8_BAR; PG8_SCHED; \
              \
            PG8_LDA(At, 0, 1); PG8_STAGE(PG8_SB(0, 0), b2, voffB); PG8_STAGE(PG8_SB(0, 1), b2 + hstepB, voffB); PG8_STAGE(PG8_SA(0, 0), a2, v2[0]); \
            PG8_WAIT_V(8); PG8_WAIT_L(0); PG8_BAR; MM0(1, 0, At, B0); MM0(1, 1, At, B1); PG8_BAR; PG8_SCHED; \
              \
            PG8_LDB(B0, 1, 0); PG8_LDB(B1, 1, 1); PG8_SCHED; PG8_LDA(At, 1, 0); PG8_STAGE(PG8_SA(0, 1), a2, v2[1]); \
            PG8_WAIT_V(8); PG8_WAIT_L(0); PG8_BAR; MM1(0, 0, At, B0); MM1(0, 1, At, B1); PG8_BAR; PG8_SCHED; \
              \
            PG8_LDA(At, 1, 1); PG8_STAGE(PG8_SB(1, 0), b3, voffB); PG8_STAGE(PG8_SB(1, 1), b3 + hstepB, voffB); PG8_STAGE(PG8_SA(1, 0), a3, v2[0]); \
            PG8_WAIT_V(8); PG8_WAIT_L(0); PG8_BAR; MM1(1, 0, At, B0); MM1(1, 1, At, B1); PG8_BAR; PG8_SCHED; }
        int t = 0;
        if constexpr (PG8_NOCLEAR) { PG8_ITER(PG8_MMA0_A, PG8_MMA_A) t = 2; }
        if constexpr (F8FROM > 0) { for (; t < F8FROM; t += 2) PG8_ITER(PG8_MMA_A, PG8_MMA_A) }
        for (; t < nt; t += 2) PG8_ITER(PG8_MMA_B, PG8_MMA_B)
#undef PG8_ITER
        if constexpr (FP8 || PG8_NOCLEAR) asm volatile("s_nop 15\n\ts_nop 7" ::: "memory");
        if (probe) { pr_b = __builtin_amdgcn_s_memrealtime(); pr_k += pr_b - pr_a; }
        if constexpr (ALIGN_EPI) { if (wr == 0) PG8_BAR; }
        if (!noepi) { int fr_o = fr, fq_o = fq; asm volatile("" : "+v"(fr_o), "+v"(fq_o));
            E(acc, cur, wr, wc, fr_o, fq_o); }
        if (probe) { asm volatile("s_waitcnt vmcnt(0)" ::: "memory"); pr_e += __builtin_amdgcn_s_memrealtime() - pr_b; ++pr_n; }
        if (!has_next) break;
        if constexpr (!PG8_NOCLEAR) {
#pragma unroll
        for (int a = 0; a < 2; ++a)
#pragma unroll
            for (int b = 0; b < 2; ++b)
#pragma unroll
                for (int m = 0; m < 4; ++m)
#pragma unroll
                    for (int n = 0; n < 2; ++n) acc[a][b][m][n] = (f32x4){0.f, 0.f, 0.f, 0.f};
        }
        nxt.newpm = (nxt.pm != cur.pm); cur = nxt; cA = nA; cB = nB; ++ui;
        if constexpr (GATHER) {
#pragma unroll
            for (int h = 0; h < 2; ++h)
#pragma unroll
                for (int i = 0; i < 2; ++i) voffA[h][i] = nvoffA[h][i];
        }
        if constexpr (ALIGN_EPI) { if (wr == 1) PG8_BAR; }
    }
    PG8_WAIT_V(0);
    if constexpr (!ALIGN_EPI) { if (wr == 0) PG8_BAR; }
    PG8_BAR;
    if (probe && blockIdx.x == 0 && tid == 0) { probe[0] = pr_k; probe[1] = pr_e; probe[2] = __builtin_amdgcn_s_memrealtime() - pr_t0; probe[3] = pr_n; }
#undef PG8_SA
#undef PG8_SB
#undef PG8_STAGE
#undef PG8_LDA
#undef PG8_LDB
#undef PG8_MMA_T
#undef PG8_MMA0_T
#undef PG8_MMA_A
#undef PG8_MMA0_A
#undef PG8_MMA_B
#undef PG8_WAIT_V
#undef PG8_WAIT_L
#undef PG8_BAR
#undef PG8_SCHED
}
struct SchedDense {
    StaticOrder so; const char* A; const char* B; size_t tstepA, tstepB; int acol_shift; size_t acol_bytes; const int* tok;
    __device__ __forceinline__ bool next(int i, Unit& u) const { return so.next(i, u); }
    __device__ __forceinline__ const char* a_base(const Unit& u) const { return A + (size_t)u.pm * tstepA + (acol_shift >= 0 ? (size_t)(u.pn >> acol_shift) * acol_bytes : 0); }
    __device__ __forceinline__ const char* b_base(const Unit& u) const { return B + (size_t)u.pn * tstepB; }
};
struct SchedMoe {
    StaticOrder so; const char* A; const char* B; size_t tstepA, tstepB, estrideB; int eo[9]; const int* tok; bool gather;
    __device__ __forceinline__ bool next(int i, Unit& u) const { return so.next(i, u); }
    __device__ __forceinline__ int expert(int pm) const { int e = 0;
#pragma unroll
        for (int x = 1; x < 8; ++x) e += (pm * 256 >= eo[x]); return e; }
    __device__ __forceinline__ const char* a_base(const Unit& u) const { return gather ? A : A + (size_t)u.pm * tstepA; }
    __device__ __forceinline__ const char* b_base(const Unit& u) const { return B + (size_t)expert(u.pm) * estrideB + (size_t)u.pn * tstepB; }
};
}

__device__ __forceinline__ float rsq_mean(float ssum) { return __builtin_amdgcn_rsqf(ssum * (1.0f / D) + RMS_EPS); }
__device__ __forceinline__ void rs_tile_to_lds(const float* ssq, int pm, LAS float* rsl) {
    const int tid = threadIdx.x;
    if (tid < 256) {
        const f32x4* p = (const f32x4*)(ssq + (size_t)(pm * 256 + tid) * 32); f32x4 v[8];
#pragma unroll
        for (int i = 0; i < 8; ++i) v[i] = p[i];
        float sm = 0.f;
#pragma unroll
        for (int i = 0; i < 8; ++i) sm += (v[i].x + v[i].y) + (v[i].z + v[i].w);
        rsl[tid] = rsq_mean(sm);
    }
    asm volatile("s_waitcnt lgkmcnt(0)" ::: "memory"); __builtin_amdgcn_s_barrier(); asm volatile("" ::: "memory");
}
__device__ __forceinline__ void store8(bf16* p, const f32x4 v0, const f32x4 v1) {
    u32x4 w; w.x = pk2(v0[0], v0[1]); w.y = pk2(v0[2], v0[3]); w.z = pk2(v1[0], v1[1]); w.w = pk2(v1[2], v1[3]); *(u32x4*)p = w;
}
struct EpiEvIn {
    const float* ssq0; bf16 *U, *VA, *Q, *Kb, *V; int pn_off; float cs;
    __device__ __forceinline__ void operator()(const f32x4 (&acc)[2][2][4][2], const Unit& u, int wr, int wc, int fr, int fq) const {
        const int row0 = u.pm * 256 + wr * 64 + fr, cw = wc * 32 + 8 * fq;
        const int pn = u.pn + pn_off;
        float rs8[2][4];
#pragma unroll
        for (int ai = 0; ai < 2; ++ai)
#pragma unroll
            for (int m = 0; m < 4; ++m) rs8[ai][m] = ssq0[row0 + ai * 128 + m * 16];
        float invf[2][2];
#pragma unroll
        for (int n = 0; n < 2; ++n)
#pragma unroll
            for (int jj = 0; jj < 2; ++jj) { const int i = 16 * wc + 4 * fq + 2 * n + jj; invf[n][jj] = __builtin_amdgcn_exp2f(-13.287712379549449f * (float)i * (1.0f / 64.0f)) * 0.15915494309189535f; }
#pragma unroll
        for (int ai = 0; ai < 2; ++ai)
#pragma unroll
            for (int m = 0; m < 4; ++m) {
                const int r = row0 + ai * 128 + m * 16;
                const float rs = rsq_mean(rs8[ai][m]) * cs;
                const float pos = (float)(r & (S - 1));
#pragma unroll
                for (int bj = 0; bj < 2; ++bj) {
                    f32x4 v0 = acc[ai][bj][m][0] * rs, v1 = acc[ai][bj][m][1] * rs;
                    if (pn < 4) {
                        gelu8(v0, v1);
                        bf16* dst = (pn < 2 ? U : VA) + (size_t)r * DA + (pn & 1) * 256 + bj * 128 + cw;
                        store8(dst, v0, v1);
                    } else if (pn < 16) {
#pragma unroll
                        for (int n = 0; n < 2; ++n) {
                            f32x4& v = n ? v1 : v0;
                            const f32x2 c2 = (f32x2){invf[n][0], invf[n][1]}, p2 = (f32x2){pos, pos};
                            const f32x2 hi = p2 * c2; const f32x2 lo = (f32x2){__builtin_fmaf(pos, c2.x, -hi.x), __builtin_fmaf(pos, c2.y, -hi.y)};
                            const f32x2 fr2 = (hi - (f32x2){floorf(hi.x), floorf(hi.y)}) + lo;
#pragma unroll
                            for (int jj = 0; jj < 2; ++jj) {
                                const float fr_ = jj ? fr2.y : fr2.x;
                                const float sn = __builtin_amdgcn_sinf(fr_), cs = __builtin_amdgcn_cosf(fr_);
                                const f32x2 x = (f32x2){v[2 * jj], v[2 * jj + 1]}, xs = (f32x2){-v[2 * jj + 1], v[2 * jj]};
                                const f32x2 y = x * cs + xs * sn;
                                v[2 * jj] = y.x; v[2 * jj + 1] = y.y;
                            }
                        }
                        const int t = (pn < 10) ? pn - 4 : pn - 10;
                        bf16* dst = (pn < 10 ? Q : Kb) + (size_t)r * DB + t * 256 + bj * 128 + cw;
                        store8(dst, v0, v1);
                    } else {
                        bf16* dst = V + (size_t)r * DB + (pn - 16) * 256 + bj * 128 + cw;
                        store8(dst, v0, v1);
                    }
                }
            }
    }
};
template <bool F32IN, int X8OUT = 0> struct EpiResid {
    const float* xi; bf16* XB; float* ssq; float cs;
    __device__ __forceinline__ void operator()(const f32x4 (&acc)[2][2][4][2], const Unit& u, int wr, int wc, int fr, int fq) const {
        const int row0 = u.pm * 256 + wr * 64 + fr, col0 = u.pn * 256 + wc * 32 + 8 * fq;
        if constexpr (!F32IN) {
            u32x4 xin[4][2][2];
#define ER_LOAD(G) do { _Pragma("unroll") for (int mm = 0; mm < 2; ++mm) _Pragma("unroll") for (int bj = 0; bj < 2; ++bj) \
                xin[G][mm][bj] = *(const u32x4*)(XB + (size_t)(row0 + ((G) >> 1) * 128 + (2 * ((G) & 1) + mm) * 16) * D + col0 + bj * 128); } while (0)
#define ER_USE(G) do { _Pragma("unroll") for (int mm = 0; mm < 2; ++mm) { const int ai = (G) >> 1, m = 2 * ((G) & 1) + mm; const int r = row0 + ai * 128 + m * 16; float sq; f32x2 sq2 = (f32x2){0.f, 0.f}; \
                _Pragma("unroll") for (int bj = 0; bj < 2; ++bj) { const size_t off = (size_t)r * D + col0 + bj * 128; const u32x4 w = xin[G][mm][bj]; \
                    const f32x4 x0 = (f32x4){bflo(w.x), bfhi(w.x), bflo(w.y), bfhi(w.y)}, x1 = (f32x4){bflo(w.z), bfhi(w.z), bflo(w.w), bfhi(w.w)}; \
                    const f32x4 v0 = x0 + acc[ai][bj][m][0] * cs, v1 = x1 + acc[ai][bj][m][1] * cs; \
                    store8(XB + off, v0, v1); \
                    if constexpr (X8OUT == 1) { u32x2 o8_; o8_.x = pk4_f8(v0.x * F8_SX, v0.y * F8_SX, v0.z * F8_SX, v0.w * F8_SX); o8_.y = pk4_f8(v1.x * F8_SX, v1.y * F8_SX, v1.z * F8_SX, v1.w * F8_SX); *(u32x2*)((unsigned char*)XB + X18_DELTA + off) = o8_; } \
                    sq2 = (f32x2){v0.x, v0.y} * (f32x2){v0.x, v0.y} + sq2; sq2 = (f32x2){v0.z, v0.w} * (f32x2){v0.z, v0.w} + sq2; \
                    sq2 = (f32x2){v1.x, v1.y} * (f32x2){v1.x, v1.y} + sq2; sq2 = (f32x2){v1.z, v1.w} * (f32x2){v1.z, v1.w} + sq2; } \
                sq = sq2.x + sq2.y; sq += __shfl_xor(sq, 16); sq += __shfl_xor(sq, 32); \
                if (fq == 0) ssq[(size_t)r * 32 + u.pn * 4 + wc] = sq; } } while (0)
            ER_LOAD(0); ER_LOAD(1); ER_LOAD(2); asm volatile("" ::: "memory");
            ER_USE(0); asm volatile("" ::: "memory"); ER_LOAD(3); asm volatile("" ::: "memory");
            ER_USE(1); ER_USE(2); ER_USE(3);
#undef ER_LOAD
#undef ER_USE
        } else {
#pragma unroll
        for (int ai = 0; ai < 2; ++ai) {
            f32x4 xin[4][2][2];
#pragma unroll
            for (int m = 0; m < 4; ++m)
#pragma unroll
                for (int bj = 0; bj < 2; ++bj) {
                    const size_t off = (size_t)(row0 + ai * 128 + m * 16) * D + col0 + bj * 128;
                    xin[m][bj][0] = *(const f32x4*)(xi + off); xin[m][bj][1] = *(const f32x4*)(xi + off + 4);
                }
            asm volatile("" ::: "memory");
#pragma unroll
            for (int m = 0; m < 4; ++m) {
                const int r = row0 + ai * 128 + m * 16; float sq = 0.f;
#pragma unroll
                for (int bj = 0; bj < 2; ++bj) {
                    const size_t off = (size_t)r * D + col0 + bj * 128;
                    const f32x4 v0 = xin[m][bj][0] + acc[ai][bj][m][0] * cs, v1 = xin[m][bj][1] + acc[ai][bj][m][1] * cs;
                    store8(XB + off, v0, v1);
                    if constexpr (X8OUT == 1) { u32x2 o; o.x = pk4_f8(v0.x * F8_SX, v0.y * F8_SX, v0.z * F8_SX, v0.w * F8_SX); o.y = pk4_f8(v1.x * F8_SX, v1.y * F8_SX, v1.z * F8_SX, v1.w * F8_SX); *(u32x2*)((unsigned char*)XB + X18_DELTA + off) = o; }
                    if constexpr (X8OUT == 2) { if (u.pn * 256 >= FGU_KB) { u32x2 o; o.x = pk4_f8(v0.x, v0.y, v0.z, v0.w); o.y = pk4_f8(v1.x, v1.y, v1.z, v1.w);
                        *(u32x2*)((unsigned char*)XB + X18_DELTA + (size_t)r * (2 * D) + 2 * FGU_KB + (col0 + bj * 128 - FGU_KB)) = o; } }
                    sq += (v0.x * v0.x + v0.y * v0.y) + (v0.z * v0.z + v0.w * v0.w) + (v1.x * v1.x + v1.y * v1.y) + (v1.z * v1.z + v1.w * v1.w);
                }
                sq += __shfl_xor(sq, 16); sq += __shfl_xor(sq, 32);
                if (fq == 0) ssq[(size_t)r * 32 + u.pn * 4 + wc] = sq;
            }
            asm volatile("" ::: "memory");
        }
        }
    }
};
template <bool MOE, bool F8OUT = MOE> struct EpiGateUp {
    const float* ssq; bf16* H; int ldh; const float* rsr; const float* gw; LAS float* rsl; float ascale;
    __device__ __forceinline__ void operator()(const f32x4 (&acc)[2][2][4][2], const Unit& u, int wr, int wc, int fr, int fq) const {
        const int rl0 = wr * 64 + fr, row0 = u.pm * 256 + rl0, col0 = u.pn * 128 + wc * 32 + 8 * fq;
        float rs8[2][4], w8[2][4];
        if (MOE) {
#pragma unroll
            for (int ai = 0; ai < 2; ++ai)
#pragma unroll
                for (int m = 0; m < 4; ++m) { rs8[ai][m] = rsr[row0 + ai * 128 + m * 16] * (1.0f / (F8_SX * F8_SW)); w8[ai][m] = gw[row0 + ai * 128 + m * 16] * F8_SH; }
        } else {
            if (u.newpm) rs_tile_to_lds(ssq, u.pm, rsl);
#pragma unroll
            for (int ai = 0; ai < 2; ++ai)
#pragma unroll
                for (int m = 0; m < 4; ++m) { rs8[ai][m] = rsl[rl0 + ai * 128 + m * 16] * ascale; w8[ai][m] = F8OUT ? F8_SH : 1.0f; }
        }
#pragma unroll
        for (int ai = 0; ai < 2; ++ai)
#pragma unroll
            for (int m = 0; m < 4; ++m) {
                const int r = row0 + ai * 128 + m * 16; const float rs = rs8[ai][m];
                const float nrs = rs * -1.44269504089f, kk = rs * rs * w8[ai][m];
                f32x4 h0, h1;
#pragma unroll
                for (int n = 0; n < 2; ++n)
#pragma unroll
                    for (int jp = 0; jp < 2; ++jp) {
                        const f32x2 g2 = (f32x2){acc[ai][0][m][n][2 * jp], acc[ai][0][m][n][2 * jp + 1]}, u2 = (f32x2){acc[ai][1][m][n][2 * jp], acc[ai][1][m][n][2 * jp + 1]};
                        const f32x2 t2 = g2 * nrs;
                        const f32x2 d2 = (f32x2){__builtin_amdgcn_exp2f(t2.x), __builtin_amdgcn_exp2f(t2.y)} + 1.0f;
                        const f32x2 r2 = (f32x2){__builtin_amdgcn_rcpf(d2.x), __builtin_amdgcn_rcpf(d2.y)};
                        const f32x2 h2 = ((g2 * u2) * kk) * r2;
                        if (n == 0) { h0[2 * jp] = h2.x; h0[2 * jp + 1] = h2.y; } else { h1[2 * jp] = h2.x; h1[2 * jp + 1] = h2.y; }
                    }
                if (F8OUT) { u32x2 o; o.x = pk4_f8(h0[0], h0[1], h0[2], h0[3]); o.y = pk4_f8(h1[0], h1[1], h1[2], h1[3]); *(u32x2*)((unsigned char*)H + (size_t)r * ldh + col0) = o; }
                else store8(H + (size_t)r * ldh + col0, h0, h1);
            }
    }
};
struct EpiOdIn {
    const float* ssq; bf16 *Gb, *XR; LAS float* rsl; float ascale;
    __device__ __forceinline__ void operator()(const f32x4 (&acc)[2][2][4][2], const Unit& u, int wr, int wc, int fr, int fq) const {
        const int rl0 = wr * 64 + fr, row0 = u.pm * 256 + rl0, cw = wc * 32 + 8 * fq;
        const bool isg = u.pn < 10; const int cb = (isg ? u.pn : u.pn - 10) * 256;
        if (u.newpm) rs_tile_to_lds(ssq, u.pm, rsl);
        float rs8[2][4];
#pragma unroll
        for (int ai = 0; ai < 2; ++ai)
#pragma unroll
            for (int m = 0; m < 4; ++m) rs8[ai][m] = rsl[rl0 + ai * 128 + m * 16] * ascale;
#pragma unroll
        for (int ai = 0; ai < 2; ++ai)
#pragma unroll
            for (int m = 0; m < 4; ++m) {
                const int r = row0 + ai * 128 + m * 16;
                const float rs = rs8[ai][m];
#pragma unroll
                for (int bj = 0; bj < 2; ++bj) {
                    f32x4 v0 = acc[ai][bj][m][0] * rs, v1 = acc[ai][bj][m][1] * rs;
                    if (isg) gelu8(v0, v1);
                    store8((isg ? Gb : XR) + (size_t)r * DRNN + cb + bj * 128 + cw, v0, v1);
                }
            }
    }
};
struct EpiGates {
    const bf16* XC; const float *b_a, *b_x, *sp8; bf16 *LA, *BT;
    __device__ __forceinline__ void operator()(const f32x4 (&acc)[2][2][4][2], const Unit& u, int wr, int wc, int fr, int fq) const {
        const int row0 = u.pm * 256 + wr * 64 + fr, ch0 = u.pn * 128 + wc * 32 + 8 * fq;
        f32x4 ba[2], bx[2], sp[2];
#pragma unroll
        for (int n = 0; n < 2; ++n) { ba[n] = *(const f32x4*)(b_a + ch0 + 4 * n); bx[n] = *(const f32x4*)(b_x + ch0 + 4 * n); sp[n] = *(const f32x4*)(sp8 + ch0 + 4 * n); }
        f32x4 nba[2], nbx[2], sp2[2];
#pragma unroll
        for (int n = 0; n < 2; ++n) { nba[n] = ba[n] * -1.44269504089f; nbx[n] = bx[n] * -1.44269504089f; sp2[n] = sp[n] * 2.0f; }
#pragma unroll
        for (int ai = 0; ai < 2; ++ai) {
            u32x4 xw[4];
#pragma unroll
            for (int m = 0; m < 4; ++m) xw[m] = *(const u32x4*)(XC + (size_t)(row0 + ai * 128 + m * 16) * DRNN + ch0);
            asm volatile("" ::: "memory");
#pragma unroll
            for (int m = 0; m < 4; ++m) {
                const size_t o = (size_t)(row0 + ai * 128 + m * 16) * DRNN + ch0;
                const float xc[8] = {bflo(xw[m].x), bfhi(xw[m].x), bflo(xw[m].y), bfhi(xw[m].y), bflo(xw[m].z), bfhi(xw[m].z), bflo(xw[m].w), bfhi(xw[m].w)};
                f32x4 la[2], bt[2];
#pragma unroll
                for (int n = 0; n < 2; ++n)
#pragma unroll
                    for (int jp = 0; jp < 2; ++jp) {
                        const f32x2 pa = (f32x2){acc[ai][0][m][n][2 * jp], acc[ai][0][m][n][2 * jp + 1]}, px = (f32x2){acc[ai][1][m][n][2 * jp], acc[ai][1][m][n][2 * jp + 1]};
                        const f32x2 ta = pa * -1.44269504089f + (f32x2){nba[n][2 * jp], nba[n][2 * jp + 1]}, tx = px * -1.44269504089f + (f32x2){nbx[n][2 * jp], nbx[n][2 * jp + 1]};
                        const f32x2 ea = (f32x2){__builtin_amdgcn_exp2f(ta.x), __builtin_amdgcn_exp2f(ta.y)} + 1.0f, ex = (f32x2){__builtin_amdgcn_exp2f(tx.x), __builtin_amdgcn_exp2f(tx.y)} + 1.0f;
                        const f32x2 rg = (f32x2){__builtin_amdgcn_rcpf(ea.x), __builtin_amdgcn_rcpf(ea.y)}, ig = (f32x2){__builtin_amdgcn_rcpf(ex.x), __builtin_amdgcn_rcpf(ex.y)};
                        const f32x2 y = rg * (f32x2){sp2[n][2 * jp], sp2[n][2 * jp + 1]};
                        f32x2 b2; const f32x2 l2 = y * (0.5f * 1.4426950408889634f);
                        if constexpr (SCAN_SQRT) b2 = ig * (f32x2){xc[4 * n + 2 * jp], xc[4 * n + 2 * jp + 1]};
                        else {
                        f32x2 t = y * (1.0f / 720.0f) + (1.0f / 120.0f); t = t * y + (1.0f / 24.0f); t = t * y + (1.0f / 6.0f); t = t * y + 0.5f; t = t * y + 1.0f;
                        f32x2 om = t * -y;
                        if (__any(fminf(y.x, y.y) < -1.0f)) { asm volatile("" ::: "memory"); om.x = (y.x < -1.0f) ? 1.0f - fast_exp(y.x) : om.x; om.y = (y.y < -1.0f) ? 1.0f - fast_exp(y.y) : om.y; }
                        const f32x2 sq = (f32x2){__builtin_amdgcn_sqrtf(fmaxf(om.x, 0.f)), __builtin_amdgcn_sqrtf(fmaxf(om.y, 0.f))};
                        b2 = (sq * ig) * (f32x2){xc[4 * n + 2 * jp], xc[4 * n + 2 * jp + 1]};
                        }
                        bt[n][2 * jp] = b2.x; bt[n][2 * jp + 1] = b2.y; la[n][2 * jp] = l2.x; la[n][2 * jp + 1] = l2.y;
                    }
                store8(LA + o, la[0], la[1]); store8(BT + o, bt[0], bt[1]);
            }
            asm volatile("" ::: "memory");
        }
    }
};
struct EpiMoeDown {
    const int* dest; bf16 *Y0, *Y1;
    __device__ __forceinline__ void operator()(const f32x4 (&acc)[2][2][4][2], const Unit& u, int wr, int wc, int fr, int fq) const {
        const int row0 = u.pm * 256 + wr * 64 + fr, col0 = u.pn * 256 + wc * 32 + 8 * fq;
        int d8[2][4];
#pragma unroll
        for (int ai = 0; ai < 2; ++ai)
#pragma unroll
            for (int m = 0; m < 4; ++m) d8[ai][m] = dest[row0 + ai * 128 + m * 16];
#pragma unroll
        for (int ai = 0; ai < 2; ++ai)
#pragma unroll
            for (int m = 0; m < 4; ++m) {
                const int d = d8[ai][m];
                if (d >= 0) {
                    bf16* yp = (d >= M) ? Y1 + (size_t)(d - M) * D : Y0 + (size_t)d * D;
#pragma unroll
                    for (int bj = 0; bj < 2; ++bj) store8(yp + col0 + bj * 128, acc[ai][bj][m][0] * (1.0f / (F8_SH * F8_SW)), acc[ai][bj][m][1] * (1.0f / (F8_SH * F8_SW)));
                }
            }
    }
};

typedef short s16x4 __attribute__((ext_vector_type(4)));
template <int OFF> __device__ __forceinline__ s16x4 tr_read(unsigned vb) { s16x4 r; asm volatile("ds_read_b64_tr_b16 %0, %1 offset:%2" : "=&v"(r) : "v"(vb), "i"(OFF) : "memory"); return r; }
template <int P>
__device__ __forceinline__ void attn_pass(const Frame& F, unsigned lds_base, const bf16* Qb, const bf16* Kb, const bf16* Vb, bf16* CAT, float* LSE, unsigned char* CAT2 = nullptr) {
    typedef pg8::bf16x8 bf16x8;
    constexpr int d = (P == 0) ? 1 : (P == 1 ? 4 : 16);
    constexpr int NBLK = 128 / d;
    constexpr int KP = 272, VP = 288, VOFF = 256 * KP;
    LAS unsigned char* Kl = F.lds; LAS unsigned char* Vl = F.lds + VOFF;
    const int w = F.wave, lane = F.lane, fr = lane & 15, fq = lane >> 4;
    const unsigned vb = lds_base + VOFF + (unsigned)((16 * w + 4 * fq + ((lane & 15) >> 2)) * VP + (lane & 3) * 8);
    constexpr int NU = 2 * 12 * 128;
    u32x4 kreg[8], vreg[8];
#define ATT_FETCH(UU) do { const int bh_ = (UU) >> 7, rem_ = (UU) & 127; const int b_ = bh_ / 12, h_ = bh_ - b_ * 12; const int r_ = rem_ / NBLK, l0_ = (rem_ - r_ * NBLK) * 128; \
        const size_t rb_ = (size_t)b_ * S + r_; \
        _Pragma("unroll") for (int j = 0; j < 8; ++j) { const int pc = F.tid + NTHR * j, wi = pc >> 4, piece = pc & 15, lw = l0_ - 128 + wi; \
            kreg[j] = (u32x4){0u, 0u, 0u, 0u}; vreg[j] = (u32x4){0u, 0u, 0u, 0u}; \
            if (lw >= 0) { const size_t o = (rb_ + (size_t)lw * d) * DB + h_ * 128 + piece * 8; kreg[j] = *(const u32x4*)(Kb + o); vreg[j] = *(const u32x4*)(Vb + o); } } } while (0)
    if (F.bid < NU) ATT_FETCH(F.bid);
    for (int u = F.bid; u < NU; u += F.G) {
        const int bh = u >> 7, rem = u & 127; const int b = bh / 12, h = bh - b * 12; const int r = rem / NBLK, blk = rem - r * NBLK; const int l0 = blk * 128;
        const size_t rowbase = (size_t)b * S + r;
        const int lq = l0 + 16 * w + fr;
        const size_t qrow = rowbase + (size_t)lq * d;
        bf16x8 qf[4];
        { const bf16* qp = Qb + qrow * DB + h * 128 + 8 * fq;
#pragma unroll
          for (int kk = 0; kk < 4; ++kk) qf[kk] = *(const bf16x8*)(qp + 32 * kk); }
        bf16* op = CAT + qrow * D + DA + h * 128 + 4 * fq; float* lp = LSE + qrow * 12 + h;
        u32x2 pvo[8]; float lse1 = 0.f;
        if (P != 0) {
#pragma unroll
            for (int dt = 0; dt < 8; ++dt) pvo[dt] = *(const u32x2*)(op + 16 * dt);
            lse1 = *lp;
        }
        __syncthreads();
#pragma unroll
        for (int j = 0; j < 8; ++j) { const int pc = F.tid + NTHR * j, wi = pc >> 4, piece = pc & 15;
            *(LAS u32x4*)(Kl + wi * KP + piece * 16) = kreg[j]; *(LAS u32x4*)(Vl + wi * VP + piece * 16) = vreg[j]; }
        if (u + F.G < NU) ATT_FETCH(u + F.G);
        __syncthreads();
        f32x4 sacc[9];
        const LAS unsigned char* kb = Kl + (16 * w + fr) * KP + fq * 16;
#pragma unroll
        for (int t = 0; t < 9; ++t) { sacc[t] = (f32x4){0.f, 0.f, 0.f, 0.f};
#pragma unroll
            for (int kk = 0; kk < 4; ++kk) { const bf16x8 kf = *(const LAS bf16x8*)(kb + t * 16 * KP + kk * 64); sacc[t] = __builtin_amdgcn_mfma_f32_16x16x32_bf16(kf, qf[kk], sacc[t], 0, 0, 0); } }
#pragma unroll
        for (int i = 0; i < 4; ++i) { if (fr > 4 * fq + i) sacc[0][i] = -INFINITY; if (fr < 4 * fq + i) sacc[8][i] = -INFINITY; }
        if (l0 == 0) {
#pragma unroll
            for (int t = 0; t < 8; ++t)
#pragma unroll
                for (int i = 0; i < 4; ++i) if (16 * w + 16 * t + 4 * fq + i < 128) sacc[t][i] = -INFINITY;
        }
        float mx = -INFINITY;
#pragma unroll
        for (int t = 0; t < 9; ++t)
#pragma unroll
            for (int i = 0; i < 4; ++i) mx = fmaxf(mx, sacc[t][i]);
        mx = fmaxf(mx, __shfl_xor(mx, 16)); mx = fmaxf(mx, __shfl_xor(mx, 32));
        float l = 0.f;
#pragma unroll
        for (int t = 0; t < 9; ++t)
#pragma unroll
            for (int i = 0; i < 4; ++i) { const float pv = __builtin_amdgcn_exp2f(sacc[t][i] - mx); sacc[t][i] = pv; l += pv; }
        l += __shfl_xor(l, 16); l += __shfl_xor(l, 32);
        f32x4 oacc[8];
#pragma unroll
        for (int dt = 0; dt < 8; ++dt) oacc[dt] = (f32x4){0.f, 0.f, 0.f, 0.f};
#define ATT_PV(T0, T1, HAS1) do { \
            bf16x8 pk; { const unsigned a0 = pk2(sacc[T0][0], sacc[T0][1]), a1 = pk2(sacc[T0][2], sacc[T0][3]); \
                unsigned b0 = 0u, b1 = 0u; if (HAS1) { b0 = pk2(sacc[(HAS1) ? (T1) : 0][0], sacc[(HAS1) ? (T1) : 0][1]); b1 = pk2(sacc[(HAS1) ? (T1) : 0][2], sacc[(HAS1) ? (T1) : 0][3]); } \
                const u32x4 pw = (u32x4){a0, a1, b0, b1}; pk = __builtin_bit_cast(bf16x8, pw); } \
            s16x4 va[8], vc[8]; \
            va[0] = tr_read<(T0) * 16 * VP + 0 * 32>(vb); vc[0] = tr_read<((HAS1) ? (T1) : (T0)) * 16 * VP + 0 * 32>(vb); \
            va[1] = tr_read<(T0) * 16 * VP + 1 * 32>(vb); vc[1] = tr_read<((HAS1) ? (T1) : (T0)) * 16 * VP + 1 * 32>(vb); \
            va[2] = tr_read<(T0) * 16 * VP + 2 * 32>(vb); vc[2] = tr_read<((HAS1) ? (T1) : (T0)) * 16 * VP + 2 * 32>(vb); \
            va[3] = tr_read<(T0) * 16 * VP + 3 * 32>(vb); vc[3] = tr_read<((HAS1) ? (T1) : (T0)) * 16 * VP + 3 * 32>(vb); \
            va[4] = tr_read<(T0) * 16 * VP + 4 * 32>(vb); vc[4] = tr_read<((HAS1) ? (T1) : (T0)) * 16 * VP + 4 * 32>(vb); \
            va[5] = tr_read<(T0) * 16 * VP + 5 * 32>(vb); vc[5] = tr_read<((HAS1) ? (T1) : (T0)) * 16 * VP + 5 * 32>(vb); \
            va[6] = tr_read<(T0) * 16 * VP + 6 * 32>(vb); vc[6] = tr_read<((HAS1) ? (T1) : (T0)) * 16 * VP + 6 * 32>(vb); \
            va[7] = tr_read<(T0) * 16 * VP + 7 * 32>(vb); vc[7] = tr_read<((HAS1) ? (T1) : (T0)) * 16 * VP + 7 * 32>(vb); \
            asm volatile("s_waitcnt lgkmcnt(0)" ::: "memory"); __builtin_amdgcn_sched_barrier(0); \
            _Pragma("unroll") for (int dt = 0; dt < 8; ++dt) { const bf16x8 vf = (bf16x8){va[dt][0], va[dt][1], va[dt][2], va[dt][3], vc[dt][0], vc[dt][1], vc[dt][2], vc[dt][3]}; \
                oacc[dt] = __builtin_amdgcn_mfma_f32_16x16x32_bf16(vf, pk, oacc[dt], 0, 0, 0); } \
            __builtin_amdgcn_sched_barrier(0); } while (0)
        ATT_PV(0, 1, 1); ATT_PV(2, 3, 1); ATT_PV(4, 5, 1); ATT_PV(6, 7, 1); ATT_PV(8, 8, 0);
#undef ATT_PV
        const float inv = 1.0f / l; const float lse2 = mx + __builtin_amdgcn_logf(l);
        if (P == 0) {
#pragma unroll
            for (int dt = 0; dt < 8; ++dt) { u32x2 o; o.x = pk2(oacc[dt][0] * inv, oacc[dt][1] * inv); o.y = pk2(oacc[dt][2] * inv, oacc[dt][3] * inv); *(u32x2*)(op + 16 * dt) = o; }
            if (fq == 0) *lp = lse2;
        } else {
            const float mn = fmaxf(lse1, lse2); const float w1 = __builtin_amdgcn_exp2f(lse1 - mn), w2 = __builtin_amdgcn_exp2f(lse2 - mn);
            const float wsum = w1 + w2; const float a1 = w1 / wsum, a2 = (w2 / wsum) * inv;
            if (P == 2 && EVOUT_MIXED) {
                unsigned char* o8 = CAT2 + qrow * C2P + 2 * DA + h * 128 + 4 * fq; const float b1 = a1 * F8_SX, b2 = a2 * F8_SX;
#pragma unroll
                for (int dt = 0; dt < 8; ++dt) { const u32x2 pv = pvo[dt];
                    *(unsigned*)(o8 + 16 * dt) = pk4_f8(b1 * bflo(pv.x) + b2 * oacc[dt][0], b1 * bfhi(pv.x) + b2 * oacc[dt][1], b1 * bflo(pv.y) + b2 * oacc[dt][2], b1 * bfhi(pv.y) + b2 * oacc[dt][3]); }
            } else {
#pragma unroll
            for (int dt = 0; dt < 8; ++dt) { const u32x2 pv = pvo[dt];
                u32x2 o; o.x = pk2(a1 * bflo(pv.x) + a2 * oacc[dt][0], a1 * bfhi(pv.x) + a2 * oacc[dt][1]); o.y = pk2(a1 * bflo(pv.y) + a2 * oacc[dt][2], a1 * bfhi(pv.y) + a2 * oacc[dt][3]); *(u32x2*)(op + 16 * dt) = o; }
            if (fq == 0) *lp = mn + __builtin_amdgcn_logf(wsum);
            }
        }
    }
#undef ATT_FETCH
    __syncthreads();
}

struct Args { const float* in[28]; float* out; unsigned char* ws; int ph_lo, ph_hi, li, noepi; };
enum { I_X = 0, I_EV_NORM_MIX, I_EV_W_IN, I_EV_LN_G, I_EV_LN_B, I_EV_W_S, I_EV_B_S, I_EV_W_OUT, I_EV_NORM_FFN, I_EV_FFN_GATE, I_EV_FFN_UP, I_EV_FFN_DOWN,
       I_OD_NORM_MIX, I_OD_W_IN, I_OD_CONV_W, I_OD_CONV_B, I_OD_W_A, I_OD_B_A, I_OD_W_X, I_OD_B_X, I_OD_LAM, I_OD_W_OUT, I_OD_NORM_FFN, I_OD_ROUTER,
       I_OD_EXP_GATE, I_OD_EXP_UP, I_OD_EXP_DOWN, I_FINAL_NORM };
constexpr int N_PHASES = 20;

#ifndef PROBE_ID
#define PROBE_ID (-1)
#define PROBE_IDX 0
#define PROBE_DIV 1.0e6f
#endif
#define PROBE_PTR(id) ((PROBE_ID == (id)) ? (unsigned long long*)(ws + WS_CTL) + 512 : (unsigned long long*)nullptr)
#ifndef MFMA_MASK
#define MFMA_MASK 0x1ff
#endif
static_assert(((MFMA_MASK >> 7) & 3) == 3, "the MoE expert GEMMs are fp8: MFMA path only");
static_assert(!(FFN_GU_FP8 || FFN_GU_MIX) || EVOUT_MIXED, "the e4m3 copy of x1 overlays CAT: the out-projection must read CAT2");
template <int ID, class Epi, bool FP8 = false, int F8FROM = 0>
__device__ __forceinline__ void dense_gemm_phase(const Frame& F, const bf16* A, int lda, const bf16* Bt, int ldb, int K, int ncol, int nunits, const Epi& E, unsigned long long* probe = nullptr, const int noepi = 0, const long adelta = 0) {
    if constexpr ((MFMA_MASK >> ID) & 1) {
        pg8::SchedDense S; S.so.init(nunits / ncol, ncol, F.G, F.bid); S.A = (const char*)A; S.B = (const char*)Bt; S.tstepA = (size_t)256 * lda * 2; S.tstepB = (size_t)256 * ldb * 2; S.acol_shift = -1; S.acol_bytes = 0; S.tok = nullptr;
        pg8::gemm_phase<Epi, pg8::SchedDense, false, true, FP8, F8FROM>(F.lds, S, E, K, lda, ldb, probe, noepi, adelta);
    } else {
        const int wr = F.wave >> 2, wc = F.wave & 3, fr = F.lane & 15, fq = F.lane >> 4;
        ARowDense ar{A, lda};
        for (int i = F.bid; i < nunits; i += F.G) { Unit u; u.pm = i / ncol; u.pn = i % ncol; u.newpm = 1; naive_gemm_unit(ar, Bt + (size_t)u.pn * 256 * ldb, ldb, K, u, E, wr, wc, fr, fq); }
    }
}

__global__ void __launch_bounds__(NTHR, 2) fwd(Args args) {
    extern __shared__ __attribute__((aligned(16))) unsigned char lds_raw[];
    const unsigned lds_base = (unsigned)(uintptr_t)lds_raw;
    Frame F; F.lds = (LAS unsigned char*)lds_raw; F.tid = threadIdx.x; F.lane = F.tid & 63; F.wave = __builtin_amdgcn_readfirstlane(F.tid >> 6); F.bid = blockIdx.x; F.G = gridDim.x;
    unsigned char* ws = args.ws;
    const int lo = args.ph_lo, hi = args.ph_hi;
#define IN(k) (lo <= (k) && (k) < hi)
#define SEAM(k) do { if (IN(k) && IN((k) + 1)) xcd_barrier(bar); } while (0)
#ifndef REPEAT_MASK
#define REPEAT_NOEPI 0
#define REPEAT_MASK 0
#endif
#define PHASE(k) if (IN(k) && frame_refresh(F, gw, gt))
    for (int u = F.tid; u < (LDS_BYTES - LDSCTL_OFF) / 4; u += NTHR) ((LAS unsigned*)(F.lds + LDSCTL_OFF))[u] = 0u;
    __syncthreads();
    XcdBarrier bar = xcd_barrier_post((unsigned*)(ws + WS_CTL) + CW_BAR + args.li * XCD_BAR_WORDS, (volatile LAS unsigned*)(F.lds + LDSCTL_OFF));
    int gw = F.bid * NWAVES + F.wave; const int NGW = F.G * NWAVES;
    int gt = F.bid * NTHR + F.tid; const int NGT = F.G * NTHR;
    float* const xres = args.out;
    bf16* const XB = (bf16*)(ws + WS_XB);
    float* const SSQ0 = (float*)(ws + WS_SSQ0); float* const SSQ1 = (float*)(ws + WS_SSQ1); float* const SSQ2 = (float*)(ws + WS_SSQ2); float* const SSQ3 = (float*)(ws + WS_SSQ3);

    PHASE(0) {
        LAS float* scr = (LAS float*)(F.lds + F.wave * 16640);
        constexpr int I0 = 32 * 88, I1 = 32 * 32, I2 = 32 * 88, I3 = 88 * 32, I4 = 32 * 80, I5 = 4 * 4, I6 = 40 * 32, I7 = 32 * 44, I8 = 44 * 32;
        constexpr int NITEMS = I0 + I1 + 2 * I2 + I3 + I4 + 20 * I5 + I6 + 16 * I7 + 8 * I8;
        for (int it = gw; it < NITEMS; it += NGW) {
            int r = it; MapV mp;
            if (r < I0) { mp = MapV{args.in[I_EV_W_IN], args.in[I_EV_NORM_MIX], (bf16*)(ws + WS_W_EVIN), D, NIN0, 2, 0, 0.f}; }
            else if ((r -= I0) < I1) {
                if (!EVOUT_MIXED) mp = MapV{args.in[I_EV_W_OUT], nullptr, (bf16*)(ws + WS_W_EVOUT), D, D, 0, 0, 0.f};
                else if (r < (DA / 64) * (D / 64)) mp = MapV{args.in[I_EV_W_OUT], nullptr, (bf16*)(ws + WS_W_EVOUT), C2P / 2, D, 0, 0, 0.f, F8_SW};
                else { r -= (DA / 64) * (D / 64); mp = MapV{args.in[I_EV_W_OUT] + (size_t)DA * D, nullptr, (bf16*)(ws + WS_W_EVOUT + 2 * DA), C2P, D, 0, 0, F8_SW}; }
            }
            else if ((r -= I1) < 2 * I2) { const int hf = r >= I2; r -= hf * I2; const float* Wg = hf ? args.in[I_EV_FFN_UP] : args.in[I_EV_FFN_GATE];
                if (!FFN_GU_MIX) mp = MapV{Wg, args.in[I_EV_NORM_FFN], (bf16*)(ws + WS_W_FGU), D, DFF, 1, hf, FFN_GU_FP8 ? F8_SW : 0.f};
                else if (r < (FGU_KB / 64) * (DFF / 64)) mp = MapV{Wg, args.in[I_EV_NORM_FFN], (bf16*)(ws + WS_W_FGU), FGU_P / 2, DFF, 1, hf, 0.f, F8_SW};
                else { r -= (FGU_KB / 64) * (DFF / 64); mp = MapV{Wg + (size_t)FGU_KB * DFF, args.in[I_EV_NORM_FFN] + FGU_KB, (bf16*)(ws + WS_W_FGU + 2 * FGU_KB), FGU_P, DFF, 1, hf, F8_SW}; }
            }
            else if ((r -= 2 * I2) < I3) { mp = MapV{args.in[I_EV_FFN_DOWN], nullptr, (bf16*)(ws + WS_W_FDN), DFF, D, 0, 0, FFN_DOWN_FP8 ? F8_SW : 0.f}; }
            else if ((r -= I3) < I4) { mp = MapV{args.in[I_OD_W_IN], args.in[I_OD_NORM_MIX], (bf16*)(ws + WS_W_ODIN), D, 2 * DRNN, 0, 0, OD_IN_FP8 ? F8_SW : 0.f}; }
            else if ((r -= I4) < 10 * I5) { const int n = r / I5; r -= n * I5; mp = MapV{args.in[I_OD_W_A] + (size_t)n * 65536, nullptr, (bf16*)(ws + WS_W_AX) + (size_t)n * 512 * 256, 256, 256, 1, 0, 0.f}; }
            else if ((r -= 10 * I5) < 10 * I5) { const int n = r / I5; r -= n * I5; mp = MapV{args.in[I_OD_W_X] + (size_t)n * 65536, nullptr, (bf16*)(ws + WS_W_AX) + (size_t)n * 512 * 256, 256, 256, 1, 1, 0.f}; }
            else if ((r -= 10 * I5) < I6) { mp = MapV{args.in[I_OD_W_OUT], nullptr, (bf16*)(ws + WS_W_ODOUT), DRNN, D, 0, 0, 0.f}; }
            else if ((r -= I6) < 8 * I7) { const int e = r / I7; r -= e * I7; mp = MapV{args.in[I_OD_EXP_GATE] + (size_t)e * D * DFE, args.in[I_OD_NORM_FFN], (bf16*)(ws + WS_W_EGU + (size_t)e * 2 * DFE * D), D, DFE, 1, 0, F8_SW}; }
            else if ((r -= 8 * I7) < 8 * I7) { const int e = r / I7; r -= e * I7; mp = MapV{args.in[I_OD_EXP_UP] + (size_t)e * D * DFE, args.in[I_OD_NORM_FFN], (bf16*)(ws + WS_W_EGU + (size_t)e * 2 * DFE * D), D, DFE, 1, 1, F8_SW}; }
            else { r -= 8 * I7; const int e = r / I8; r -= e * I8; mp = MapV{args.in[I_OD_EXP_DOWN] + (size_t)e * DFE * D, nullptr, (bf16*)(ws + WS_W_EDN + (size_t)e * D * DFE), DFE, D, 0, 0, F8_SW}; }
            cvt_item64(mp, r, scr, F.lane);
        }
        { const float* Ws = args.in[I_EV_W_S]; bf16* WSM = (bf16*)(ws + WS_WSM);
          for (int i = gt; i < 4 * 128 * 128; i += NGT) { const int t = (i >> 7) & 127, sidx = i & 127; WSM[i] = (bf16)f2bf(sidx <= t ? Ws[i] : 0.f); } }
        for (int c = gt; c < DRNN; c += NGT) ((float*)(ws + WS_SP8))[c] = -8.0f * log1pf(expf(-args.in[I_OD_LAM][c]));
        const float* x = args.in[I_X];
        for (int m = gw; m < M; m += NGW) {
            const f32x4* xr = (const f32x4*)(x + (size_t)m * D) + F.lane; u32x2* o8 = (u32x2*)(XB + (size_t)m * D) + F.lane; float s = 0.f;
#pragma unroll
            for (int j = 0; j < 8; ++j) { const f32x4 v = xr[64 * j]; s += (v.x * v.x + v.y * v.y) + (v.z * v.z + v.w * v.w); u32x2 w; w.x = pk2(v.x, v.y); w.y = pk2(v.z, v.w); o8[64 * j] = w;
                if (EVIN_QKV_FP8) *((unsigned*)((unsigned char*)args.out + (size_t)m * D) + F.lane + 64 * j) = pk4_f8(v.x * F8_SX, v.y * F8_SX, v.z * F8_SX, v.w * F8_SX); }
            s = wave_sum(s); if (F.lane == 0) SSQ0[m] = s;
        }
    }
    SEAM(0);
    PHASE(1) {
        if constexpr (EVIN_QKV_FP8) {
            EpiEvIn E1{SSQ0, (bf16*)(ws + WS_U), (bf16*)(ws + WS_VA), (bf16*)(ws + WS_Q), (bf16*)(ws + WS_K), (bf16*)(ws + WS_V), 0, 1.0f};
            dense_gemm_phase<0>(F, XB, D, (const bf16*)(ws + WS_W_EVIN), D, D, 4, (M / 256) * 4, E1, PROBE_PTR(0), (REPEAT_NOEPI ? args.noepi : 0));
            EpiEvIn E2{SSQ0, (bf16*)(ws + WS_U), (bf16*)(ws + WS_VA), (bf16*)(ws + WS_Q), (bf16*)(ws + WS_K), (bf16*)(ws + WS_V), 4, 1.0f / (F8_SX * F8_SW)};
            dense_gemm_phase<0, EpiEvIn, true>(F, (const bf16*)args.out, D / 2, (const bf16*)(ws + WS_W_EVIN + EVIN8_OFF), D / 2, D / 2, 18, (M / 256) * 18, E2, nullptr, (REPEAT_NOEPI ? args.noepi : 0));
        } else {
            EpiEvIn E{SSQ0, (bf16*)(ws + WS_U), (bf16*)(ws + WS_VA), (bf16*)(ws + WS_Q), (bf16*)(ws + WS_K), (bf16*)(ws + WS_V), 0, 1.0f};
            dense_gemm_phase<0>(F, XB, D, (const bf16*)(ws + WS_W_EVIN), D, D, NIN0 / 256, (M / 256) * (NIN0 / 256), E, PROBE_PTR(0), (REPEAT_NOEPI ? args.noepi : 0));
        }
    }
    SEAM(1);
    PHASE(2) {
        const bf16* U = (const bf16*)(ws + WS_U); const bf16* VA = (const bf16*)(ws + WS_VA); bf16* CAT = (bf16*)(ws + WS_CAT);
        const float* ln_g = args.in[I_EV_LN_G]; const float* ln_b = args.in[I_EV_LN_B]; const float* bs = args.in[I_EV_B_S]; const bf16* WSM = (const bf16*)(ws + WS_WSM);
        typedef pg8::bf16x8 bf16x8;
        constexpr int WP = 272, VP = 288, WOFF = 1024, VOFF2 = WOFF + 128 * WP;
        LAS float* stats = (LAS float*)F.lds;
        LAS unsigned char* Wl = F.lds + WOFF; LAS unsigned char* Vl = F.lds + VOFF2;
        const int fr = F.lane & 15, fq = F.lane >> 4;
        const unsigned vbg = lds_base + VOFF2 + (unsigned)((8 * fq + ((F.lane & 15) >> 2)) * VP + (16 * F.wave + 4 * (F.lane & 3)) * 2);
        for (int c = F.bid; c < M / 128; c += F.G) {
            const int r0 = c * 128;
            __syncthreads();
            for (int rr = 0; rr < 16; ++rr) {
                const int sr = F.wave * 16 + rr; const u32x4 w = *(const u32x4*)(VA + (size_t)(r0 + sr) * DA + 8 * F.lane);
                const float v[8] = {bflo(w.x), bfhi(w.x), bflo(w.y), bfhi(w.y), bflo(w.z), bfhi(w.z), bflo(w.w), bfhi(w.w)};
                float sm = 0.f;
#pragma unroll
                for (int i = 0; i < 8; ++i) sm += v[i];
                const float mean = wave_sum(sm) * (1.0f / DA); float q = 0.f;
#pragma unroll
                for (int i = 0; i < 8; ++i) { const float dd = v[i] - mean; q += dd * dd; }
                const float var = wave_sum(q) * (1.0f / DA);
                if (F.lane == 0) { stats[2 * sr] = mean; stats[2 * sr + 1] = 1.0f / sqrtf(var + LN_EPS); }
            }
            __syncthreads();
            for (int g = 0; g < 4; ++g) {
#pragma unroll
                for (int j = 0; j < 4; ++j) { const int pc = F.tid + NTHR * j, t = pc >> 4, piece = pc & 15;
                    *(LAS u32x4*)(Wl + t * WP + piece * 16) = *(const u32x4*)(WSM + (size_t)(g * 128 + t) * 128 + piece * 8); }
                { const int sr = F.tid >> 2, cq = (F.tid & 3) * 32; const float mean = stats[2 * sr], rstd = stats[2 * sr + 1];
#pragma unroll
                  for (int i4 = 0; i4 < 4; ++i4) { const int col = g * 128 + cq + 8 * i4; const u32x4 w = *(const u32x4*)(VA + (size_t)(r0 + sr) * DA + col);
                      const float v[8] = {bflo(w.x), bfhi(w.x), bflo(w.y), bfhi(w.y), bflo(w.z), bfhi(w.z), bflo(w.w), bfhi(w.w)};
                      const f32x4 g0 = *(const f32x4*)(ln_g + col), g1 = *(const f32x4*)(ln_g + col + 4), b0 = *(const f32x4*)(ln_b + col), b1 = *(const f32x4*)(ln_b + col + 4);
                      u32x4 o; o.x = pk2((v[0] - mean) * rstd * g0.x + b0.x, (v[1] - mean) * rstd * g0.y + b0.y); o.y = pk2((v[2] - mean) * rstd * g0.z + b0.z, (v[3] - mean) * rstd * g0.w + b0.w);
                      o.z = pk2((v[4] - mean) * rstd * g1.x + b1.x, (v[5] - mean) * rstd * g1.y + b1.y); o.w = pk2((v[6] - mean) * rstd * g1.z + b1.z, (v[7] - mean) * rstd * g1.w + b1.w);
                      *(LAS u32x4*)(Vl + sr * VP + (cq + 8 * i4) * 2) = o; } }
                __syncthreads();
                bf16x8 xf[4];
                { s16x4 a0 = tr_read<(0 * 32 + 0) * VP>(vbg), a1 = tr_read<(0 * 32 + 4) * VP>(vbg), b0 = tr_read<(1 * 32 + 0) * VP>(vbg), b1 = tr_read<(1 * 32 + 4) * VP>(vbg);
                  s16x4 c0 = tr_read<(2 * 32 + 0) * VP>(vbg), c1 = tr_read<(2 * 32 + 4) * VP>(vbg), d0 = tr_read<(3 * 32 + 0) * VP>(vbg), d1 = tr_read<(3 * 32 + 4) * VP>(vbg);
                  asm volatile("s_waitcnt lgkmcnt(0)" ::: "memory"); __builtin_amdgcn_sched_barrier(0);
                  xf[0] = (bf16x8){a0[0], a0[1], a0[2], a0[3], a1[0], a1[1], a1[2], a1[3]}; xf[1] = (bf16x8){b0[0], b0[1], b0[2], b0[3], b1[0], b1[1], b1[2], b1[3]};
                  xf[2] = (bf16x8){c0[0], c0[1], c0[2], c0[3], c1[0], c1[1], c1[2], c1[3]}; xf[3] = (bf16x8){d0[0], d0[1], d0[2], d0[3], d1[0], d1[1], d1[2], d1[3]}; }
                const LAS unsigned char* wb = Wl + fr * WP + fq * 16;
#pragma unroll
                for (int tt = 0; tt < 8; ++tt) {
                    f32x4 a = (f32x4){0.f, 0.f, 0.f, 0.f};
#pragma unroll
                    for (int ks = 0; ks < (tt >> 1) + 1; ++ks) { const bf16x8 yf = *(const LAS bf16x8*)(wb + tt * 16 * WP + ks * 64); a = __builtin_amdgcn_mfma_f32_16x16x32_bf16(xf[ks], yf, a, 0, 0, 0); }
                    const int t = 16 * tt + fr; const int col = g * 128 + 16 * F.wave + 4 * fq; const float bias = bs[g * 128 + t];
                    const u32x2 uw = *(const u32x2*)(U + (size_t)(r0 + t) * DA + col);
                    u32x2 o;
                    if (EVOUT_MIXED) { o.x = pk2(bflo(uw.x) * (a[0] + bias) * F8_SX, bfhi(uw.x) * (a[1] + bias) * F8_SX); o.y = pk2(bflo(uw.y) * (a[2] + bias) * F8_SX, bfhi(uw.y) * (a[3] + bias) * F8_SX);
                        *(u32x2*)((unsigned char*)args.out + (size_t)(r0 + t) * C2P + col * 2) = o; }
                    else { o.x = pk2(bflo(uw.x) * (a[0] + bias), bfhi(uw.x) * (a[1] + bias)); o.y = pk2(bflo(uw.y) * (a[2] + bias), bfhi(uw.y) * (a[3] + bias));
                        *(u32x2*)(CAT + (size_t)(r0 + t) * D + col) = o; }
                }
                __syncthreads();
            }
        }
        __syncthreads();
        attn_pass<0>(F, lds_base, (const bf16*)(ws + WS_Q), (const bf16*)(ws + WS_K), (const bf16*)(ws + WS_V), CAT, (float*)(ws + WS_LSE));
    }
    SEAM(2);
    PHASE(3) attn_pass<1>(F, lds_base, (const bf16*)(ws + WS_Q), (const bf16*)(ws + WS_K), (const bf16*)(ws + WS_V), (bf16*)(ws + WS_CAT), (float*)(ws + WS_LSE));
    SEAM(3);
    PHASE(4) attn_pass<2>(F, lds_base, (const bf16*)(ws + WS_Q), (const bf16*)(ws + WS_K), (const bf16*)(ws + WS_V), (bf16*)(ws + WS_CAT), (float*)(ws + WS_LSE), (unsigned char*)args.out);
    SEAM(4);
    PHASE(5) {
        EpiResid<true, (FFN_GU_MIX ? 2 : (FFN_GU_FP8 ? 1 : 0))> E{args.in[I_X], XB, SSQ1, EVOUT_MIXED ? 1.0f / (F8_SX * F8_SW) : 1.0f};
        if constexpr (EVOUT_MIXED) dense_gemm_phase<1, EpiResid<true, (FFN_GU_MIX ? 2 : (FFN_GU_FP8 ? 1 : 0))>, true, 2 * DA / 128>(F, (const bf16*)args.out, C2P / 2, (const bf16*)(ws + WS_W_EVOUT), C2P / 2, C2P / 2, D / 256, (M / 256) * (D / 256), E, PROBE_PTR(1), (REPEAT_NOEPI ? args.noepi : 0));
        else dense_gemm_phase<1>(F, (const bf16*)(ws + WS_CAT), D, (const bf16*)(ws + WS_W_EVOUT), D, D, D / 256, (M / 256) * (D / 256), E, PROBE_PTR(1), (REPEAT_NOEPI ? args.noepi : 0));
    }
    SEAM(5);
    PHASE(6) {
        EpiGateUp<false, FFN_DOWN_FP8 != 0> E{SSQ1, (bf16*)(ws + WS_H), DFF, nullptr, nullptr, (LAS float*)(F.lds + 131072), FFN_GU_MIX ? 1.0f / F8_SW : (FFN_GU_FP8 ? 1.0f / (F8_SX * F8_SW) : 1.0f)};
        if constexpr (FFN_GU_MIX) dense_gemm_phase<2, EpiGateUp<false, FFN_DOWN_FP8 != 0>, true, 2 * FGU_KB / 128>(F, XB, D, (const bf16*)(ws + WS_W_FGU), FGU_P / 2, FGU_P / 2, 2 * DFF / 256, (M / 256) * (2 * DFF / 256), E, PROBE_PTR(2), (REPEAT_NOEPI ? args.noepi : 0), X18_DELTA);
        else if constexpr (FFN_GU_FP8) dense_gemm_phase<2, EpiGateUp<false, FFN_DOWN_FP8 != 0>, true>(F, (const bf16*)(ws + WS_X18), D / 2, (const bf16*)(ws + WS_W_FGU), D / 2, D / 2, 2 * DFF / 256, (M / 256) * (2 * DFF / 256), E, PROBE_PTR(2), (REPEAT_NOEPI ? args.noepi : 0));
        else dense_gemm_phase<2>(F, XB, D, (const bf16*)(ws + WS_W_FGU), D, D, 2 * DFF / 256, (M / 256) * (2 * DFF / 256), E, PROBE_PTR(2), (REPEAT_NOEPI ? args.noepi : 0));
    }
    SEAM(6);
    PHASE(7) {
        EpiResid<false, (OD_IN_FP8 ? 1 : 0)> E{nullptr, XB, SSQ2, FFN_DOWN_FP8 ? 1.0f / (F8_SH * F8_SW) : 1.0f};
        if constexpr (FFN_DOWN_FP8) dense_gemm_phase<3, EpiResid<false, (OD_IN_FP8 ? 1 : 0)>, true>(F, (const bf16*)(ws + WS_H), DFF / 2, (const bf16*)(ws + WS_W_FDN), DFF / 2, DFF / 2, D / 256, (M / 256) * (D / 256), E, PROBE_PTR(3), (REPEAT_NOEPI ? args.noepi : 0));
        else dense_gemm_phase<3>(F, (const bf16*)(ws + WS_H), DFF, (const bf16*)(ws + WS_W_FDN), DFF, DFF, D / 256, (M / 256) * (D / 256), E, PROBE_PTR(3), (REPEAT_NOEPI ? args.noepi : 0));
    }
    SEAM(7);
    PHASE(8) {
        EpiOdIn E{SSQ2, (bf16*)(ws + WS_G), (bf16*)(ws + WS_XR), (LAS float*)(F.lds + 131072), OD_IN_FP8 ? 1.0f / (F8_SX * F8_SW) : 1.0f};
        if constexpr (OD_IN_FP8) dense_gemm_phase<4, EpiOdIn, true>(F, (const bf16*)(ws + WS_X18), D / 2, (const bf16*)(ws + WS_W_ODIN), D / 2, D / 2, 2 * DRNN / 256, (M / 256) * (2 * DRNN / 256), E, PROBE_PTR(4), (REPEAT_NOEPI ? args.noepi : 0));
        else dense_gemm_phase<4>(F, XB, D, (const bf16*)(ws + WS_W_ODIN), D, D, 2 * DRNN / 256, (M / 256) * (2 * DRNN / 256), E, PROBE_PTR(4), (REPEAT_NOEPI ? args.noepi : 0));
    }
    SEAM(8);
    PHASE(9) {
        const bf16* XR = (const bf16*)(ws + WS_XR); bf16* XC = (bf16*)(ws + WS_XC); const float* cw = args.in[I_OD_CONV_W]; const float* cb = args.in[I_OD_CONV_B];
        for (int it = gt; it < (M / 16) * (DRNN / 8); it += NGT) {
            const int rb = it / (DRNN / 8), cg = it - rb * (DRNN / 8), ch = cg * 8, r0 = rb * 16;
            f32x4 w[4][2], bias[2];
#pragma unroll
            for (int tap = 0; tap < 4; ++tap) { w[tap][0] = *(const f32x4*)(cw + tap * DRNN + ch); w[tap][1] = *(const f32x4*)(cw + tap * DRNN + ch + 4); }
            bias[0] = *(const f32x4*)(cb + ch); bias[1] = *(const f32x4*)(cb + ch + 4);
            const bf16* xp = XR + (size_t)r0 * DRNN + ch; bf16* op = XC + (size_t)r0 * DRNN + ch;
            u32x4 h1 = (u32x4){0u, 0u, 0u, 0u}, h2 = h1, h3 = h1;
            if ((r0 & (S - 1)) != 0) { h1 = *(const u32x4*)(xp - DRNN); h2 = *(const u32x4*)(xp - 2 * DRNN); h3 = *(const u32x4*)(xp - 3 * DRNN); }
            f32x4 x1[2] = {(f32x4){bflo(h1.x), bfhi(h1.x), bflo(h1.y), bfhi(h1.y)}, (f32x4){bflo(h1.z), bfhi(h1.z), bflo(h1.w), bfhi(h1.w)}};
            f32x4 x2[2] = {(f32x4){bflo(h2.x), bfhi(h2.x), bflo(h2.y), bfhi(h2.y)}, (f32x4){bflo(h2.z), bfhi(h2.z), bflo(h2.w), bfhi(h2.w)}};
            f32x4 x3[2] = {(f32x4){bflo(h3.x), bfhi(h3.x), bflo(h3.y), bfhi(h3.y)}, (f32x4){bflo(h3.z), bfhi(h3.z), bflo(h3.w), bfhi(h3.w)}};
#pragma unroll
            for (int t = 0; t < 16; ++t) {
                const u32x4 h0 = *(const u32x4*)(xp + (size_t)t * DRNN);
                const f32x4 x0[2] = {(f32x4){bflo(h0.x), bfhi(h0.x), bflo(h0.y), bfhi(h0.y)}, (f32x4){bflo(h0.z), bfhi(h0.z), bflo(h0.w), bfhi(h0.w)}};
                const f32x4 y0 = bias[0] + x3[0] * w[0][0] + x2[0] * w[1][0] + x1[0] * w[2][0] + x0[0] * w[3][0];
                const f32x4 y1 = bias[1] + x3[1] * w[0][1] + x2[1] * w[1][1] + x1[1] * w[2][1] + x0[1] * w[3][1];
                store8(op + (size_t)t * DRNN, y0, y1);
                x3[0] = x2[0]; x3[1] = x2[1]; x2[0] = x1[0]; x2[1] = x1[1]; x1[0] = x0[0]; x1[1] = x0[1];
            }
        }
    }
    SEAM(9);
    PHASE(10) {
        const bf16* XC = (const bf16*)(ws + WS_XC);
        EpiGates E{XC, args.in[I_OD_B_A], args.in[I_OD_B_X], (const float*)(ws + WS_SP8), (bf16*)(ws + WS_LA), (bf16*)args.out};
        if constexpr ((MFMA_MASK >> 5) & 1) {
            pg8::SchedDense Sg; Sg.so.init(M / 256, 20, F.G, F.bid); Sg.A = (const char*)XC; Sg.B = (const char*)(ws + WS_W_AX); Sg.tstepA = (size_t)256 * DRNN * 2; Sg.tstepB = (size_t)256 * 256 * 2; Sg.acol_shift = 1; Sg.acol_bytes = 512; Sg.tok = nullptr;
            pg8::gemm_phase<EpiGates, pg8::SchedDense, false, true>(F.lds, Sg, E, 256, DRNN, 256, nullptr, (REPEAT_NOEPI ? args.noepi : 0));
        } else {
        const int wr = F.wave >> 2, wc = F.wave & 3, fr = F.lane & 15, fq = F.lane >> 4;
        for (int i = F.bid; i < (M / 256) * 20; i += F.G) { Unit u; u.pm = i / 20; u.pn = i % 20; u.newpm = 1;
            ARowDense ar{XC + (u.pn >> 1) * 256, DRNN};
            naive_gemm_unit(ar, (const bf16*)(ws + WS_W_AX) + (size_t)u.pn * 256 * 256, 256, 256, u, E, wr, wc, fr, fq); }
        }
    }
    SEAM(10);
    const bf16* LA = (const bf16*)(ws + WS_LA); const bf16* BT = (const bf16*)args.out;
    constexpr int SCL = 16, NCHK = S / SCL;
    float* CA = (float*)(ws + WS_XC); float* CBv = CA + (size_t)2 * DRNN * NCHK; float* HIN = CBv + (size_t)2 * DRNN * NCHK;
    PHASE(11) {
        for (int it = gt; it < 2 * NCHK * (DRNN / 8); it += NGT) {
            const int cg = it % (DRNN / 8), bc = it / (DRNN / 8), ch = cg * 8;
            const size_t base = (size_t)bc * SCL * DRNN + ch;
            u32x4 lw[SCL], bw[SCL];
#pragma unroll
            for (int t = 0; t < SCL; ++t) { lw[t] = *(const u32x4*)(LA + base + (size_t)t * DRNN); bw[t] = *(const u32x4*)(BT + base + (size_t)t * DRNN); }
            float h[8], P[8];
#pragma unroll
            for (int i = 0; i < 8; ++i) { h[i] = 0.f; P[i] = 1.f; }
#pragma unroll
            for (int t = 0; t < SCL; ++t) {
                const float la[8] = {bflo(lw[t].x), bfhi(lw[t].x), bflo(lw[t].y), bfhi(lw[t].y), bflo(lw[t].z), bfhi(lw[t].z), bflo(lw[t].w), bfhi(lw[t].w)};
                const float bb[8] = {bflo(bw[t].x), bfhi(bw[t].x), bflo(bw[t].y), bfhi(bw[t].y), bflo(bw[t].z), bfhi(bw[t].z), bflo(bw[t].w), bfhi(bw[t].w)};
#pragma unroll
                for (int i = 0; i < 8; ++i) { const float a = __builtin_amdgcn_exp2f(la[i]); const float b = SCAN_SQRT ? __builtin_amdgcn_sqrtf(fmaxf(__builtin_fmaf(-a, a, 1.0f), 0.f)) * bb[i] : bb[i]; h[i] = a * h[i] + b; P[i] *= a; }
            }
            const size_t k = (size_t)bc * DRNN + ch;
            *(f32x4*)(CA + k) = (f32x4){P[0], P[1], P[2], P[3]}; *(f32x4*)(CA + k + 4) = (f32x4){P[4], P[5], P[6], P[7]};
            *(f32x4*)(CBv + k) = (f32x4){h[0], h[1], h[2], h[3]}; *(f32x4*)(CBv + k + 4) = (f32x4){h[4], h[5], h[6], h[7]};
        }
    }
    SEAM(11);
    PHASE(12) {
        for (int it = gw; it < 2 * (DRNN / 4); it += NGW) {
            const int b = it / (DRNN / 4), c4 = it - b * (DRNN / 4);
            const size_t k0 = ((size_t)b * NCHK + 16 * F.lane) * DRNN + 4 * c4;
            f32x4 a4[16], b4[16];
#pragma unroll
            for (int q = 0; q < 16; ++q) { a4[q] = *(const f32x4*)(CA + k0 + (size_t)q * DRNN); b4[q] = *(const f32x4*)(CBv + k0 + (size_t)q * DRNN); }
            f32x4 A = a4[0], B = b4[0];
#pragma unroll
            for (int q = 1; q < 16; ++q) { B = a4[q] * B + b4[q]; A = A * a4[q]; }
#pragma unroll
            for (int o = 1; o < 64; o <<= 1) {
                f32x4 Ap, Bp;
#pragma unroll
                for (int c = 0; c < 4; ++c) { Ap[c] = __shfl_up(A[c], o); Bp[c] = __shfl_up(B[c], o); }
                if (F.lane >= o) { B = A * Bp + B; A = A * Ap; }
            }
            f32x4 hin;
#pragma unroll
            for (int c = 0; c < 4; ++c) hin[c] = __shfl_up(B[c], 1);
            if (F.lane == 0) hin = (f32x4){0.f, 0.f, 0.f, 0.f};
#pragma unroll
            for (int q = 0; q < 16; ++q) { *(f32x4*)(HIN + k0 + (size_t)q * DRNN) = hin; hin = a4[q] * hin + b4[q]; }
        }
    }
    SEAM(12);
    PHASE(13) {
        bf16* Gb = (bf16*)(ws + WS_G);
        for (int it = gt; it < 2 * NCHK * (DRNN / 8); it += NGT) {
            const int cg = it % (DRNN / 8), bc = it / (DRNN / 8), ch = cg * 8;
            const size_t base = (size_t)bc * SCL * DRNN + ch;
            const size_t k = (size_t)bc * DRNN + ch;
            const f32x4 h0 = *(const f32x4*)(HIN + k), h1 = *(const f32x4*)(HIN + k + 4);
            float h[8] = {h0.x, h0.y, h0.z, h0.w, h1.x, h1.y, h1.z, h1.w};
#pragma unroll 8
            for (int t = 0; t < SCL; ++t) {
                const size_t o = base + (size_t)t * DRNN;
                const u32x4 lw = *(const u32x4*)(LA + o), bw = *(const u32x4*)(BT + o), gwv = *(const u32x4*)(Gb + o);
                const float la[8] = {bflo(lw.x), bfhi(lw.x), bflo(lw.y), bfhi(lw.y), bflo(lw.z), bfhi(lw.z), bflo(lw.w), bfhi(lw.w)};
                const float bb[8] = {bflo(bw.x), bfhi(bw.x), bflo(bw.y), bfhi(bw.y), bflo(bw.z), bfhi(bw.z), bflo(bw.w), bfhi(bw.w)};
                const float gg[8] = {bflo(gwv.x), bfhi(gwv.x), bflo(gwv.y), bfhi(gwv.y), bflo(gwv.z), bfhi(gwv.z), bflo(gwv.w), bfhi(gwv.w)};
                float y[8];
#pragma unroll
                for (int i = 0; i < 8; ++i) { const float a = __builtin_amdgcn_exp2f(la[i]); const float b = SCAN_SQRT ? __builtin_amdgcn_sqrtf(fmaxf(__builtin_fmaf(-a, a, 1.0f), 0.f)) * bb[i] : bb[i]; h[i] = a * h[i] + b; y[i] = gg[i] * h[i]; }
                u32x4 ow; ow.x = pk2(y[0], y[1]); ow.y = pk2(y[2], y[3]); ow.z = pk2(y[4], y[5]); ow.w = pk2(y[6], y[7]);
                *(u32x4*)(Gb + o) = ow;
            }
        }
    }
    SEAM(13);
    PHASE(14) {
        EpiResid<false> E{nullptr, XB, SSQ3, 1.0f};
        dense_gemm_phase<6>(F, (const bf16*)(ws + WS_G), DRNN, (const bf16*)(ws + WS_W_ODOUT), DRNN, DRNN, D / 256, (M / 256) * (D / 256), E, PROBE_PTR(6), (REPEAT_NOEPI ? args.noepi : 0));
    }
    SEAM(14);
    int* TOPE = (int*)(ws + WS_TOPE); float* TOPG = (float*)(ws + WS_TOPG); int* CNT = (int*)(ws + WS_CNT); int* EOFF = (int*)(ws + WS_EOFF);
    int* TOK = (int*)(ws + WS_TOK); float* GWv = (float*)(ws + WS_GW); int* DEST = (int*)(ws + WS_DEST);
    unsigned char* X8 = ws + WS_X8;
    float* RS3 = (float*)(ws + WS_SSQ0);
    float* RSR = (float*)(ws + WS_CA);
    const int TPW = (M + F.G - 1) / F.G;
    PHASE(15) {
        const float* Wr = args.in[I_OD_ROUTER]; const float* gn = args.in[I_OD_NORM_FFN];
        LAS int* cnt8 = (LAS int*)F.lds;
        if (F.tid < 8) cnt8[F.tid] = 0;
        __syncthreads();
        int myc[8];
#pragma unroll
        for (int e = 0; e < 8; ++e) myc[e] = 0;
        for (int tg = F.wave; 4 * tg < TPW; tg += NWAVES) {
            const int t0 = F.bid * TPW + 4 * tg; if (t0 >= M) break;
            float a[4][8];
#pragma unroll
            for (int q = 0; q < 4; ++q)
#pragma unroll
                for (int e = 0; e < 8; ++e) a[q][e] = 0.f;
#pragma unroll 2
            for (int j = 0; j < 8; ++j) { const int k0 = 4 * F.lane + 256 * j; const f32x4 gv = *(const f32x4*)(gn + k0);
                f32x4 xv[4];
#pragma unroll
                for (int q = 0; q < 4; ++q) { const int tq = (t0 + q < M) ? t0 + q : M - 1; const u32x2 xw = *((const u32x2*)(XB + (size_t)tq * D) + F.lane + 64 * j);
                    const f32x4 xr4 = (f32x4){bflo(xw.x), bfhi(xw.x), bflo(xw.y), bfhi(xw.y)};
                    *((unsigned*)(X8 + (size_t)tq * D) + F.lane + 64 * j) = pk4_f8(xr4.x * F8_SX, xr4.y * F8_SX, xr4.z * F8_SX, xr4.w * F8_SX);
                    xv[q] = xr4 * gv; }
#pragma unroll
                for (int kk = 0; kk < 4; ++kk) { const f32x4 w0 = *(const f32x4*)(Wr + (size_t)(k0 + kk) * 8), w1 = *(const f32x4*)(Wr + (size_t)(k0 + kk) * 8 + 4);
#pragma unroll
                    for (int q = 0; q < 4; ++q) { const float xg = xv[q][kk];
                        a[q][0] += xg * w0.x; a[q][1] += xg * w0.y; a[q][2] += xg * w0.z; a[q][3] += xg * w0.w; a[q][4] += xg * w1.x; a[q][5] += xg * w1.y; a[q][6] += xg * w1.z; a[q][7] += xg * w1.w; } } }
#pragma unroll
            for (int q = 0; q < 4; ++q) {
                const int t = t0 + q; if (t >= M) break;
#pragma unroll
                for (int e = 0; e < 8; ++e) a[q][e] = wave_sum(a[q][e]);
                const float sq = (F.lane < 32) ? SSQ3[(size_t)t * 32 + F.lane] : 0.f; const float rs = rsq_mean(wave_sum(sq));
                int e1 = 0; float l1 = a[q][0];
#pragma unroll
                for (int e = 1; e < 8; ++e) if (a[q][e] > l1) { l1 = a[q][e]; e1 = e; }
                int e2 = -1; float l2 = -INFINITY;
#pragma unroll
                for (int e = 0; e < 8; ++e) if (e != e1 && a[q][e] > l2) { l2 = a[q][e]; e2 = e; }
                const float g1 = 1.0f / (1.0f + expf((l2 - l1) * rs)), g2 = 1.0f - g1;
                if (F.lane == 0) { TOPE[2 * t] = e1; TOPE[2 * t + 1] = e2; TOPG[2 * t] = g1; TOPG[2 * t + 1] = g2; RS3[t] = rs; }
#pragma unroll
                for (int e = 0; e < 8; ++e) myc[e] += (e == e1) + (e == e2);
            }
        }
        if (F.lane == 0) {
#pragma unroll
            for (int e = 0; e < 8; ++e) atomicAdd((int*)(lds_raw) + e, myc[e]);
        }
        __syncthreads();
        if (F.tid < 8) CNT[F.bid * 8 + F.tid] = cnt8[F.tid];
    }
    SEAM(15);
    PHASE(16) {
        LAS int* tot = (LAS int*)F.lds;
        LAS int* bef = tot + 8;
        LAS int* eoff = tot + 16;
        LAS int* cntc = tot + 32;
        LAS int* run = tot + 32 + 8 * 64;
        { LAS int* pt = tot + 1024; LAS int* pb = pt + 512;
          const int e = F.tid & 7, wc0 = F.tid >> 3; int t = 0, b = 0;
          for (int w = wc0; w < F.G; w += 64) { const int c = CNT[w * 8 + e]; t += c; if (w < F.bid) b += c; }
          pt[F.tid] = t; pb[F.tid] = b;
          __syncthreads();
          if (F.tid < 8) { int tt = 0, bb = 0; for (int q = 0; q < 64; ++q) { tt += pt[q * 8 + F.tid]; bb += pb[q * 8 + F.tid]; } tot[F.tid] = tt; bef[F.tid] = bb; } }
        __syncthreads();
        if (F.tid == 0) { int o = 0; for (int e = 0; e < 8; ++e) { eoff[e] = o; o += (tot[e] + 255) & ~255; } eoff[8] = o; }
        __syncthreads();
        if (F.bid == 0 && F.tid < 9) EOFF[F.tid] = eoff[F.tid];
        const int nslots = 2 * TPW, nchunk = (nslots + 63) / 64;
        for (int c = F.wave; c < nchunk; c += NWAVES) {
            const int sl = c * 64 + F.lane; const int t = F.bid * TPW + (sl >> 1); const int e = (sl < nslots && t < M) ? TOPE[2 * t + (sl & 1)] : -1;
#pragma unroll
            for (int x = 0; x < 8; ++x) { const unsigned long long mk = __ballot(e == x); if (F.lane == 0) cntc[c * 8 + x] = __popcll(mk); }
        }
        __syncthreads();
        if (F.tid < 8) { int r = 0; for (int c = 0; c < nchunk; ++c) { const int v = cntc[c * 8 + F.tid]; cntc[c * 8 + F.tid] = r; r += v; } }
        __syncthreads();
        for (int c = F.wave; c < nchunk; c += NWAVES) {
            const int sl = c * 64 + F.lane; const int t = F.bid * TPW + (sl >> 1); const bool ok = (sl < nslots && t < M); const int e = ok ? TOPE[2 * t + (sl & 1)] : -1;
            int posn = -1;
#pragma unroll
            for (int x = 0; x < 8; ++x) { const unsigned long long mk = __ballot(e == x); if (e == x) posn = eoff[x] + bef[x] + cntc[c * 8 + x] + __popcll(mk & ((1ull << F.lane) - 1ull)); }
            if (ok) { TOK[posn] = t; GWv[posn] = TOPG[2 * t + (sl & 1)]; DEST[posn] = (sl & 1) * M + t; RSR[posn] = RS3[t]; }
        }
        if (F.bid < 8) { const int e = F.bid; for (int p = eoff[e] + tot[e] + F.tid; p < eoff[e + 1]; p += NTHR) { TOK[p] = 0; GWv[p] = 0.f; DEST[p] = -1; RSR[p] = 0.f; } }
        (void)run;
    }
    SEAM(16);
    PHASE(17) {
        EpiGateUp<true> E{nullptr, (bf16*)(ws + WS_HM), DFE, RSR, GWv, nullptr};
        const int wr = F.wave >> 2, wc = F.wave & 3, fr = F.lane & 15, fq = F.lane >> 4;
        int eo[9];
#pragma unroll
        for (int e = 0; e < 9; ++e) eo[e] = EOFF[e];
        const int NT = eo[8] / 256;
        if constexpr ((MFMA_MASK >> 7) & 1) {
            pg8::SchedMoe Sm; Sm.so.init(NT, 22, F.G, F.bid); Sm.A = (const char*)X8; Sm.B = (const char*)(ws + WS_W_EGU); Sm.tstepA = 0; Sm.tstepB = (size_t)256 * D; Sm.estrideB = (size_t)2 * DFE * D;
#pragma unroll
            for (int e = 0; e < 9; ++e) Sm.eo[e] = eo[e];
            Sm.tok = TOK; Sm.gather = true;
            pg8::gemm_phase<EpiGateUp<true>, pg8::SchedMoe, true, true, true>(F.lds, Sm, E, D / 2, D / 2, D / 2, nullptr, (REPEAT_NOEPI ? args.noepi : 0));
        } else {
        ARowGather ar{XB, D, TOK};
        for (int i = F.bid; i < NT * 22; i += F.G) { Unit u; u.pm = i / 22; u.pn = i % 22; int e = 0;
#pragma unroll
            for (int x = 1; x < 8; ++x) e += (u.pm * 256 >= eo[x]);
            naive_gemm_unit(ar, (const bf16*)(ws + WS_W_EGU) + (size_t)e * 2 * DFE * D + (size_t)u.pn * 256 * D, D, D, u, E, wr, wc, fr, fq); }
        }
    }
    SEAM(17);
    PHASE(18) {
        EpiMoeDown E{DEST, (bf16*)(ws + WS_Y0), (bf16*)(ws + WS_Y1)};
        const int wr = F.wave >> 2, wc = F.wave & 3, fr = F.lane & 15, fq = F.lane >> 4;
        int eo[9];
#pragma unroll
        for (int e = 0; e < 9; ++e) eo[e] = EOFF[e];
        const int NT = eo[8] / 256;
        if constexpr ((MFMA_MASK >> 8) & 1) {
            pg8::SchedMoe Sm; Sm.so.init(NT, 8, F.G, F.bid); Sm.A = (const char*)(ws + WS_HM); Sm.B = (const char*)(ws + WS_W_EDN); Sm.tstepA = (size_t)256 * DFE; Sm.tstepB = (size_t)256 * DFE; Sm.estrideB = (size_t)D * DFE;
#pragma unroll
            for (int e = 0; e < 9; ++e) Sm.eo[e] = eo[e];
            Sm.tok = nullptr; Sm.gather = false;
            pg8::gemm_phase<EpiMoeDown, pg8::SchedMoe, false, true, true>(F.lds, Sm, E, DFE / 2, DFE / 2, DFE / 2, nullptr, (REPEAT_NOEPI ? args.noepi : 0));
        } else {
        ARowDense ar{(const bf16*)(ws + WS_HM), DFE};
        for (int i = F.bid; i < NT * 8; i += F.G) { Unit u; u.pm = i / 8; u.pn = i % 8; int e = 0;
#pragma unroll
            for (int x = 1; x < 8; ++x) e += (u.pm * 256 >= eo[x]);
            naive_gemm_unit(ar, (const bf16*)(ws + WS_W_EDN) + (size_t)e * D * DFE + (size_t)u.pn * 256 * DFE, DFE, DFE, u, E, wr, wc, fr, fq); }
        }
    }
    SEAM(18);
    PHASE(19) {
        const bf16* Y0 = (const bf16*)(ws + WS_Y0); const bf16* Y1 = (const bf16*)(ws + WS_Y1); const float* gf = args.in[I_FINAL_NORM];
        for (int m = gw; m < M; m += NGW) {
            f32x4* orow = (f32x4*)(xres + (size_t)m * D) + F.lane; const u32x2* xb = (const u32x2*)(XB + (size_t)m * D) + F.lane;
            const u32x2* y0 = (const u32x2*)(Y0 + (size_t)m * D) + F.lane; const u32x2* y1 = (const u32x2*)(Y1 + (size_t)m * D) + F.lane;
            f32x4 v[8]; float s = 0.f;
#pragma unroll
            for (int j = 0; j < 8; ++j) { const u32x2 x = xb[64 * j]; const u32x2 a = y0[64 * j], b = y1[64 * j];
                v[j] = (f32x4){bflo(x.x) + bflo(a.x) + bflo(b.x), bfhi(x.x) + bfhi(a.x) + bfhi(b.x), bflo(x.y) + bflo(a.y) + bflo(b.y), bfhi(x.y) + bfhi(a.y) + bfhi(b.y)};
                s += (v[j].x * v[j].x + v[j].y * v[j].y) + (v[j].z * v[j].z + v[j].w * v[j].w); }
            float rs = 1.0f / sqrtf(wave_sum(s) * (1.0f / D) + RMS_EPS);
            if (PROBE_ID >= 0) rs *= 1.0f + (float)((const unsigned long long*)(ws + WS_CTL))[512 + PROBE_IDX] * (1.0f / PROBE_DIV);
#pragma unroll
            for (int j = 0; j < 8; ++j) { const f32x4 g = *((const f32x4*)gf + F.lane + 64 * j); orow[64 * j] = v[j] * rs * g; }
        }
    }
#undef IN
#undef SEAM
#undef PHASE
}

extern "C" void kernel_launch(void* const* d_in, const int* in_sizes, int n_in, void* d_out, int out_size, void* d_ws, size_t ws_size, hipStream_t stream) {
    static int grid = 0;
    if (grid == 0) {
        if (n_in != 28 || in_sizes[0] != M * D || out_size != M * D || ws_size < WS_END) { fprintf(stderr, "kernel_launch: unexpected shapes (n_in %d, in0 %d, out %d, ws %zu); nothing launched\n", n_in, n_in > 0 ? in_sizes[0] : -1, out_size, ws_size); grid = -1; return; }
        int dev = 0, cus = 0;
        if (hipGetDevice(&dev) != hipSuccess || hipDeviceGetAttribute(&cus, hipDeviceAttributeMultiprocessorCount, dev) != hipSuccess) { grid = -1; return; }
        if (hipFuncSetAttribute((const void*)fwd, hipFuncAttributeMaxDynamicSharedMemorySize, LDS_BYTES) != hipSuccess) { grid = -1; return; }
        int per_cu = 0;
        if (hipOccupancyMaxActiveBlocksPerMultiprocessor(&per_cu, (const void*)fwd, NTHR, LDS_BYTES) != hipSuccess || per_cu < 1) { fprintf(stderr, "kernel_launch: occupancy query says %d blocks per CU\n", per_cu); (void)hipGetLastError(); }
        grid = cus;
    }
    if (grid < 0) return;
    (void)hipMemsetAsync((char*)d_ws + WS_CTL, 0, CTL_ZERO_BYTES, stream);
    Args a{};
    for (int i = 0; i < 28; ++i) a.in[i] = (const float*)d_in[i];
    a.out = (float*)d_out; a.ws = (unsigned char*)d_ws;
#if defined(MK_PER_PHASE)
    for (int ph = 0; ph < N_PHASES; ++ph) { a.ph_lo = ph; a.ph_hi = ph + 1; a.li = ph; hipLaunchKernelGGL(fwd, dim3(grid), dim3(NTHR), LDS_BYTES, stream, a); }
#else
    if (REPEAT_MASK == 0) {
        a.ph_lo = 0; a.ph_hi = N_PHASES;
        hipLaunchKernelGGL(fwd, dim3(grid), dim3(NTHR), LDS_BYTES, stream, a);
    } else {
        int lo = 0, li = 0;
        for (int k = 0; k < N_PHASES; ++k) if ((REPEAT_MASK >> k) & 1) {
            a.ph_lo = lo; a.ph_hi = k + 1; a.li = li++; hipLaunchKernelGGL(fwd, dim3(grid), dim3(NTHR), LDS_BYTES, stream, a);
            a.ph_lo = k; a.ph_hi = k + 1; a.li = li++; a.noepi = REPEAT_NOEPI; hipLaunchKernelGGL(fwd, dim3(grid), dim3(NTHR), LDS_BYTES, stream, a); a.noepi = 0;
            lo = k + 1; }
        if (lo < N_PHASES) { a.ph_lo = lo; a.ph_hi = N_PHASES; a.li = li++; hipLaunchKernelGGL(fwd, dim3(grid), dim3(NTHR), LDS_BYTES, stream, a); }
    }
#endif
}
```

```cpp
#include <hip/hip_runtime.h>
#include <cstdio>
#include <cstdint>

#define GAS __attribute__((address_space(1)))
#define LAS __attribute__((address_space(3)))
typedef unsigned short bf16;
typedef float f32x4 __attribute__((ext_vector_type(4)));
typedef float f32x2 __attribute__((ext_vector_type(2)));
typedef unsigned u32x4 __attribute__((ext_vector_type(4)));
typedef unsigned u32x2 __attribute__((ext_vector_type(2)));

constexpr int M = 32768, S = 16384, D = 2048;
constexpr int DA = 512, DB = 1536, NIN0 = 5632, DFF = 5632, DRNN = 2560, NEXP = 8, DFE = 2816;
constexpr int NWAVES = 8, NTHR = 512;
constexpr float RMS_EPS = 1e-6f, LN_EPS = 1e-5f;
constexpr int FGU_KB = 1024, FGU_P = 2 * FGU_KB + (D - FGU_KB);
constexpr int C2P = 2 * DA + DB;
constexpr int RMAX = 2 * M + NEXP * 256;

constexpr size_t MiB = 1u << 20, KiB = 1u << 10;
constexpr size_t WS_CTL = 0, CTL_ZERO_BYTES = 1 * MiB;
constexpr size_t WS_SSQ0 = 1 * MiB;
constexpr size_t WS_SSQ1 = WS_SSQ0 + 128 * KiB;
constexpr size_t WS_SSQ2 = WS_SSQ1 + 4 * MiB;
constexpr size_t WS_SSQ3 = WS_SSQ2 + 4 * MiB;
constexpr size_t WS_TOPE = WS_SSQ3 + 4 * MiB;
constexpr size_t WS_TOPG = WS_TOPE + 256 * KiB;
constexpr size_t WS_CNT  = WS_TOPG + 256 * KiB;
constexpr size_t WS_EOFF = WS_CNT + 64 * KiB;
constexpr size_t WS_TOK  = WS_EOFF + 4 * KiB;
constexpr size_t WS_GW   = WS_TOK + 272 * KiB;
constexpr size_t WS_DEST = WS_GW + 272 * KiB;
constexpr size_t WS_CA   = WS_DEST + 272 * KiB;
constexpr size_t WS_CB   = WS_CA + 1280 * KiB;
constexpr size_t WS_HIN  = WS_CB + 1280 * KiB;
constexpr size_t WS_SP8  = WS_HIN + 1280 * KiB;
constexpr size_t WS_LSE  = WS_SP8 + 16 * KiB;
constexpr size_t WS_WSM  = WS_LSE + 1536 * KiB;
constexpr size_t WS_SMALL_END = WS_WSM + 128 * KiB;
static_assert(WS_SMALL_END <= 20 * MiB, "small region");
constexpr size_t WS_WODD = 20 * MiB;
constexpr size_t WS_W_ODIN = WS_WODD, WS_W_AX = WS_WODD + 20 * MiB, WS_W_ODOUT = WS_W_AX + 3 * MiB;
constexpr size_t WS_WL0 = 53 * MiB;
constexpr size_t WS_W_EVIN = WS_WL0, WS_W_EVOUT = WS_WL0 + 22 * MiB, WS_W_FGU = WS_W_EVOUT + 8 * MiB, WS_W_FDN = WS_W_FGU + 44 * MiB;
constexpr size_t WS_XB = 149 * MiB;
constexpr size_t WS_WEXP = 277 * MiB;
constexpr size_t WS_W_EGU = WS_WEXP, WS_W_EDN = WS_WEXP + 176 * MiB;
constexpr size_t WS_ACT = 541 * MiB;
constexpr size_t WS_END = 1021 * MiB;
constexpr size_t WS_U = WS_ACT, WS_VA = WS_ACT + 32 * MiB, WS_Q = WS_ACT + 64 * MiB, WS_K = WS_ACT + 160 * MiB, WS_V = WS_ACT + 256 * MiB, WS_CAT = WS_ACT + 352 * MiB;
constexpr size_t WS_X18 = WS_CAT;
constexpr long X18_DELTA = (long)WS_X18 - (long)WS_XB;
constexpr size_t WS_H = WS_ACT;
constexpr size_t WS_G = WS_ACT, WS_XR = WS_ACT + 160 * MiB, WS_XC = WS_ACT + 320 * MiB, WS_LA = WS_XR;
constexpr size_t WS_HM = WS_ACT;
constexpr size_t WS_X8 = WS_ACT + 256 * MiB;
constexpr size_t WS_Y0 = WS_W_EGU, WS_Y1 = WS_WODD;
static_assert((size_t)M * DRNN * 2 <= (size_t)M * D * 4, "BT fits d_out");
static_assert(WS_Y1 + (size_t)M * D * 2 <= WS_XB && WS_Y0 + (size_t)M * D * 2 <= WS_W_EDN, "Y overlays");
static_assert((size_t)RMAX * DFE * 2 <= 480 * MiB, "HM fits ACT");

constexpr float F8_SX = 16.f, F8_SW = 256.f, F8_SH = 8.f;
#ifndef EVIN_QKV_FP8
#define EVIN_QKV_FP8 1
#endif
constexpr size_t EVIN8_OFF = 4 * MiB;
#ifndef FFN_DOWN_FP8
#define PG8_NOCLEAR 1
#define EVOUT_MIXED 1
#define FFN_GU_FP8 0
#define OD_IN_FP8 0
#define FFN_GU_MIX 1
#define SCAN_SQRT 1
#define FFN_DOWN_FP8 1
#endif
constexpr int LDS_BYTES = 147456;
constexpr int LDSCTL_OFF = 146432;
constexpr int CW_BAR = 4096;
static_assert((CW_BAR + 48 * 3456) * 4 <= (int)CTL_ZERO_BYTES, "barrier words inside the memset region");

#define LDS_WAIT() asm volatile("s_waitcnt lgkmcnt(0)" ::: "memory")
#define VM_WAIT() asm volatile("s_waitcnt vmcnt(0)" ::: "memory")
__device__ __forceinline__ unsigned f2bf(float f) { unsigned u = __builtin_bit_cast(unsigned, f); return (u + 0x7fffu + ((u >> 16) & 1u)) >> 16; }
typedef __bf16 bf16n2 __attribute__((ext_vector_type(2)));
__device__ __forceinline__ unsigned pk2(float lo, float hi) { const bf16n2 v = __builtin_convertvector((f32x2){lo, hi}, bf16n2); return __builtin_bit_cast(unsigned, v); }
__device__ __forceinline__ unsigned pk4_f8(float a, float b, float c, float d) {
    a = __builtin_amdgcn_fmed3f(a, -448.f, 448.f); b = __builtin_amdgcn_fmed3f(b, -448.f, 448.f); c = __builtin_amdgcn_fmed3f(c, -448.f, 448.f); d = __builtin_amdgcn_fmed3f(d, -448.f, 448.f);
    int w = 0; w = __builtin_amdgcn_cvt_pk_fp8_f32(a, b, w, false); w = __builtin_amdgcn_cvt_pk_fp8_f32(c, d, w, true); return (unsigned)w; }
__device__ __forceinline__ float bflo(unsigned w) { return __builtin_bit_cast(float, w << 16); }
__device__ __forceinline__ float bfhi(unsigned w) { return __builtin_bit_cast(float, w & 0xffff0000u); }
__device__ __forceinline__ float bf2f(bf16 b) { return __builtin_bit_cast(float, ((unsigned)b) << 16); }
__device__ __forceinline__ float wave_sum(float v) {
#pragma unroll
    for (int o = 1; o < 64; o <<= 1) v += __shfl_xor(v, o);
    return v;
}
__device__ __forceinline__ float wave_max(float v) {
#pragma unroll
    for (int o = 1; o < 64; o <<= 1) v = fmaxf(v, __shfl_xor(v, o));
    return v;
}
__device__ __forceinline__ float fast_exp(float x) { return __builtin_amdgcn_exp2f(x * 1.44269504089f); }
__device__ __forceinline__ float sigmoid_f(float x) { return __builtin_amdgcn_rcpf(1.0f + fast_exp(-x)); }
__device__ __forceinline__ float silu_f(float x) { return x * sigmoid_f(x); }
__device__ __forceinline__ float gelu_f(float x) { const float u = 0.7978845608f * (x + 0.044715f * x * x * x); return x * sigmoid_f(2.0f * u); }
__device__ __forceinline__ f32x2 gelu2(f32x2 x) {
    const f32x2 q = x * x;
    const f32x2 a = x * (q * (0.044715f * -2.0f * 1.44269504089f * 0.7978845608f) + (-2.0f * 1.44269504089f * 0.7978845608f));
    const f32x2 d = (f32x2){__builtin_amdgcn_exp2f(a.x), __builtin_amdgcn_exp2f(a.y)} + 1.0f;
    return x * (f32x2){__builtin_amdgcn_rcpf(d.x), __builtin_amdgcn_rcpf(d.y)};
}
__device__ __forceinline__ void gelu8(f32x4& v0, f32x4& v1) {
    const f32x2 a = gelu2((f32x2){v0[0], v0[1]}), b = gelu2((f32x2){v0[2], v0[3]}), c = gelu2((f32x2){v1[0], v1[1]}), d = gelu2((f32x2){v1[2], v1[3]});
    v0 = (f32x4){a.x, a.y, b.x, b.y}; v1 = (f32x4){c.x, c.y, d.x, d.y};
}

#define XB_TMO      128
#define XB_XCNT(j)  (256  + 64 * (j))
#define XB_XSUB(j)  (1280 + 64 * (j))
#define XB_XGEN(j)  (2304 + 64 * (j))
#define XB_TOP      3328
#define XB_TOPGEN   3392
#define XCD_BAR_WORDS 3456
#define XB_SPIN_CAP (1u << 18)

__device__ __forceinline__ unsigned xb_ld(unsigned* p)              { return __hip_atomic_load(p, __ATOMIC_RELAXED, __HIP_MEMORY_SCOPE_AGENT); }
__device__ __forceinline__ unsigned xb_add(unsigned* p, unsigned v) { return __hip_atomic_fetch_add(p, v, __ATOMIC_RELAXED, __HIP_MEMORY_SCOPE_AGENT); }
__device__ __forceinline__ unsigned xb_xcc_id() { return (unsigned)__builtin_amdgcn_s_getreg((3 << 11) | 20) & 0xFu; }
#define XB_SPIN(cond, bar) do { unsigned _sp = 0; while (cond) { __builtin_amdgcn_s_sleep(1); \
    if ((++_sp & 255u) == 0u) { if (xb_ld(&(bar)[XB_TMO])) break; if (_sp > XB_SPIN_CAP) { atomicAdd(&(bar)[XB_TMO], 1u); break; } } } } while (0)

struct XcdBarrier {
    unsigned* bar; unsigned x;
    volatile LAS unsigned* st;
};

__device__ __forceinline__ XcdBarrier xcd_barrier_post(unsigned* bar, volatile LAS unsigned* st) {
    XcdBarrier b; b.bar = bar; b.x = xb_xcc_id(); b.st = st;
    if (threadIdx.x == 0) (void)xb_add(&bar[XB_XCNT(b.x)], 1u);
    return b;
}
__device__ __forceinline__ void xcd_barrier_complete(unsigned* bar, unsigned x, unsigned& nloc, unsigned& nx) {
    const unsigned G = gridDim.x * gridDim.y * gridDim.z;
    unsigned sum, cnt, mine, sp = 0u;
    for (;;) {
        sum = 0u; cnt = 0u; mine = 0u;
#pragma unroll
        for (unsigned j = 0; j < 16; ++j) { const unsigned c = xb_ld(&bar[XB_XCNT(j)]); sum += c; cnt += (c > 0u) ? 1u : 0u; mine = (j == x) ? c : mine; }
        if (sum == G) break;
        __builtin_amdgcn_s_sleep(1);
        if ((++sp & 255u) == 0u) { if (xb_ld(&bar[XB_TMO])) break; if (sp > XB_SPIN_CAP) { atomicAdd(&bar[XB_TMO], 1u); break; } }
    }
    nloc = mine > 0u ? mine : 1u; nx = cnt > 0u ? cnt : 1u;
}

__device__ __forceinline__ void xcd_barrier(const XcdBarrier& b) {
    asm volatile("s_waitcnt vmcnt(0)" ::: "memory");
    __syncthreads();
    if (threadIdx.x == 0) {
        unsigned* bar = b.bar;
        __builtin_amdgcn_s_waitcnt(0);
        unsigned nloc = b.st[0], nx = b.st[1];
        if (nloc == 0u) { xcd_barrier_complete(bar, b.x, nloc, nx); b.st[0] = nloc; b.st[1] = nx; }
        const unsigned old = xb_add(&bar[XB_XSUB(b.x)], 1u);
        const unsigned gen = old / nloc;
        if (old + 1u == (gen + 1u) * nloc) {
            __builtin_amdgcn_fence(__ATOMIC_RELEASE, "agent");
            asm volatile("s_waitcnt vmcnt(0)" ::: "memory");
            const unsigned og = xb_add(&bar[XB_TOP], 1u);
            const unsigned tg = og / nx;
            if (og + 1u == (tg + 1u) * nx) xb_add(&bar[XB_TOPGEN], 1u);
            else XB_SPIN(xb_ld(&bar[XB_TOPGEN]) == tg, bar);
            __builtin_amdgcn_fence(__ATOMIC_ACQUIRE, "agent");
            xb_add(&bar[XB_XGEN(b.x)], 1u);
            asm volatile("s_waitcnt vmcnt(0)" ::: "memory");
        } else {
            XB_SPIN(xb_ld(&bar[XB_XGEN(b.x)]) == gen, bar);
            __builtin_amdgcn_fence(__ATOMIC_ACQUIRE, "agent");
            asm volatile("s_waitcnt vmcnt(0)" ::: "memory");
        }
    }
    __syncthreads();
}

struct Frame {
    LAS unsigned char* lds;
    int tid, lane, wave, bid, G;
};
struct Unit { int pm, pn, newpm; };
__device__ __forceinline__ bool frame_refresh(Frame& F, int& gw, int& gt) {
    int t = threadIdx.x; asm volatile("" : "+v"(t));
    F.tid = t; F.lane = t & 63; F.wave = __builtin_amdgcn_readfirstlane(t >> 6);
    gw = F.bid * NWAVES + F.wave; gt = F.bid * NTHR + t; return true;
}

struct MapV { const float* W; const float* gain; bf16* dst; int K, NP, mode, half; float f8scale; float bscale; };
__device__ __forceinline__ int mapv_drow(const MapV& mp, int n) {
    if (mp.mode == 1) return ((n >> 7) << 8) + mp.half * 128 + (n & 127);
    if (mp.mode == 2 && n >= 2 * DA && n < 2 * DA + 2 * DB) { const int base = (n < 2 * DA + DB) ? 2 * DA : 2 * DA + DB; const int cc = n - base, head = cc >> 7, i = cc & 127; return base + head * 128 + ((i < 64) ? 2 * i : 2 * (i - 64) + 1); }
    return n;
}
__device__ __forceinline__ void cvt_item64(const MapV& mp, int item, LAS float* scr, int lane) {
    const int nblk = mp.NP / 64, kb = item / nblk, nb = item - kb * nblk, k0 = 64 * kb, n0 = 64 * nb;
    const int lr = lane >> 4, lc = (lane & 15) * 4;
    const float* src = mp.W + (size_t)(k0 + lr) * mp.NP + n0 + lc;
    f32x4 v[16];
#pragma unroll
    for (int i = 0; i < 16; ++i) v[i] = *(const f32x4*)(src + (size_t)(4 * i) * mp.NP);
    float cs = (mp.bscale > 0.f) ? mp.bscale : 1.0f; if (mp.mode == 2 && n0 >= 2 * DA && n0 < 2 * DA + DB) cs = 0.08838834764831845f * 1.4426950408889634f;
    const bool f8 = mp.f8scale > 0.f || (EVIN_QKV_FP8 && mp.mode == 2 && n0 >= 2 * DA);
    if (f8) cs *= (mp.f8scale > 0.f ? mp.f8scale : F8_SW);
#pragma unroll
    for (int i = 0; i < 16; ++i) { const float g = mp.gain ? mp.gain[k0 + 4 * i + lr] * cs : cs; LAS float* d = scr + (4 * i + lr) * 65 + lc;
        d[0] = v[i].x * g; d[1] = v[i].y * g; d[2] = v[i].z * g; d[3] = v[i].w * g; }
    LDS_WAIT();
    const int c = lane & 7;
    if (f8) {
        unsigned char* d8 = (unsigned char*)mp.dst; if (mp.mode == 2) d8 += EVIN8_OFF - (size_t)(2 * DA) * mp.K;
#pragma unroll
        for (int j = 0; j < 8; ++j) { const int n = (lane >> 3) + 8 * j; const LAS float* q = scr + (8 * c) * 65 + n;
            u32x2 o; o.x = pk4_f8(q[0 * 65], q[1 * 65], q[2 * 65], q[3 * 65]); o.y = pk4_f8(q[4 * 65], q[5 * 65], q[6 * 65], q[7 * 65]);
            *(u32x2*)(d8 + (size_t)mapv_drow(mp, n0 + n) * mp.K + k0 + 8 * c) = o; }
    } else {
#pragma unroll
        for (int j = 0; j < 8; ++j) { const int n = (lane >> 3) + 8 * j; const LAS float* q = scr + (8 * c) * 65 + n;
            u32x4 o; o.x = pk2(q[0 * 65], q[1 * 65]); o.y = pk2(q[2 * 65], q[3 * 65]); o.z = pk2(q[4 * 65], q[5 * 65]); o.w = pk2(q[6 * 65], q[7 * 65]);
            *(u32x4*)(mp.dst + (size_t)mapv_drow(mp, n0 + n) * mp.K + k0 + 8 * c) = o; }
    }
    LDS_WAIT();
}

template <class AR, class Epi>
__device__ __forceinline__ void naive_gemm_unit(const AR& ar, const bf16* Bt, int ldb, int K, const Unit& u, const Epi& E, int wr, int wc, int fr, int fq) {
    f32x4 acc[2][2][4][2];
#pragma unroll
    for (int a = 0; a < 2; ++a)
#pragma unroll
        for (int b = 0; b < 2; ++b)
#pragma unroll
            for (int m = 0; m < 4; ++m)
#pragma unroll
                for (int n = 0; n < 2; ++n) acc[a][b][m][n] = (f32x4){0.f, 0.f, 0.f, 0.f};
    const bf16* ap[2][4];
#pragma unroll
    for (int a = 0; a < 2; ++a)
#pragma unroll
        for (int m = 0; m < 4; ++m) ap[a][m] = ar.row(u, a * 128 + wr * 64 + m * 16 + fr);
#pragma unroll
    for (int b = 0; b < 2; ++b)
#pragma unroll
        for (int n = 0; n < 2; ++n) {
            const bf16* bp = Bt + (size_t)(b * 128 + wc * 32 + 8 * fq + 4 * n) * ldb;
#pragma unroll 1
            for (int k = 0; k < K; k += 4) {
                f32x4 bv[4];
#pragma unroll
                for (int j = 0; j < 4; ++j) { const u32x2 w = *(const u32x2*)(bp + (size_t)j * ldb + k); bv[j] = (f32x4){bflo(w.x), bfhi(w.x), bflo(w.y), bfhi(w.y)}; }
#pragma unroll
                for (int a = 0; a < 2; ++a)
#pragma unroll
                    for (int m = 0; m < 4; ++m) {
                        const u32x2 w = *(const u32x2*)(ap[a][m] + k); const f32x4 av = (f32x4){bflo(w.x), bfhi(w.x), bflo(w.y), bfhi(w.y)};
#pragma unroll
                        for (int j = 0; j < 4; ++j) { const f32x4 p = av * bv[j]; acc[a][b][m][n][j] += (p.x + p.y) + (p.z + p.w); }
                    }
            }
        }
    E(acc, u, wr, wc, fr, fq);
}
struct ARowDense { const bf16* A; int lda; __device__ __forceinline__ const bf16* row(const Unit& u, int r) const { return A + (size_t)(u.pm * 256 + r) * lda; } };
struct ARowGather { const bf16* A; int lda; const int* tok; __device__ __forceinline__ const bf16* row(const Unit& u, int r) const { return A + (size_t)tok[u.pm * 256 + r] * lda; } };

namespace pg8 {
typedef short bf16x8 __attribute__((ext_vector_type(8)));
typedef int i32x4 __attribute__((ext_vector_type(4)));
typedef int i32x8 __attribute__((ext_vector_type(8)));
constexpr int BM = 256, BK = 64, HALF = 128, HTB = HALF * BK * 2, STAGE_BYTES = 8 * HTB, NXCD = 8, WGM = 4;
__host__ __device__ __forceinline__ int lds_byte(int r, int c) { const int st = (r >> 4) * 2 + (c >> 5), rr = r & 15, cc = c & 31, ob = rr * 64 + cc * 2; return st * 1024 + (ob ^ (((ob >> 9) & 1) << 5)); }
__host__ __device__ __forceinline__ void stage_rc(int b, int& R, int& C) { const int st = b / 1024, sb = b % 1024, swz = sb ^ (((sb >> 9) & 1) << 5); R = (st >> 1) * 16 + swz / 64; C = (st & 1) * 32 + (swz % 64) / 2; }
__host__ __device__ __forceinline__ int perm32(int rho) { const int n = rho >> 4, i = rho & 15; return 8 * (i >> 2) + 4 * n + (i & 3); }
struct StaticOrder {
    int nM, nN, nwg, G, c;
    __host__ __device__ void init(int nM_, int nN_, int G_, int c_) { nM = nM_; nN = nN_; nwg = nM * nN; G = G_; c = c_; }
    __host__ __device__ bool next(int i, Unit& u) const {
        const long L = (long)i * G + c; if (L >= nwg) return false;
        int wgid = (int)L; { const int q = nwg / NXCD, r = nwg % NXCD, xcd = wgid % NXCD, off = wgid / NXCD; wgid = (xcd < r ? xcd * (q + 1) : r * (q + 1) + (xcd - r) * q) + off; }
        const int nig = WGM * nN, gid = wgid / nig, fm = gid * WGM, gsz = (nM - fm) < WGM ? (nM - fm) : WGM;
        u.pm = fm + ((wgid % nig) % gsz); u.pn = (wgid % nig) / gsz; return true;
    }
};
template <class Epi, class Sched, bool GATHER, bool ALIGN_EPI, bool FP8 = false, int F8FROM = 0>
__device__ __forceinline__ void gemm_phase(LAS unsigned char* lds, const Sched& S, const Epi& E, const int K, const int lda, const int ldb, unsigned long long* probe = nullptr, const int noepi = 0, const long adelta = 0) {
    unsigned long long pr_t0 = 0, pr_k = 0, pr_e = 0, pr_a = 0, pr_b = 0; unsigned pr_n = 0;
    const int tid = threadIdx.x, wid = __builtin_amdgcn_readfirstlane(tid >> 6), lane = tid & 63, wr = wid >> 2, wc = wid & 3, fr = lane & 15, fq = lane >> 4;
    constexpr bool T0 = FP8 && F8FROM == 0, T1 = FP8;
    static_assert(F8FROM == 0 || (FP8 && F8FROM >= 4 && F8FROM % 2 == 0 && PG8_NOCLEAR), "mixed K range: fp8 tail behind an even number (>= 4) of bf16 K-tiles");
    int nt = K / BK; asm volatile("" : "+s"(nt));
    unsigned voffA[2][2], nvoffA[2][2], voffB[2]; int RA[2]; unsigned CA2[2];
#pragma unroll
    for (int i = 0; i < 2; ++i) { int R, C; stage_rc(tid * 16 + i * 8192, R, C); const int Rb = (R & ~31) + perm32(R & 31);
        voffB[i] = (unsigned)(Rb * ldb + C) * 2u; RA[i] = R; CA2[i] = (unsigned)C * 2u;
        voffA[0][i] = (unsigned)(R * lda + C) * 2u; voffA[1][i] = (unsigned)((R + HALF) * lda + C) * 2u; nvoffA[0][i] = voffA[0][i]; nvoffA[1][i] = voffA[1][i]; }
    const size_t kstep = (size_t)(BK * 2);
    const size_t hstepB = (size_t)HALF * ldb * 2;
    const unsigned ldsw = (unsigned)wid * 1024u;
    const int aoff = lds_byte(wr * 64 + fr, fq * 8), boff = lds_byte(wc * 32 + fr, fq * 8);
#define PG8_SA(b, h) (((b) * 2 + (h)) * HTB)
#define PG8_SB(b, h) ((4 + (b) * 2 + (h)) * HTB)
#define PG8_STAGE(bufoff, gbase, voff) do { _Pragma("unroll") for (int _i = 0; _i < 2; ++_i) \
        __builtin_amdgcn_global_load_lds((const unsigned*)((const char*)(gbase) + (voff)[_i]), (LAS unsigned*)(lds + (bufoff) + ldsw + _i * 8192), 16, 0, 0); } while (0)
#define PG8_LDA(dst, b, h) do { _Pragma("unroll") for (int m = 0; m < 4; ++m) _Pragma("unroll") for (int k = 0; k < 2; ++k) dst[m][k] = *(const LAS bf16x8*)(lds + PG8_SA(b, h) + aoff + m * 2048 + k * 1024); } while (0)
#define PG8_LDB(dst, b, h) do { _Pragma("unroll") for (int n = 0; n < 2; ++n) _Pragma("unroll") for (int k = 0; k < 2; ++k) dst[n][k] = *(const LAS bf16x8*)(lds + PG8_SB(b, h) + boff + n * 2048 + k * 1024); } while (0)
#define PG8_MMA_T(T8, ai, bj, At, Bt) do { __builtin_amdgcn_s_setprio(1); \
        if constexpr (T8) { _Pragma("unroll") for (int m = 0; m < 4; ++m) _Pragma("unroll") for (int n = 0; n < 2; ++n) { \
            const i32x4 b0_ = __builtin_bit_cast(i32x4, Bt[n][0]), b1_ = __builtin_bit_cast(i32x4, Bt[n][1]), a0_ = __builtin_bit_cast(i32x4, At[m][0]), a1_ = __builtin_bit_cast(i32x4, At[m][1]); \
            const i32x8 bb_ = __builtin_shufflevector(b0_, b1_, 0, 1, 2, 3, 4, 5, 6, 7), aa_ = __builtin_shufflevector(a0_, a1_, 0, 1, 2, 3, 4, 5, 6, 7); \
            asm volatile("v_mfma_scale_f32_16x16x128_f8f6f4 %0, %1, %2, %0, %3, %3 op_sel_hi:[0,0,0]" : "+v"(acc[ai][bj][m][n]) : "v"(bb_), "v"(aa_), "v"(f8one)); } } \
        else if constexpr (PG8_NOCLEAR) { _Pragma("unroll") for (int k = 0; k < 2; ++k) _Pragma("unroll") for (int m = 0; m < 4; ++m) _Pragma("unroll") for (int n = 0; n < 2; ++n) \
            asm volatile("v_mfma_f32_16x16x32_bf16 %0, %1, %2, %0" : "+v"(acc[ai][bj][m][n]) : "v"(Bt[n][k]), "v"(At[m][k])); } \
        else { _Pragma("unroll") for (int m = 0; m < 4; ++m) _Pragma("unroll") for (int n = 0; n < 2; ++n) _Pragma("unroll") for (int k = 0; k < 2; ++k) \
            acc[ai][bj][m][n] = __builtin_amdgcn_mfma_f32_16x16x32_bf16(Bt[n][k], At[m][k], acc[ai][bj][m][n], 0, 0, 0); } \
        __builtin_amdgcn_s_setprio(0); } while (0)
#define PG8_MMA0_T(T8, ai, bj, At, Bt) do { __builtin_amdgcn_s_setprio(1); \
        if constexpr (T8) { _Pragma("unroll") for (int m = 0; m < 4; ++m) _Pragma("unroll") for (int n = 0; n < 2; ++n) { \
            const i32x4 b0_ = __builtin_bit_cast(i32x4, Bt[n][0]), b1_ = __builtin_bit_cast(i32x4, Bt[n][1]), a0_ = __builtin_bit_cast(i32x4, At[m][0]), a1_ = __builtin_bit_cast(i32x4, At[m][1]); \
            const i32x8 bb_ = __builtin_shufflevector(b0_, b1_, 0, 1, 2, 3, 4, 5, 6, 7), aa_ = __builtin_shufflevector(a0_, a1_, 0, 1, 2, 3, 4, 5, 6, 7); \
            asm volatile("v_mfma_scale_f32_16x16x128_f8f6f4 %0, %1, %2, 0, %3, %3 op_sel_hi:[0,0,0]" : "=&v"(acc[ai][bj][m][n]) : "v"(bb_), "v"(aa_), "v"(f8one)); } } \
        else { _Pragma("unroll") for (int m = 0; m < 4; ++m) _Pragma("unroll") for (int n = 0; n < 2; ++n) \
                asm volatile("v_mfma_f32_16x16x32_bf16 %0, %1, %2, 0" : "=&v"(acc[ai][bj][m][n]) : "v"(Bt[n][0]), "v"(At[m][0])); \
            _Pragma("unroll") for (int m = 0; m < 4; ++m) _Pragma("unroll") for (int n = 0; n < 2; ++n) \
                asm volatile("v_mfma_f32_16x16x32_bf16 %0, %1, %2, %0" : "+v"(acc[ai][bj][m][n]) : "v"(Bt[n][1]), "v"(At[m][1])); } \
        __builtin_amdgcn_s_setprio(0); } while (0)
#define PG8_MMA_A(ai, bj, At, Bt) PG8_MMA_T(T0, ai, bj, At, Bt)
#define PG8_MMA0_A(ai, bj, At, Bt) PG8_MMA0_T(T0, ai, bj, At, Bt)
#define PG8_MMA_B(ai, bj, At, Bt) PG8_MMA_T(T1, ai, bj, At, Bt)
#define PG8_WAIT_V(n) asm volatile("s_waitcnt vmcnt(" #n ")" ::: "memory")
#define PG8_WAIT_L(n) asm volatile("s_waitcnt lgkmcnt(" #n ")" ::: "memory")
#define PG8_BAR __builtin_amdgcn_s_barrier()
#define PG8_SCHED __builtin_amdgcn_sched_barrier(0)
    Unit cur, nxt; int ui = 0;
    if (!S.next(0, cur)) return;
    cur.newpm = 1;
    if (probe) pr_t0 = __builtin_amdgcn_s_memrealtime();
    if constexpr (GATHER) {
#pragma unroll
        for (int h = 0; h < 2; ++h)
#pragma unroll
            for (int i = 0; i < 2; ++i) voffA[h][i] = (unsigned)S.tok[cur.pm * BM + h * HALF + RA[i]] * (unsigned)(lda * 2) + CA2[i];
    }
    f32x4 acc[2][2][4][2];
#pragma unroll
    for (int a = 0; a < 2; ++a)
#pragma unroll
        for (int b = 0; b < 2; ++b)
#pragma unroll
            for (int m = 0; m < 4; ++m)
#pragma unroll
                for (int n = 0; n < 2; ++n) acc[a][b][m][n] = (f32x4){0.f, 0.f, 0.f, 0.f};
    bf16x8 At[4][2], B0[2][2], B1[2][2]; const int f8one = 0x7f7f7f7f;
    const char* cA = S.a_base(cur); const char* cB = S.b_base(cur);
    PG8_STAGE(PG8_SB(0, 0), cB, voffB); PG8_STAGE(PG8_SB(0, 1), cB + hstepB, voffB); PG8_STAGE(PG8_SA(0, 0), cA, voffA[0]); PG8_STAGE(PG8_SA(0, 1), cA, voffA[1]);
    if (wr == 1) PG8_BAR;
    PG8_WAIT_V(2); PG8_BAR;
    PG8_STAGE(PG8_SB(1, 0), cB + kstep, voffB); PG8_STAGE(PG8_SA(1, 0), cA + kstep, voffA[0]); PG8_STAGE(PG8_SB(1, 1), cB + hstepB + kstep, voffB);
    PG8_WAIT_V(6); PG8_BAR;
    for (;;) {
        const bool has_next = S.next(ui + 1, nxt);
        const char* nA = has_next ? S.a_base(nxt) : cA; const char* nB = has_next ? S.b_base(nxt) : cB;
        if constexpr (GATHER) {
            if (has_next) {
#pragma unroll
                for (int h = 0; h < 2; ++h)
#pragma unroll
                    for (int i = 0; i < 2; ++i) nvoffA[h][i] = (unsigned)S.tok[nxt.pm * BM + h * HALF + RA[i]] * (unsigned)(lda * 2) + CA2[i];
            } else {
#pragma unroll
                for (int h = 0; h < 2; ++h)
#pragma unroll
                    for (int i = 0; i < 2; ++i) nvoffA[h][i] = voffA[h][i];
            }
        }
        if (probe) pr_a = __builtin_amdgcn_s_memrealtime();
#define PG8_ITER(MM0, MM1) { \
            const bool last = (t == nt - 2); \
            const char* a1 = cA + (size_t)(t + 1) * kstep + ((F8FROM > 0 && t >= F8FROM) ? adelta : 0); \
            const char* a2 = last ? nA : cA + (size_t)(t + 2) * kstep + ((F8FROM > 0 && t + 2 >= F8FROM) ? adelta : 0); const char* b2 = last ? nB : cB + (size_t)(t + 2) * kstep; \
            const char* a3 = a2 + kstep; const char* b3 = b2 + kstep; \
            unsigned v2[2][2]; \
            _Pragma("unroll") for (int h = 0; h < 2; ++h) _Pragma("unroll") for (int i = 0; i < 2; ++i) v2[h][i] = (GATHER && last) ? nvoffA[h][i] : voffA[h][i]; \
              \
            PG8_LDB(B0, 0, 0); PG8_LDB(B1, 0, 1); PG8_SCHED; PG8_LDA(At, 0, 0); PG8_STAGE(PG8_SA(1, 1), a1, voffA[1]); \
            PG8_WAIT_V(8); PG8_WAIT_L(0); PG8_BAR; MM0(0, 0, At, B0); MM0(0, 1, At, B1); PG8_BAR; PG8_SCHED; \
              \
            PG8_LDA(At, 0, 1); PG8_STAGE(PG8_SB(0, 0), b2, voffB); PG8_STAGE(PG8_SB(0, 1), b2 + hstepB, voffB); PG8_STAGE(PG8_SA(0, 0), a2, v2[0]); \
            PG8_WAIT_V(8); PG8_WAIT_L(0); PG8_BAR; MM0(1, 0, At, B0); MM0(1, 1, At, B1); PG8_BAR; PG8_SCHED; \
              \
            PG8_LDB(B0, 1, 0); PG8_LDB(B1, 1, 1); PG8_SCHED; PG8_LDA(At, 1, 0); PG8_STAGE(PG8_SA(0, 1), a2, v2[1]); \
            PG8_WAIT_V(8); PG8_WAIT_L(0); PG8_BAR; MM1(0, 0, At, B0); MM1(0, 1, At, B1); PG8_BAR; PG8_SCHED; \
              \
            PG8_LDA(At, 1, 1); PG8_STAGE(PG8_SB(1, 0), b3, voffB); PG8_STAGE(PG8_SB(1, 1), b3 + hstepB, voffB); PG8_STAGE(PG8_SA(1, 0), a3, v2[0]); \
            PG8_WAIT_V(8); PG8_WAIT_L(0); PG8_BAR; MM1(1, 0, At, B0); MM1(1, 1, At, B1); PG8_BAR; PG8_SCHED; }
        int t = 0;
        if constexpr (PG8_NOCLEAR) { PG8_ITER(PG8_MMA0_A, PG8_MMA_A) t = 2; }
        if constexpr (F8FROM > 0) { for (; t < F8FROM; t += 2) PG8_ITER(PG8_MMA_A, PG8_MMA_A) }
        for (; t < nt; t += 2) PG8_ITER(PG8_MMA_B, PG8_MMA_B)
#undef PG8_ITER
        if constexpr (FP8 || PG8_NOCLEAR) asm volatile("s_nop 15\n\ts_nop 7" ::: "memory");
        if (probe) { pr_b = __builtin_amdgcn_s_memrealtime(); pr_k += pr_b - pr_a; }
        if constexpr (ALIGN_EPI) { if (wr == 0) PG8_BAR; }
        if (!noepi) { int fr_o = fr, fq_o = fq; asm volatile("" : "+v"(fr_o), "+v"(fq_o));
            E(acc, cur, wr, wc, fr_o, fq_o); }
        if (probe) { asm volatile("s_waitcnt vmcnt(0)" ::: "memory"); pr_e += __builtin_amdgcn_s_memrealtime() - pr_b; ++pr_n; }
        if (!has_next) break;
        if constexpr (!PG8_NOCLEAR) {
#pragma unroll
        for (int a = 0; a < 2; ++a)
#pragma unroll
            for (int b = 0; b < 2; ++b)
#pragma unroll
                for (int m = 0; m < 4; ++m)
#pragma unroll
                    for (int n = 0; n < 2; ++n) acc[a][b][m][n] = (f32x4){0.f, 0.f, 0.f, 0.f};
        }
        nxt.newpm = (nxt.pm != cur.pm); cur = nxt; cA = nA; cB = nB; ++ui;
        if constexpr (GATHER) {
#pragma unroll
            for (int h = 0; h < 2; ++h)
#pragma unroll
                for (int i = 0; i < 2; ++i) voffA[h][i] = nvoffA[h][i];
        }
        if constexpr (ALIGN_EPI) { if (wr == 1) PG8_BAR; }
    }
    PG8_WAIT_V(0);
    if constexpr (!ALIGN_EPI) { if (wr == 0) PG8_BAR; }
    PG8_BAR;
    if (probe && blockIdx.x == 0 && tid == 0) { probe[0] = pr_k; probe[1] = pr_e; probe[2] = __builtin_amdgcn_s_memrealtime() - pr_t0; probe[3] = pr_n; }
#undef PG8_SA
#undef PG8_SB
#undef PG8_STAGE
#undef PG8_LDA
#undef PG8_LDB
#undef PG8_MMA_T
#undef PG8_MMA0_T
#undef PG8_MMA_A
#undef PG8_MMA0_A
#undef PG8_MMA_B
#undef PG8_WAIT_V
#undef PG8_WAIT_L
#undef PG8_BAR
#undef PG8_SCHED
}
struct SchedDense {
    StaticOrder so; const char* A; const char* B; size_t tstepA, tstepB; int acol_shift; size_t acol_bytes; const int* tok;
    __device__ __forceinline__ bool next(int i, Unit& u) const { return so.next(i, u); }
    __device__ __forceinline__ const char* a_base(const Unit& u) const { return A + (size_t)u.pm * tstepA + (acol_shift >= 0 ? (size_t)(u.pn >> acol_shift) * acol_bytes : 0); }
    __device__ __forceinline__ const char* b_base(const Unit& u) const { return B + (size_t)u.pn * tstepB; }
};
struct SchedMoe {
    StaticOrder so; const char* A; const char* B; size_t tstepA, tstepB, estrideB; int eo[9]; const int* tok; bool gather;
    __device__ __forceinline__ bool next(int i, Unit& u) const { return so.next(i, u); }
    __device__ __forceinline__ int expert(int pm) const { int e = 0;
#pragma unroll
        for (int x = 1; x < 8; ++x) e += (pm * 256 >= eo[x]); return e; }
    __device__ __forceinline__ const char* a_base(const Unit& u) const { return gather ? A : A + (size_t)u.pm * tstepA; }
    __device__ __forceinline__ const char* b_base(const Unit& u) const { return B + (size_t)expert(u.pm) * estrideB + (size_t)u.pn * tstepB; }
};
}

__device__ __forceinline__ float rsq_mean(float ssum) { return __builtin_amdgcn_rsqf(ssum * (1.0f / D) + RMS_EPS); }
__device__ __forceinline__ void rs_tile_to_lds(const float* ssq, int pm, LAS float* rsl) {
    const int tid = threadIdx.x;
    if (tid < 256) {
        const f32x4* p = (const f32x4*)(ssq + (size_t)(pm * 256 + tid) * 32); f32x4 v[8];
#pragma unroll
        for (int i = 0; i < 8; ++i) v[i] = p[i];
        float sm = 0.f;
#pragma unroll
        for (int i = 0; i < 8; ++i) sm += (v[i].x + v[i].y) + (v[i].z + v[i].w);
        rsl[tid] = rsq_mean(sm);
    }
    asm volatile("s_waitcnt lgkmcnt(0)" ::: "memory"); __builtin_amdgcn_s_barrier(); asm volatile("" ::: "memory");
}
__device__ __forceinline__ void store8(bf16* p, const f32x4 v0, const f32x4 v1) {
    u32x4 w; w.x = pk2(v0[0], v0[1]); w.y = pk2(v0[2], v0[3]); w.z = pk2(v1[0], v1[1]); w.w = pk2(v1[2], v1[3]); *(u32x4*)p = w;
}
struct EpiEvIn {
    const float* ssq0; bf16 *U, *VA, *Q, *Kb, *V; int pn_off; float cs;
    __device__ __forceinline__ void operator()(const f32x4 (&acc)[2][2][4][2], const Unit& u, int wr, int wc, int fr, int fq) const {
        const int row0 = u.pm * 256 + wr * 64 + fr, cw = wc * 32 + 8 * fq;
        const int pn = u.pn + pn_off;
        float rs8[2][4];
#pragma unroll
        for (int ai = 0; ai < 2; ++ai)
#pragma unroll
            for (int m = 0; m < 4; ++m) rs8[ai][m] = ssq0[row0 + ai * 128 + m * 16];
        float invf[2][2];
#pragma unroll
        for (int n = 0; n < 2; ++n)
#pragma unroll
            for (int jj = 0; jj < 2; ++jj) { const int i = 16 * wc + 4 * fq + 2 * n + jj; invf[n][jj] = __builtin_amdgcn_exp2f(-13.287712379549449f * (float)i * (1.0f / 64.0f)) * 0.15915494309189535f; }
#pragma unroll
        for (int ai = 0; ai < 2; ++ai)
#pragma unroll
            for (int m = 0; m < 4; ++m) {
                const int r = row0 + ai * 128 + m * 16;
                const float rs = rsq_mean(rs8[ai][m]) * cs;
                const float pos = (float)(r & (S - 1));
#pragma unroll
                for (int bj = 0; bj < 2; ++bj) {
                    f32x4 v0 = acc[ai][bj][m][0] * rs, v1 = acc[ai][bj][m][1] * rs;
                    if (pn < 4) {
                        gelu8(v0, v1);
                        bf16* dst = (pn < 2 ? U : VA) + (size_t)r * DA + (pn & 1) * 256 + bj * 128 + cw;
                        store8(dst, v0, v1);
                    } else if (pn < 16) {
#pragma unroll
                        for (int n = 0; n < 2; ++n) {
                            f32x4& v = n ? v1 : v0;
                            const f32x2 c2 = (f32x2){invf[n][0], invf[n][1]}, p2 = (f32x2){pos, pos};
                            const f32x2 hi = p2 * c2; const f32x2 lo = (f32x2){__builtin_fmaf(pos, c2.x, -hi.x), __builtin_fmaf(pos, c2.y, -hi.y)};
                            const f32x2 fr2 = (hi - (f32x2){floorf(hi.x), floorf(hi.y)}) + lo;
#pragma unroll
                            for (int jj = 0; jj < 2; ++jj) {
                                const float fr_ = jj ? fr2.y : fr2.x;
                                const float sn = __builtin_amdgcn_sinf(fr_), cs = __builtin_amdgcn_cosf(fr_);
                                const f32x2 x = (f32x2){v[2 * jj], v[2 * jj + 1]}, xs = (f32x2){-v[2 * jj + 1], v[2 * jj]};
                                const f32x2 y = x * cs + xs * sn;
                                v[2 * jj] = y.x; v[2 * jj + 1] = y.y;
                            }
                        }
                        const int t = (pn < 10) ? pn - 4 : pn - 10;
                        bf16* dst = (pn < 10 ? Q : Kb) + (size_t)r * DB + t * 256 + bj * 128 + cw;
                        store8(dst, v0, v1);
                    } else {
                        bf16* dst = V + (size_t)r * DB + (pn - 16) * 256 + bj * 128 + cw;
                        store8(dst, v0, v1);
                    }
                }
            }
    }
};
template <bool F32IN, int X8OUT = 0> struct EpiResid {
    const float* xi; bf16* XB; float* ssq; float cs;
    __device__ __forceinline__ void operator()(const f32x4 (&acc)[2][2][4][2], const Unit& u, int wr, int wc, int fr, int fq) const {
        const int row0 = u.pm * 256 + wr * 64 + fr, col0 = u.pn * 256 + wc * 32 + 8 * fq;
        if constexpr (!F32IN) {
            u32x4 xin[4][2][2];
#define ER_LOAD(G) do { _Pragma("unroll") for (int mm = 0; mm < 2; ++mm) _Pragma("unroll") for (int bj = 0; bj < 2; ++bj) \
                xin[G][mm][bj] = *(const u32x4*)(XB + (size_t)(row0 + ((G) >> 1) * 128 + (2 * ((G) & 1) + mm) * 16) * D + col0 + bj * 128); } while (0)
#define ER_USE(G) do { _Pragma("unroll") for (int mm = 0; mm < 2; ++mm) { const int ai = (G) >> 1, m = 2 * ((G) & 1) + mm; const int r = row0 + ai * 128 + m * 16; float sq; f32x2 sq2 = (f32x2){0.f, 0.f}; \
                _Pragma("unroll") for (int bj = 0; bj < 2; ++bj) { const size_t off = (size_t)r * D + col0 + bj * 128; const u32x4 w = xin[G][mm][bj]; \
                    const f32x4 x0 = (f32x4){bflo(w.x), bfhi(w.x), bflo(w.y), bfhi(w.y)}, x1 = (f32x4){bflo(w.z), bfhi(w.z), bflo(w.w), bfhi(w.w)}; \
                    const f32x4 v0 = x0 + acc[ai][bj][m][0] * cs, v1 = x1 + acc[ai][bj][m][1] * cs; \
                    store8(XB + off, v0, v1); \
                    if constexpr (X8OUT == 1) { u32x2 o8_; o8_.x = pk4_f8(v0.x * F8_SX, v0.y * F8_SX, v0.z * F8_SX, v0.w * F8_SX); o8_.y = pk4_f8(v1.x * F8_SX, v1.y * F8_SX, v1.z * F8_SX, v1.w * F8_SX); *(u32x2*)((unsigned char*)XB + X18_DELTA + off) = o8_; } \
                    sq2 = (f32x2){v0.x, v0.y} * (f32x2){v0.x, v0.y} + sq2; sq2 = (f32x2){v0.z, v0.w} * (f32x2){v0.z, v0.w} + sq2; \
                    sq2 = (f32x2){v1.x, v1.y} * (f32x2){v1.x, v1.y} + sq2; sq2 = (f32x2){v1.z, v1.w} * (f32x2){v1.z, v1.w} + sq2; } \
                sq = sq2.x + sq2.y; sq += __shfl_xor(sq, 16); sq += __shfl_xor(sq, 32); \
                if (fq == 0) ssq[(size_t)r * 32 + u.pn * 4 + wc] = sq; } } while (0)
            ER_LOAD(0); ER_LOAD(1); ER_LOAD(2); asm volatile("" ::: "memory");
            ER_USE(0); asm volatile("" ::: "memory"); ER_LOAD(3); asm volatile("" ::: "memory");
            ER_USE(1); ER_USE(2); ER_USE(3);
#undef ER_LOAD
#undef ER_USE
        } else {
#pragma unroll
        for (int ai = 0; ai < 2; ++ai) {
            f32x4 xin[4][2][2];
#pragma unroll
            for (int m = 0; m < 4; ++m)
#pragma unroll
                for (int bj = 0; bj < 2; ++bj) {
                    const size_t off = (size_t)(row0 + ai * 128 + m * 16) * D + col0 + bj * 128;
                    xin[m][bj][0] = *(const f32x4*)(xi + off); xin[m][bj][1] = *(const f32x4*)(xi + off + 4);
                }
            asm volatile("" ::: "memory");
#pragma unroll
            for (int m = 0; m < 4; ++m) {
                const int r = row0 + ai * 128 + m * 16; float sq = 0.f;
#pragma unroll
                for (int bj = 0; bj < 2; ++bj) {
                    const size_t off = (size_t)r * D + col0 + bj * 128;
                    const f32x4 v0 = xin[m][bj][0] + acc[ai][bj][m][0] * cs, v1 = xin[m][bj][1] + acc[ai][bj][m][1] * cs;
                    store8(XB + off, v0, v1);
                    if constexpr (X8OUT == 1) { u32x2 o; o.x = pk4_f8(v0.x * F8_SX, v0.y * F8_SX, v0.z * F8_SX, v0.w * F8_SX); o.y = pk4_f8(v1.x * F8_SX, v1.y * F8_SX, v1.z * F8_SX, v1.w * F8_SX); *(u32x2*)((unsigned char*)XB + X18_DELTA + off) = o; }
                    if constexpr (X8OUT == 2) { if (u.pn * 256 >= FGU_KB) { u32x2 o; o.x = pk4_f8(v0.x, v0.y, v0.z, v0.w); o.y = pk4_f8(v1.x, v1.y, v1.z, v1.w);
                        *(u32x2*)((unsigned char*)XB + X18_DELTA + (size_t)r * (2 * D) + 2 * FGU_KB + (col0 + bj * 128 - FGU_KB)) = o; } }
                    sq += (v0.x * v0.x + v0.y * v0.y) + (v0.z * v0.z + v0.w * v0.w) + (v1.x * v1.x + v1.y * v1.y) + (v1.z * v1.z + v1.w * v1.w);
                }
                sq += __shfl_xor(sq, 16); sq += __shfl_xor(sq, 32);
                if (fq == 0) ssq[(size_t)r * 32 + u.pn * 4 + wc] = sq;
            }
            asm volatile("" ::: "memory");
        }
        }
    }
};
template <bool MOE, bool F8OUT = MOE> struct EpiGateUp {
    const float* ssq; bf16* H; int ldh; const float* rsr; const float* gw; LAS float* rsl; float ascale;
    __device__ __forceinline__ void operator()(const f32x4 (&acc)[2][2][4][2], const Unit& u, int wr, int wc, int fr, int fq) const {
        const int rl0 = wr * 64 + fr, row0 = u.pm * 256 + rl0, col0 = u.pn * 128 + wc * 32 + 8 * fq;
        float rs8[2][4], w8[2][4];
        if (MOE) {
#pragma unroll
            for (int ai = 0; ai < 2; ++ai)
#pragma unroll
                for (int m = 0; m < 4; ++m) { rs8[ai][m] = rsr[row0 + ai * 128 + m * 16] * (1.0f / (F8_SX * F8_SW)); w8[ai][m] = gw[row0 + ai * 128 + m * 16] * F8_SH; }
        } else {
            if (u.newpm) rs_tile_to_lds(ssq, u.pm, rsl);
#pragma unroll
            for (int ai = 0; ai < 2; ++ai)
#pragma unroll
                for (int m = 0; m < 4; ++m) { rs8[ai][m] = rsl[rl0 + ai * 128 + m * 16] * ascale; w8[ai][m] = F8OUT ? F8_SH : 1.0f; }
        }
#pragma unroll
        for (int ai = 0; ai < 2; ++ai)
#pragma unroll
            for (int m = 0; m < 4; ++m) {
                const int r = row0 + ai * 128 + m * 16; const float rs = rs8[ai][m];
                const float nrs = rs * -1.44269504089f, kk = rs * rs * w8[ai][m];
                f32x4 h0, h1;
#pragma unroll
                for (int n = 0; n < 2; ++n)
#pragma unroll
                    for (int jp = 0; jp < 2; ++jp) {
                        const f32x2 g2 = (f32x2){acc[ai][0][m][n][2 * jp], acc[ai][0][m][n][2 * jp + 1]}, u2 = (f32x2){acc[ai][1][m][n][2 * jp], acc[ai][1][m][n][2 * jp + 1]};
                        const f32x2 t2 = g2 * nrs;
                        const f32x2 d2 = (f32x2){__builtin_amdgcn_exp2f(t2.x), __builtin_amdgcn_exp2f(t2.y)} + 1.0f;
                        const f32x2 r2 = (f32x2){__builtin_amdgcn_rcpf(d2.x), __builtin_amdgcn_rcpf(d2.y)};
                        const f32x2 h2 = ((g2 * u2) * kk) * r2;
                        if (n == 0) { h0[2 * jp] = h2.x; h0[2 * jp + 1] = h2.y; } else { h1[2 * jp] = h2.x; h1[2 * jp + 1] = h2.y; }
                    }
                if (F8OUT) { u32x2 o; o.x = pk4_f8(h0[0], h0[1], h0[2], h0[3]); o.y = pk4_f8(h1[0], h1[1], h1[2], h1[3]); *(u32x2*)((unsigned char*)H + (size_t)r * ldh + col0) = o; }
                else store8(H + (size_t)r * ldh + col0, h0, h1);
            }
    }
};
struct EpiOdIn {
    const float* ssq; bf16 *Gb, *XR; LAS float* rsl; float ascale;
    __device__ __forceinline__ void operator()(const f32x4 (&acc)[2][2][4][2], const Unit& u, int wr, int wc, int fr, int fq) const {
        const int rl0 = wr * 64 + fr, row0 = u.pm * 256 + rl0, cw = wc * 32 + 8 * fq;
        const bool isg = u.pn < 10; const int cb = (isg ? u.pn : u.pn - 10) * 256;
        if (u.newpm) rs_tile_to_lds(ssq, u.pm, rsl);
        float rs8[2][4];
#pragma unroll
        for (int ai = 0; ai < 2; ++ai)
#pragma unroll
            for (int m = 0; m < 4; ++m) rs8[ai][m] = rsl[rl0 + ai * 128 + m * 16] * ascale;
#pragma unroll
        for (int ai = 0; ai < 2; ++ai)
#pragma unroll
            for (int m = 0; m < 4; ++m) {
                const int r = row0 + ai * 128 + m * 16;
                const float rs = rs8[ai][m];
#pragma unroll
                for (int bj = 0; bj < 2; ++bj) {
                    f32x4 v0 = acc[ai][bj][m][0] * rs, v1 = acc[ai][bj][m][1] * rs;
                    if (isg) gelu8(v0, v1);
                    store8((isg ? Gb : XR) + (size_t)r * DRNN + cb + bj * 128 + cw, v0, v1);
                }
            }
    }
};
struct EpiGates {
    const bf16* XC; const float *b_a, *b_x, *sp8; bf16 *LA, *BT;
    __device__ __forceinline__ void operator()(const f32x4 (&acc)[2][2][4][2], const Unit& u, int wr, int wc, int fr, int fq) const {
        const int row0 = u.pm * 256 + wr * 64 + fr, ch0 = u.pn * 128 + wc * 32 + 8 * fq;
        f32x4 ba[2], bx[2], sp[2];
#pragma unroll
        for (int n = 0; n < 2; ++n) { ba[n] = *(const f32x4*)(b_a + ch0 + 4 * n); bx[n] = *(const f32x4*)(b_x + ch0 + 4 * n); sp[n] = *(const f32x4*)(sp8 + ch0 + 4 * n); }
        f32x4 nba[2], nbx[2], sp2[2];
#pragma unroll
        for (int n = 0; n < 2; ++n) { nba[n] = ba[n] * -1.44269504089f; nbx[n] = bx[n] * -1.44269504089f; sp2[n] = sp[n] * 2.0f; }
#pragma unroll
        for (int ai = 0; ai < 2; ++ai) {
            u32x4 xw[4];
#pragma unroll
            for (int m = 0; m < 4; ++m) xw[m] = *(const u32x4*)(XC + (size_t)(row0 + ai * 128 + m * 16) * DRNN + ch0);
            asm volatile("" ::: "memory");
#pragma unroll
            for (int m = 0; m < 4; ++m) {
                const size_t o = (size_t)(row0 + ai * 128 + m * 16) * DRNN + ch0;
                const float xc[8] = {bflo(xw[m].x), bfhi(xw[m].x), bflo(xw[m].y), bfhi(xw[m].y), bflo(xw[m].z), bfhi(xw[m].z), bflo(xw[m].w), bfhi(xw[m].w)};
                f32x4 la[2], bt[2];
#pragma unroll
                for (int n = 0; n < 2; ++n)
#pragma unroll
                    for (int jp = 0; jp < 2; ++jp) {
                        const f32x2 pa = (f32x2){acc[ai][0][m][n][2 * jp], acc[ai][0][m][n][2 * jp + 1]}, px = (f32x2){acc[ai][1][m][n][2 * jp], acc[ai][1][m][n][2 * jp + 1]};
                        const f32x2 ta = pa * -1.44269504089f + (f32x2){nba[n][2 * jp], nba[n][2 * jp + 1]}, tx = px * -1.44269504089f + (f32x2){nbx[n][2 * jp], nbx[n][2 * jp + 1]};
                        const f32x2 ea = (f32x2){__builtin_amdgcn_exp2f(ta.x), __builtin_amdgcn_exp2f(ta.y)} + 1.0f, ex = (f32x2){__builtin_amdgcn_exp2f(tx.x), __builtin_amdgcn_exp2f(tx.y)} + 1.0f;
                        const f32x2 rg = (f32x2){__builtin_amdgcn_rcpf(ea.x), __builtin_amdgcn_rcpf(ea.y)}, ig = (f32x2){__builtin_amdgcn_rcpf(ex.x), __builtin_amdgcn_rcpf(ex.y)};
                        const f32x2 y = rg * (f32x2){sp2[n][2 * jp], sp2[n][2 * jp + 1]};
                        f32x2 b2; const f32x2 l2 = y * (0.5f * 1.4426950408889634f);
                        if constexpr (SCAN_SQRT) b2 = ig * (f32x2){xc[4 * n + 2 * jp], xc[4 * n + 2 * jp + 1]};
                        else {
                        f32x2 t = y * (1.0f / 720.0f) + (1.0f / 120.0f); t = t * y + (1.0f / 24.0f); t = t * y + (1.0f / 6.0f); t = t * y + 0.5f; t = t * y + 1.0f;
                        f32x2 om = t * -y;
                        if (__any(fminf(y.x, y.y) < -1.0f)) { asm volatile("" ::: "memory"); om.x = (y.x < -1.0f) ? 1.0f - fast_exp(y.x) : om.x; om.y = (y.y < -1.0f) ? 1.0f - fast_exp(y.y) : om.y; }
                        const f32x2 sq = (f32x2){__builtin_amdgcn_sqrtf(fmaxf(om.x, 0.f)), __builtin_amdgcn_sqrtf(fmaxf(om.y, 0.f))};
                        b2 = (sq * ig) * (f32x2){xc[4 * n + 2 * jp], xc[4 * n + 2 * jp + 1]};
                        }
                        bt[n][2 * jp] = b2.x; bt[n][2 * jp + 1] = b2.y; la[n][2 * jp] = l2.x; la[n][2 * jp + 1] = l2.y;
                    }
                store8(LA + o, la[0], la[1]); store8(BT + o, bt[0], bt[1]);
            }
            asm volatile("" ::: "memory");
        }
    }
};
struct EpiMoeDown {
    const int* dest; bf16 *Y0, *Y1;
    __device__ __forceinline__ void operator()(const f32x4 (&acc)[2][2][4][2], const Unit& u, int wr, int wc, int fr, int fq) const {
        const int row0 = u.pm * 256 + wr * 64 + fr, col0 = u.pn * 256 + wc * 32 + 8 * fq;
        int d8[2][4];
#pragma unroll
        for (int ai = 0; ai < 2; ++ai)
#pragma unroll
            for (int m = 0; m < 4; ++m) d8[ai][m] = dest[row0 + ai * 128 + m * 16];
#pragma unroll
        for (int ai = 0; ai < 2; ++ai)
#pragma unroll
            for (int m = 0; m < 4; ++m) {
                const int d = d8[ai][m];
                if (d >= 0) {
                    bf16* yp = (d >= M) ? Y1 + (size_t)(d - M) * D : Y0 + (size_t)d * D;
#pragma unroll
                    for (int bj = 0; bj < 2; ++bj) store8(yp + col0 + bj * 128, acc[ai][bj][m][0] * (1.0f / (F8_SH * F8_SW)), acc[ai][bj][m][1] * (1.0f / (F8_SH * F8_SW)));
                }
            }
    }
};

typedef short s16x4 __attribute__((ext_vector_type(4)));
template <int OFF> __device__ __forceinline__ s16x4 tr_read(unsigned vb) { s16x4 r; asm volatile("ds_read_b64_tr_b16 %0, %1 offset:%2" : "=&v"(r) : "v"(vb), "i"(OFF) : "memory"); return r; }
template <int P>
__device__ __forceinline__ void attn_pass(const Frame& F, unsigned lds_base, const bf16* Qb, const bf16* Kb, const bf16* Vb, bf16* CAT, float* LSE, unsigned char* CAT2 = nullptr) {
    typedef pg8::bf16x8 bf16x8;
    constexpr int d = (P == 0) ? 1 : (P == 1 ? 4 : 16);
    constexpr int NBLK = 128 / d;
    constexpr int KP = 272, VP = 288, VOFF = 256 * KP;
    LAS unsigned char* Kl = F.lds; LAS unsigned char* Vl = F.lds + VOFF;
    const int w = F.wave, lane = F.lane, fr = lane & 15, fq = lane >> 4;
    const unsigned vb = lds_base + VOFF + (unsigned)((16 * w + 4 * fq + ((lane & 15) >> 2)) * VP + (lane & 3) * 8);
    constexpr int NU = 2 * 12 * 128;
    u32x4 kreg[8], vreg[8];
#define ATT_FETCH(UU) do { const int bh_ = (UU) >> 7, rem_ = (UU) & 127; const int b_ = bh_ / 12, h_ = bh_ - b_ * 12; const int r_ = rem_ / NBLK, l0_ = (rem_ - r_ * NBLK) * 128; \
        const size_t rb_ = (size_t)b_ * S + r_; \
        _Pragma("unroll") for (int j = 0; j < 8; ++j) { const int pc = F.tid + NTHR * j, wi = pc >> 4, piece = pc & 15, lw = l0_ - 128 + wi; \
            kreg[j] = (u32x4){0u, 0u, 0u, 0u}; vreg[j] = (u32x4){0u, 0u, 0u, 0u}; \
            if (lw >= 0) { const size_t o = (rb_ + (size_t)lw * d) * DB + h_ * 128 + piece * 8; kreg[j] = *(const u32x4*)(Kb + o); vreg[j] = *(const u32x4*)(Vb + o); } } } while (0)
    if (F.bid < NU) ATT_FETCH(F.bid);
    for (int u = F.bid; u < NU; u += F.G) {
        const int bh = u >> 7, rem = u & 127; const int b = bh / 12, h = bh - b * 12; const int r = rem / NBLK, blk = rem - r * NBLK; const int l0 = blk * 128;
        const size_t rowbase = (size_t)b * S + r;
        const int lq = l0 + 16 * w + fr;
        const size_t qrow = rowbase + (size_t)lq * d;
        bf16x8 qf[4];
        { const bf16* qp = Qb + qrow * DB + h * 128 + 8 * fq;
#pragma unroll
          for (int kk = 0; kk < 4; ++kk) qf[kk] = *(const bf16x8*)(qp + 32 * kk); }
        bf16* op = CAT + qrow * D + DA + h * 128 + 4 * fq; float* lp = LSE + qrow * 12 + h;
        u32x2 pvo[8]; float lse1 = 0.f;
        if (P != 0) {
#pragma unroll
            for (int dt = 0; dt < 8; ++dt) pvo[dt] = *(const u32x2*)(op + 16 * dt);
            lse1 = *lp;
        }
        __syncthreads();
#pragma unroll
        for (int j = 0; j < 8; ++j) { const int pc = F.tid + NTHR * j, wi = pc >> 4, piece = pc & 15;
            *(LAS u32x4*)(Kl + wi * KP + piece * 16) = kreg[j]; *(LAS u32x4*)(Vl + wi * VP + piece * 16) = vreg[j]; }
        if (u + F.G < NU) ATT_FETCH(u + F.G);
        __syncthreads();
        f32x4 sacc[9];
        const LAS unsigned char* kb = Kl + (16 * w + fr) * KP + fq * 16;
#pragma unroll
        for (int t = 0; t < 9; ++t) { sacc[t] = (f32x4){0.f, 0.f, 0.f, 0.f};
#pragma unroll
            for (int kk = 0; kk < 4; ++kk) { const bf16x8 kf = *(const LAS bf16x8*)(kb + t * 16 * KP + kk * 64); sacc[t] = __builtin_amdgcn_mfma_f32_16x16x32_bf16(kf, qf[kk], sacc[t], 0, 0, 0); } }
#pragma unroll
        for (int i = 0; i < 4; ++i) { if (fr > 4 * fq + i) sacc[0][i] = -INFINITY; if (fr < 4 * fq + i) sacc[8][i] = -INFINITY; }
        if (l0 == 0) {
#pragma unroll
            for (int t = 0; t < 8; ++t)
#pragma unroll
                for (int i = 0; i < 4; ++i) if (16 * w + 16 * t + 4 * fq + i < 128) sacc[t][i] = -INFINITY;
        }
        float mx = -INFINITY;
#pragma unroll
        for (int t = 0; t < 9; ++t)
#pragma unroll
            for (int i = 0; i < 4; ++i) mx = fmaxf(mx, sacc[t][i]);
        mx = fmaxf(mx, __shfl_xor(mx, 16)); mx = fmaxf(mx, __shfl_xor(mx, 32));
        float l = 0.f;
#pragma unroll
        for (int t = 0; t < 9; ++t)
#pragma unroll
            for (int i = 0; i < 4; ++i) { const float pv = __builtin_amdgcn_exp2f(sacc[t][i] - mx); sacc[t][i] = pv; l += pv; }
        l += __shfl_xor(l, 16); l += __shfl_xor(l, 32);
        f32x4 oacc[8];
#pragma unroll
        for (int dt = 0; dt < 8; ++dt) oacc[dt] = (f32x4){0.f, 0.f, 0.f, 0.f};
#define ATT_PV(T0, T1, HAS1) do { \
            bf16x8 pk; { const unsigned a0 = pk2(sacc[T0][0], sacc[T0][1]), a1 = pk2(sacc[T0][2], sacc[T0][3]); \
                unsigned b0 = 0u, b1 = 0u; if (HAS1) { b0 = pk2(sacc[(HAS1) ? (T1) : 0][0], sacc[(HAS1) ? (T1) : 0][1]); b1 = pk2(sacc[(HAS1) ? (T1) : 0][2], sacc[(HAS1) ? (T1) : 0][3]); } \
                const u32x4 pw = (u32x4){a0, a1, b0, b1}; pk = __builtin_bit_cast(bf16x8, pw); } \
            s16x4 va[8], vc[8]; \
            va[0] = tr_read<(T0) * 16 * VP + 0 * 32>(vb); vc[0] = tr_read<((HAS1) ? (T1) : (T0)) * 16 * VP + 0 * 32>(vb); \
            va[1] = tr_read<(T0) * 16 * VP + 1 * 32>(vb); vc[1] = tr_read<((HAS1) ? (T1) : (T0)) * 16 * VP + 1 * 32>(vb); \
            va[2] = tr_read<(T0) * 16 * VP + 2 * 32>(vb); vc[2] = tr_read<((HAS1) ? (T1) : (T0)) * 16 * VP + 2 * 32>(vb); \
            va[3] = tr_read<(T0) * 16 * VP + 3 * 32>(vb); vc[3] = tr_read<((HAS1) ? (T1) : (T0)) * 16 * VP + 3 * 32>(vb); \
            va[4] = tr_read<(T0) * 16 * VP + 4 * 32>(vb); vc[4] = tr_read<((HAS1) ? (T1) : (T0)) * 16 * VP + 4 * 32>(vb); \
            va[5] = tr_read<(T0) * 16 * VP + 5 * 32>(vb); vc[5] = tr_read<((HAS1) ? (T1) : (T0)) * 16 * VP + 5 * 32>(vb); \
            va[6] = tr_read<(T0) * 16 * VP + 6 * 32>(vb); vc[6] = tr_read<((HAS1) ? (T1) : (T0)) * 16 * VP + 6 * 32>(vb); \
            va[7] = tr_read<(T0) * 16 * VP + 7 * 32>(vb); vc[7] = tr_read<((HAS1) ? (T1) : (T0)) * 16 * VP + 7 * 32>(vb); \
            asm volatile("s_waitcnt lgkmcnt(0)" ::: "memory"); __builtin_amdgcn_sched_barrier(0); \
            _Pragma("unroll") for (int dt = 0; dt < 8; ++dt) { const bf16x8 vf = (bf16x8){va[dt][0], va[dt][1], va[dt][2], va[dt][3], vc[dt][0], vc[dt][1], vc[dt][2], vc[dt][3]}; \
                oacc[dt] = __builtin_amdgcn_mfma_f32_16x16x32_bf16(vf, pk, oacc[dt], 0, 0, 0); } \
            __builtin_amdgcn_sched_barrier(0); } while (0)
        ATT_PV(0, 1, 1); ATT_PV(2, 3, 1); ATT_PV(4, 5, 1); ATT_PV(6, 7, 1); ATT_PV(8, 8, 0);
#undef ATT_PV
        const float inv = 1.0f / l; const float lse2 = mx + __builtin_amdgcn_logf(l);
        if (P == 0) {
#pragma unroll
            for (int dt = 0; dt < 8; ++dt) { u32x2 o; o.x = pk2(oacc[dt][0] * inv, oacc[dt][1] * inv); o.y = pk2(oacc[dt][2] * inv, oacc[dt][3] * inv); *(u32x2*)(op + 16 * dt) = o; }
            if (fq == 0) *lp = lse2;
        } else {
            const float mn = fmaxf(lse1, lse2); const float w1 = __builtin_amdgcn_exp2f(lse1 - mn), w2 = __builtin_amdgcn_exp2f(lse2 - mn);
            const float wsum = w1 + w2; const float a1 = w1 / wsum, a2 = (w2 / wsum) * inv;
            if (P == 2 && EVOUT_MIXED) {
                unsigned char* o8 = CAT2 + qrow * C2P + 2 * DA + h * 128 + 4 * fq; const float b1 = a1 * F8_SX, b2 = a2 * F8_SX;
#pragma unroll
                for (int dt = 0; dt < 8; ++dt) { const u32x2 pv = pvo[dt];
                    *(unsigned*)(o8 + 16 * dt) = pk4_f8(b1 * bflo(pv.x) + b2 * oacc[dt][0], b1 * bfhi(pv.x) + b2 * oacc[dt][1], b1 * bflo(pv.y) + b2 * oacc[dt][2], b1 * bfhi(pv.y) + b2 * oacc[dt][3]); }
            } else {
#pragma unroll
            for (int dt = 0; dt < 8; ++dt) { const u32x2 pv = pvo[dt];
                u32x2 o; o.x = pk2(a1 * bflo(pv.x) + a2 * oacc[dt][0], a1 * bfhi(pv.x) + a2 * oacc[dt][1]); o.y = pk2(a1 * bflo(pv.y) + a2 * oacc[dt][2], a1 * bfhi(pv.y) + a2 * oacc[dt][3]); *(u32x2*)(op + 16 * dt) = o; }
            if (fq == 0) *lp = mn + __builtin_amdgcn_logf(wsum);
            }
        }
    }
#undef ATT_FETCH
    __syncthreads();
}

struct Args { const float* in[28]; float* out; unsigned char* ws; int ph_lo, ph_hi, li, noepi; };
enum { I_X = 0, I_EV_NORM_MIX, I_EV_W_IN, I_EV_LN_G, I_EV_LN_B, I_EV_W_S, I_EV_B_S, I_EV_W_OUT, I_EV_NORM_FFN, I_EV_FFN_GATE, I_EV_FFN_UP, I_EV_FFN_DOWN,
       I_OD_NORM_MIX, I_OD_W_IN, I_OD_CONV_W, I_OD_CONV_B, I_OD_W_A, I_OD_B_A, I_OD_W_X, I_OD_B_X, I_OD_LAM, I_OD_W_OUT, I_OD_NORM_FFN, I_OD_ROUTER,
       I_OD_EXP_GATE, I_OD_EXP_UP, I_OD_EXP_DOWN, I_FINAL_NORM };
constexpr int N_PHASES = 20;

#ifndef PROBE_ID
#define PROBE_ID (-1)
#define PROBE_IDX 0
#define PROBE_DIV 1.0e6f
#endif
#define PROBE_PTR(id) ((PROBE_ID == (id)) ? (unsigned long long*)(ws + WS_CTL) + 512 : (unsigned long long*)nullptr)
#ifndef MFMA_MASK
#define MFMA_MASK 0x1ff
#endif
static_assert(((MFMA_MASK >> 7) & 3) == 3, "the MoE expert GEMMs are fp8: MFMA path only");
static_assert(!(FFN_GU_FP8 || FFN_GU_MIX) || EVOUT_MIXED, "the e4m3 copy of x1 overlays CAT: the out-projection must read CAT2");
template <int ID, class Epi, bool FP8 = false, int F8FROM = 0>
__device__ __forceinline__ void dense_gemm_phase(const Frame& F, const bf16* A, int lda, const bf16* Bt, int ldb, int K, int ncol, int nunits, const Epi& E, unsigned long long* probe = nullptr, const int noepi = 0, const long adelta = 0) {
    if constexpr ((MFMA_MASK >> ID) & 1) {
        pg8::SchedDense S; S.so.init(nunits / ncol, ncol, F.G, F.bid); S.A = (const char*)A; S.B = (const char*)Bt; S.tstepA = (size_t)256 * lda * 2; S.tstepB = (size_t)256 * ldb * 2; S.acol_shift = -1; S.acol_bytes = 0; S.tok = nullptr;
        pg8::gemm_phase<Epi, pg8::SchedDense, false, true, FP8, F8FROM>(F.lds, S, E, K, lda, ldb, probe, noepi, adelta);
    } else {
        const int wr = F.wave >> 2, wc = F.wave & 3, fr = F.lane & 15, fq = F.lane >> 4;
        ARowDense ar{A, lda};
        for (int i = F.bid; i < nunits; i += F.G) { Unit u; u.pm = i / ncol; u.pn = i % ncol; u.newpm = 1; naive_gemm_unit(ar, Bt + (size_t)u.pn * 256 * ldb, ldb, K, u, E, wr, wc, fr, fq); }
    }
}

__global__ void __launch_bounds__(NTHR, 2) fwd(Args args) {
    extern __shared__ __attribute__((aligned(16))) unsigned char lds_raw[];
    const unsigned lds_base = (unsigned)(uintptr_t)lds_raw;
    Frame F; F.lds = (LAS unsigned char*)lds_raw; F.tid = threadIdx.x; F.lane = F.tid & 63; F.wave = __builtin_amdgcn_readfirstlane(F.tid >> 6); F.bid = blockIdx.x; F.G = gridDim.x;
    unsigned char* ws = args.ws;
    const int lo = args.ph_lo, hi = args.ph_hi;
#define IN(k) (lo <= (k) && (k) < hi)
#define SEAM(k) do { if (IN(k) && IN((k) + 1)) xcd_barrier(bar); } while (0)
#ifndef REPEAT_MASK
#define REPEAT_NOEPI 0
#define REPEAT_MASK 0
#endif
#define PHASE(k) if (IN(k) && frame_refresh(F, gw, gt))
    for (int u = F.tid; u < (LDS_BYTES - LDSCTL_OFF) / 4; u += NTHR) ((LAS unsigned*)(F.lds + LDSCTL_OFF))[u] = 0u;
    __syncthreads();
    XcdBarrier bar = xcd_barrier_post((unsigned*)(ws + WS_CTL) + CW_BAR + args.li * XCD_BAR_WORDS, (volatile LAS unsigned*)(F.lds + LDSCTL_OFF));
    int gw = F.bid * NWAVES + F.wave; const int NGW = F.G * NWAVES;
    int gt = F.bid * NTHR + F.tid; const int NGT = F.G * NTHR;
    float* const xres = args.out;
    bf16* const XB = (bf16*)(ws + WS_XB);
    float* const SSQ0 = (float*)(ws + WS_SSQ0); float* const SSQ1 = (float*)(ws + WS_SSQ1); float* const SSQ2 = (float*)(ws + WS_SSQ2); float* const SSQ3 = (float*)(ws + WS_SSQ3);

    PHASE(0) {
        LAS float* scr = (LAS float*)(F.lds + F.wave * 16640);
        constexpr int I0 = 32 * 88, I1 = 32 * 32, I2 = 32 * 88, I3 = 88 * 32, I4 = 32 * 80, I5 = 4 * 4, I6 = 40 * 32, I7 = 32 * 44, I8 = 44 * 32;
        constexpr int NITEMS = I0 + I1 + 2 * I2 + I3 + I4 + 20 * I5 + I6 + 16 * I7 + 8 * I8;
        for (int it = gw; it < NITEMS; it += NGW) {
            int r = it; MapV mp;
            if (r < I0) { mp = MapV{args.in[I_EV_W_IN], args.in[I_EV_NORM_MIX], (bf16*)(ws + WS_W_EVIN), D, NIN0, 2, 0, 0.f}; }
            else if ((r -= I0) < I1) {
                if (!EVOUT_MIXED) mp = MapV{args.in[I_EV_W_OUT], nullptr, (bf16*)(ws + WS_W_EVOUT), D, D, 0, 0, 0.f};
                else if (r < (DA / 64) * (D / 64)) mp = MapV{args.in[I_EV_W_OUT], nullptr, (bf16*)(ws + WS_W_EVOUT), C2P / 2, D, 0, 0, 0.f, F8_SW};
                else { r -= (DA / 64) * (D / 64); mp = MapV{args.in[I_EV_W_OUT] + (size_t)DA * D, nullptr, (bf16*)(ws + WS_W_EVOUT + 2 * DA), C2P, D, 0, 0, F8_SW}; }
            }
            else if ((r -= I1) < 2 * I2) { const int hf = r >= I2; r -= hf * I2; const float* Wg = hf ? args.in[I_EV_FFN_UP] : args.in[I_EV_FFN_GATE];
                if (!FFN_GU_MIX) mp = MapV{Wg, args.in[I_EV_NORM_FFN], (bf16*)(ws + WS_W_FGU), D, DFF, 1, hf, FFN_GU_FP8 ? F8_SW : 0.f};
                else if (r < (FGU_KB / 64) * (DFF / 64)) mp = MapV{Wg, args.in[I_EV_NORM_FFN], (bf16*)(ws + WS_W_FGU), FGU_P / 2, DFF, 1, hf, 0.f, F8_SW};
                else { r -= (FGU_KB / 64) * (DFF / 64); mp = MapV{Wg + (size_t)FGU_KB * DFF, args.in[I_EV_NORM_FFN] + FGU_KB, (bf16*)(ws + WS_W_FGU + 2 * FGU_KB), FGU_P, DFF, 1, hf, F8_SW}; }
            }
            else if ((r -= 2 * I2) < I3) { mp = MapV{args.in[I_EV_FFN_DOWN], nullptr, (bf16*)(ws + WS_W_FDN), DFF, D, 0, 0, FFN_DOWN_FP8 ? F8_SW : 0.f}; }
            else if ((r -= I3) < I4) { mp = MapV{args.in[I_OD_W_IN], args.in[I_OD_NORM_MIX], (bf16*)(ws + WS_W_ODIN), D, 2 * DRNN, 0, 0, OD_IN_FP8 ? F8_SW : 0.f}; }
            else if ((r -= I4) < 10 * I5) { const int n = r / I5; r -= n * I5; mp = MapV{args.in[I_OD_W_A] + (size_t)n * 65536, nullptr, (bf16*)(ws + WS_W_AX) + (size_t)n * 512 * 256, 256, 256, 1, 0, 0.f}; }
            else if ((r -= 10 * I5) < 10 * I5) { const int n = r / I5; r -= n * I5; mp = MapV{args.in[I_OD_W_X] + (size_t)n * 65536, nullptr, (bf16*)(ws + WS_W_AX) + (size_t)n * 512 * 256, 256, 256, 1, 1, 0.f}; }
            else if ((r -= 10 * I5) < I6) { mp = MapV{args.in[I_OD_W_OUT], nullptr, (bf16*)(ws + WS_W_ODOUT), DRNN, D, 0, 0, 0.f}; }
            else if ((r -= I6) < 8 * I7) { const int e = r / I7; r -= e * I7; mp = MapV{args.in[I_OD_EXP_GATE] + (size_t)e * D * DFE, args.in[I_OD_NORM_FFN], (bf16*)(ws + WS_W_EGU + (size_t)e * 2 * DFE * D), D, DFE, 1, 0, F8_SW}; }
            else if ((r -= 8 * I7) < 8 * I7) { const int e = r / I7; r -= e * I7; mp = MapV{args.in[I_OD_EXP_UP] + (size_t)e * D * DFE, args.in[I_OD_NORM_FFN], (bf16*)(ws + WS_W_EGU + (size_t)e * 2 * DFE * D), D, DFE, 1, 1, F8_SW}; }
            else { r -= 8 * I7; const int e = r / I8; r -= e * I8; mp = MapV{args.in[I_OD_EXP_DOWN] + (size_t)e * DFE * D, nullptr, (bf16*)(ws + WS_W_EDN + (size_t)e * D * DFE), DFE, D, 0, 0, F8_SW}; }
            cvt_item64(mp, r, scr, F.lane);
        }
        { const float* Ws = args.in[I_EV_W_S]; bf16* WSM = (bf16*)(ws + WS_WSM);
          for (int i = gt; i < 4 * 128 * 128; i += NGT) { const int t = (i >> 7) & 127, sidx = i & 127; WSM[i] = (bf16)f2bf(sidx <= t ? Ws[i] : 0.f); } }
        for (int c = gt; c < DRNN; c += NGT) ((float*)(ws + WS_SP8))[c] = -8.0f * log1pf(expf(-args.in[I_OD_LAM][c]));
        const float* x = args.in[I_X];
        for (int m = gw; m < M; m += NGW) {
            const f32x4* xr = (const f32x4*)(x + (size_t)m * D) + F.lane; u32x2* o8 = (u32x2*)(XB + (size_t)m * D) + F.lane; float s = 0.f;
#pragma unroll
            for (int j = 0; j < 8; ++j) { const f32x4 v = xr[64 * j]; s += (v.x * v.x + v.y * v.y) + (v.z * v.z + v.w * v.w); u32x2 w; w.x = pk2(v.x, v.y); w.y = pk2(v.z, v.w); o8[64 * j] = w;
                if (EVIN_QKV_FP8) *((unsigned*)((unsigned char*)args.out + (size_t)m * D) + F.lane + 64 * j) = pk4_f8(v.x * F8_SX, v.y * F8_SX, v.z * F8_SX, v.w * F8_SX); }
            s = wave_sum(s); if (F.lane == 0) SSQ0[m] = s;
        }
    }
    SEAM(0);
    PHASE(1) {
        if constexpr (EVIN_QKV_FP8) {
            EpiEvIn E1{SSQ0, (bf16*)(ws + WS_U), (bf16*)(ws + WS_VA), (bf16*)(ws + WS_Q), (bf16*)(ws + WS_K), (bf16*)(ws + WS_V), 0, 1.0f};
            dense_gemm_phase<0>(F, XB, D, (const bf16*)(ws + WS_W_EVIN), D, D, 4, (M / 256) * 4, E1, PROBE_PTR(0), (REPEAT_NOEPI ? args.noepi : 0));
            EpiEvIn E2{SSQ0, (bf16*)(ws + WS_U), (bf16*)(ws + WS_VA), (bf16*)(ws + WS_Q), (bf16*)(ws + WS_K), (bf16*)(ws + WS_V), 4, 1.0f / (F8_SX * F8_SW)};
            dense_gemm_phase<0, EpiEvIn, true>(F, (const bf16*)args.out, D / 2, (const bf16*)(ws + WS_W_EVIN + EVIN8_OFF), D / 2, D / 2, 18, (M / 256) * 18, E2, nullptr, (REPEAT_NOEPI ? args.noepi : 0));
        } else {
            EpiEvIn E{SSQ0, (bf16*)(ws + WS_U), (bf16*)(ws + WS_VA), (bf16*)(ws + WS_Q), (bf16*)(ws + WS_K), (bf16*)(ws + WS_V), 0, 1.0f};
            dense_gemm_phase<0>(F, XB, D, (const bf16*)(ws + WS_W_EVIN), D, D, NIN0 / 256, (M / 256) * (NIN0 / 256), E, PROBE_PTR(0), (REPEAT_NOEPI ? args.noepi : 0));
        }
    }
    SEAM(1);
    PHASE(2) {
        const bf16* U = (const bf16*)(ws + WS_U); const bf16* VA = (const bf16*)(ws + WS_VA); bf16* CAT = (bf16*)(ws + WS_CAT);
        const float* ln_g = args.in[I_EV_LN_G]; const float* ln_b = args.in[I_EV_LN_B]; const float* bs = args.in[I_EV_B_S]; const bf16* WSM = (const bf16*)(ws + WS_WSM);
        typedef pg8::bf16x8 bf16x8;
        constexpr int WP = 272, VP = 288, WOFF = 1024, VOFF2 = WOFF + 128 * WP;
        LAS float* stats = (LAS float*)F.lds;
        LAS unsigned char* Wl = F.lds + WOFF; LAS unsigned char* Vl = F.lds + VOFF2;
        const int fr = F.lane & 15, fq = F.lane >> 4;
        const unsigned vbg = lds_base + VOFF2 + (unsigned)((8 * fq + ((F.lane & 15) >> 2)) * VP + (16 * F.wave + 4 * (F.lane & 3)) * 2);
        for (int c = F.bid; c < M / 128; c += F.G) {
            const int r0 = c * 128;
            __syncthreads();
            for (int rr = 0; rr < 16; ++rr) {
                const int sr = F.wave * 16 + rr; const u32x4 w = *(const u32x4*)(VA + (size_t)(r0 + sr) * DA + 8 * F.lane);
                const float v[8] = {bflo(w.x), bfhi(w.x), bflo(w.y), bfhi(w.y), bflo(w.z), bfhi(w.z), bflo(w.w), bfhi(w.w)};
                float sm = 0.f;
#pragma unroll
                for (int i = 0; i < 8; ++i) sm += v[i];
                const float mean = wave_sum(sm) * (1.0f / DA); float q = 0.f;
#pragma unroll
                for (int i = 0; i < 8; ++i) { const float dd = v[i] - mean; q += dd * dd; }
                const float var = wave_sum(q) * (1.0f / DA);
                if (F.lane == 0) { stats[2 * sr] = mean; stats[2 * sr + 1] = 1.0f / sqrtf(var + LN_EPS); }
            }
            __syncthreads();
            for (int g = 0; g < 4; ++g) {
#pragma unroll
                for (int j = 0; j < 4; ++j) { const int pc = F.tid + NTHR * j, t = pc >> 4, piece = pc & 15;
                    *(LAS u32x4*)(Wl + t * WP + piece * 16) = *(const u32x4*)(WSM + (size_t)(g * 128 + t) * 128 + piece * 8); }
                { const int sr = F.tid >> 2, cq = (F.tid & 3) * 32; const float mean = stats[2 * sr], rstd = stats[2 * sr + 1];
#pragma unroll
                  for (int i4 = 0; i4 < 4; ++i4) { const int col = g * 128 + cq + 8 * i4; const u32x4 w = *(const u32x4*)(VA + (size_t)(r0 + sr) * DA + col);
                      const float v[8] = {bflo(w.x), bfhi(w.x), bflo(w.y), bfhi(w.y), bflo(w.z), bfhi(w.z), bflo(w.w), bfhi(w.w)};
                      const f32x4 g0 = *(const f32x4*)(ln_g + col), g1 = *(const f32x4*)(ln_g + col + 4), b0 = *(const f32x4*)(ln_b + col), b1 = *(const f32x4*)(ln_b + col + 4);
                      u32x4 o; o.x = pk2((v[0] - mean) * rstd * g0.x + b0.x, (v[1] - mean) * rstd * g0.y + b0.y); o.y = pk2((v[2] - mean) * rstd * g0.z + b0.z, (v[3] - mean) * rstd * g0.w + b0.w);
                      o.z = pk2((v[4] - mean) * rstd * g1.x + b1.x, (v[5] - mean) * rstd * g1.y + b1.y); o.w = pk2((v[6] - mean) * rstd * g1.z + b1.z, (v[7] - mean) * rstd * g1.w + b1.w);
                      *(LAS u32x4*)(Vl + sr * VP + (cq + 8 * i4) * 2) = o; } }
                __syncthreads();
                bf16x8 xf[4];
                { s16x4 a0 = tr_read<(0 * 32 + 0) * VP>(vbg), a1 = tr_read<(0 * 32 + 4) * VP>(vbg), b0 = tr_read<(1 * 32 + 0) * VP>(vbg), b1 = tr_read<(1 * 32 + 4) * VP>(vbg);
                  s16x4 c0 = tr_read<(2 * 32 + 0) * VP>(vbg), c1 = tr_read<(2 * 32 + 4) * VP>(vbg), d0 = tr_read<(3 * 32 + 0) * VP>(vbg), d1 = tr_read<(3 * 32 + 4) * VP>(vbg);
                  asm volatile("s_waitcnt lgkmcnt(0)" ::: "memory"); __builtin_amdgcn_sched_barrier(0);
                  xf[0] = (bf16x8){a0[0], a0[1], a0[2], a0[3], a1[0], a1[1], a1[2], a1[3]}; xf[1] = (bf16x8){b0[0], b0[1], b0[2], b0[3], b1[0], b1[1], b1[2], b1[3]};
                  xf[2] = (bf16x8){c0[0], c0[1], c0[2], c0[3], c1[0], c1[1], c1[2], c1[3]}; xf[3] = (bf16x8){d0[0], d0[1], d0[2], d0[3], d1[0], d1[1], d1[2], d1[3]}; }
                const LAS unsigned char* wb = Wl + fr * WP + fq * 16;
#pragma unroll
                for (int tt = 0; tt < 8; ++tt) {
                    f32x4 a = (f32x4){0.f, 0.f, 0.f, 0.f};
#pragma unroll
                    for (int ks = 0; ks < (tt >> 1) + 1; ++ks) { const bf16x8 yf = *(const LAS bf16x8*)(wb + tt * 16 * WP + ks * 64); a = __builtin_amdgcn_mfma_f32_16x16x32_bf16(xf[ks], yf, a, 0, 0, 0); }
                    const int t = 16 * tt + fr; const int col = g * 128 + 16 * F.wave + 4 * fq; const float bias = bs[g * 128 + t];
                    const u32x2 uw = *(const u32x2*)(U + (size_t)(r0 + t) * DA + col);
                    u32x2 o;
                    if (EVOUT_MIXED) { o.x = pk2(bflo(uw.x) * (a[0] + bias) * F8_SX, bfhi(uw.x) * (a[1] + bias) * F8_SX); o.y = pk2(bflo(uw.y) * (a[2] + bias) * F8_SX, bfhi(uw.y) * (a[3] + bias) * F8_SX);
                        *(u32x2*)((unsigned char*)args.out + (size_t)(r0 + t) * C2P + col * 2) = o; }
                    else { o.x = pk2(bflo(uw.x) * (a[0] + bias), bfhi(uw.x) * (a[1] + bias)); o.y = pk2(bflo(uw.y) * (a[2] + bias), bfhi(uw.y) * (a[3] + bias));
                        *(u32x2*)(CAT + (size_t)(r0 + t) * D + col) = o; }
                }
                __syncthreads();
            }
        }
        __syncthreads();
        attn_pass<0>(F, lds_base, (const bf16*)(ws + WS_Q), (const bf16*)(ws + WS_K), (const bf16*)(ws + WS_V), CAT, (float*)(ws + WS_LSE));
    }
    SEAM(2);
    PHASE(3) attn_pass<1>(F, lds_base, (const bf16*)(ws + WS_Q), (const bf16*)(ws + WS_K), (const bf16*)(ws + WS_V), (bf16*)(ws + WS_CAT), (float*)(ws + WS_LSE));
    SEAM(3);
    PHASE(4) attn_pass<2>(F, lds_base, (const bf16*)(ws + WS_Q), (const bf16*)(ws + WS_K), (const bf16*)(ws + WS_V), (bf16*)(ws + WS_CAT), (float*)(ws + WS_LSE), (unsigned char*)args.out);
    SEAM(4);
    PHASE(5) {
        EpiResid<true, (FFN_GU_MIX ? 2 : (FFN_GU_FP8 ? 1 : 0))> E{args.in[I_X], XB, SSQ1, EVOUT_MIXED ? 1.0f / (F8_SX * F8_SW) : 1.0f};
        if constexpr (EVOUT_MIXED) dense_gemm_phase<1, EpiResid<true, (FFN_GU_MIX ? 2 : (FFN_GU_FP8 ? 1 : 0))>, true, 2 * DA / 128>(F, (const bf16*)args.out, C2P / 2, (const bf16*)(ws + WS_W_EVOUT), C2P / 2, C2P / 2, D / 256, (M / 256) * (D / 256), E, PROBE_PTR(1), (REPEAT_NOEPI ? args.noepi : 0));
        else dense_gemm_phase<1>(F, (const bf16*)(ws + WS_CAT), D, (const bf16*)(ws + WS_W_EVOUT), D, D, D / 256, (M / 256) * (D / 256), E, PROBE_PTR(1), (REPEAT_NOEPI ? args.noepi : 0));
    }
    SEAM(5);
    PHASE(6) {
        EpiGateUp<false, FFN_DOWN_FP8 != 0> E{SSQ1, (bf16*)(ws + WS_H), DFF, nullptr, nullptr, (LAS float*)(F.lds + 131072), FFN_GU_MIX ? 1.0f / F8_SW : (FFN_GU_FP8 ? 1.0f / (F8_SX * F8_SW) : 1.0f)};
        if constexpr (FFN_GU_MIX) dense_gemm_phase<2, EpiGateUp<false, FFN_DOWN_FP8 != 0>, true, 2 * FGU_KB / 128>(F, XB, D, (const bf16*)(ws + WS_W_FGU), FGU_P / 2, FGU_P / 2, 2 * DFF / 256, (M / 256) * (2 * DFF / 256), E, PROBE_PTR(2), (REPEAT_NOEPI ? args.noepi : 0), X18_DELTA);
        else if constexpr (FFN_GU_FP8) dense_gemm_phase<2, EpiGateUp<false, FFN_DOWN_FP8 != 0>, true>(F, (const bf16*)(ws + WS_X18), D / 2, (const bf16*)(ws + WS_W_FGU), D / 2, D / 2, 2 * DFF / 256, (M / 256) * (2 * DFF / 256), E, PROBE_PTR(2), (REPEAT_NOEPI ? args.noepi : 0));
        else dense_gemm_phase<2>(F, XB, D, (const bf16*)(ws + WS_W_FGU), D, D, 2 * DFF / 256, (M / 256) * (2 * DFF / 256), E, PROBE_PTR(2), (REPEAT_NOEPI ? args.noepi : 0));
    }
    SEAM(6);
    PHASE(7) {
        EpiResid<false, (OD_IN_FP8 ? 1 : 0)> E{nullptr, XB, SSQ2, FFN_DOWN_FP8 ? 1.0f / (F8_SH * F8_SW) : 1.0f};
        if constexpr (FFN_DOWN_FP8) dense_gemm_phase<3, EpiResid<false, (OD_IN_FP8 ? 1 : 0)>, true>(F, (const bf16*)(ws + WS_H), DFF / 2, (const bf16*)(ws + WS_W_FDN), DFF / 2, DFF / 2, D / 256, (M / 256) * (D / 256), E, PROBE_PTR(3), (REPEAT_NOEPI ? args.noepi : 0));
        else dense_gemm_phase<3>(F, (const bf16*)(ws + WS_H), DFF, (const bf16*)(ws + WS_W_FDN), DFF, DFF, D / 256, (M / 256) * (D / 256), E, PROBE_PTR(3), (REPEAT_NOEPI ? args.noepi : 0));
    }
    SEAM(7);
    PHASE(8) {
        EpiOdIn E{SSQ2, (bf16*)(ws + WS_G), (bf16*)(ws + WS_XR), (LAS float*)(F.lds + 131072), OD_IN_FP8 ? 1.0f / (F8_SX * F8_SW) : 1.0f};
        if constexpr (OD_IN_FP8) dense_gemm_phase<4, EpiOdIn, true>(F, (const bf16*)(ws + WS_X18), D / 2, (const bf16*)(ws + WS_W_ODIN), D / 2, D / 2, 2 * DRNN / 256, (M / 256) * (2 * DRNN / 256), E, PROBE_PTR(4), (REPEAT_NOEPI ? args.noepi : 0));
        else dense_gemm_phase<4>(F, XB, D, (const bf16*)(ws + WS_W_ODIN), D, D, 2 * DRNN / 256, (M / 256) * (2 * DRNN / 256), E, PROBE_PTR(4), (REPEAT_NOEPI ? args.noepi : 0));
    }
    SEAM(8);
    PHASE(9) {
        const bf16* XR = (const bf16*)(ws + WS_XR); bf16* XC = (bf16*)(ws + WS_XC); const float* cw = args.in[I_OD_CONV_W]; const float* cb = args.in[I_OD_CONV_B];
        for (int it = gt; it < (M / 16) * (DRNN / 8); it += NGT) {
            const int rb = it / (DRNN / 8), cg = it - rb * (DRNN / 8), ch = cg * 8, r0 = rb * 16;
            f32x4 w[4][2], bias[2];
#pragma unroll
            for (int tap = 0; tap < 4; ++tap) { w[tap][0] = *(const f32x4*)(cw + tap * DRNN + ch); w[tap][1] = *(const f32x4*)(cw + tap * DRNN + ch + 4); }
            bias[0] = *(const f32x4*)(cb + ch); bias[1] = *(const f32x4*)(cb + ch + 4);
            const bf16* xp = XR + (size_t)r0 * DRNN + ch; bf16* op = XC + (size_t)r0 * DRNN + ch;
            u32x4 h1 = (u32x4){0u, 0u, 0u, 0u}, h2 = h1, h3 = h1;
            if ((r0 & (S - 1)) != 0) { h1 = *(const u32x4*)(xp - DRNN); h2 = *(const u32x4*)(xp - 2 * DRNN); h3 = *(const u32x4*)(xp - 3 * DRNN); }
            f32x4 x1[2] = {(f32x4){bflo(h1.x), bfhi(h1.x), bflo(h1.y), bfhi(h1.y)}, (f32x4){bflo(h1.z), bfhi(h1.z), bflo(h1.w), bfhi(h1.w)}};
            f32x4 x2[2] = {(f32x4){bflo(h2.x), bfhi(h2.x), bflo(h2.y), bfhi(h2.y)}, (f32x4){bflo(h2.z), bfhi(h2.z), bflo(h2.w), bfhi(h2.w)}};
            f32x4 x3[2] = {(f32x4){bflo(h3.x), bfhi(h3.x), bflo(h3.y), bfhi(h3.y)}, (f32x4){bflo(h3.z), bfhi(h3.z), bflo(h3.w), bfhi(h3.w)}};
#pragma unroll
            for (int t = 0; t < 16; ++t) {
                const u32x4 h0 = *(const u32x4*)(xp + (size_t)t * DRNN);
                const f32x4 x0[2] = {(f32x4){bflo(h0.x), bfhi(h0.x), bflo(h0.y), bfhi(h0.y)}, (f32x4){bflo(h0.z), bfhi(h0.z), bflo(h0.w), bfhi(h0.w)}};
                const f32x4 y0 = bias[0] + x3[0] * w[0][0] + x2[0] * w[1][0] + x1[0] * w[2][0] + x0[0] * w[3][0];
                const f32x4 y1 = bias[1] + x3[1] * w[0][1] + x2[1] * w[1][1] + x1[1] * w[2][1] + x0[1] * w[3][1];
                store8(op + (size_t)t * DRNN, y0, y1);
                x3[0] = x2[0]; x3[1] = x2[1]; x2[0] = x1[0]; x2[1] = x1[1]; x1[0] = x0[0]; x1[1] = x0[1];
            }
        }
    }
    SEAM(9);
    PHASE(10) {
        const bf16* XC = (const bf16*)(ws + WS_XC);
        EpiGates E{XC, args.in[I_OD_B_A], args.in[I_OD_B_X], (const float*)(ws + WS_SP8), (bf16*)(ws + WS_LA), (bf16*)args.out};
        if constexpr ((MFMA_MASK >> 5) & 1) {
            pg8::SchedDense Sg; Sg.so.init(M / 256, 20, F.G, F.bid); Sg.A = (const char*)XC; Sg.B = (const char*)(ws + WS_W_AX); Sg.tstepA = (size_t)256 * DRNN * 2; Sg.tstepB = (size_t)256 * 256 * 2; Sg.acol_shift = 1; Sg.acol_bytes = 512; Sg.tok = nullptr;
            pg8::gemm_phase<EpiGates, pg8::SchedDense, false, true>(F.lds, Sg, E, 256, DRNN, 256, nullptr, (REPEAT_NOEPI ? args.noepi : 0));
        } else {
        const int wr = F.wave >> 2, wc = F.wave & 3, fr = F.lane & 15, fq = F.lane >> 4;
        for (int i = F.bid; i < (M / 256) * 20; i += F.G) { Unit u; u.pm = i / 20; u.pn = i % 20; u.newpm = 1;
            ARowDense ar{XC + (u.pn >> 1) * 256, DRNN};
            naive_gemm_unit(ar, (const bf16*)(ws + WS_W_AX) + (size_t)u.pn * 256 * 256, 256, 256, u, E, wr, wc, fr, fq); }
        }
    }
    SEAM(10);
    const bf16* LA = (const bf16*)(ws + WS_LA); const bf16* BT = (const bf16*)args.out;
    constexpr int SCL = 16, NCHK = S / SCL;
    float* CA = (float*)(ws + WS_XC); float* CBv = CA + (size_t)2 * DRNN * NCHK; float* HIN = CBv + (size_t)2 * DRNN * NCHK;
    PHASE(11) {
        for (int it = gt; it < 2 * NCHK * (DRNN / 8); it += NGT) {
            const int cg = it % (DRNN / 8), bc = it / (DRNN / 8), ch = cg * 8;
            const size_t base = (size_t)bc * SCL * DRNN + ch;
            u32x4 lw[SCL], bw[SCL];
#pragma unroll
            for (int t = 0; t < SCL; ++t) { lw[t] = *(const u32x4*)(LA + base + (size_t)t * DRNN); bw[t] = *(const u32x4*)(BT + base + (size_t)t * DRNN); }
            float h[8], P[8];
#pragma unroll
            for (int i = 0; i < 8; ++i) { h[i] = 0.f; P[i] = 1.f; }
#pragma unroll
            for (int t = 0; t < SCL; ++t) {
                const float la[8] = {bflo(lw[t].x), bfhi(lw[t].x), bflo(lw[t].y), bfhi(lw[t].y), bflo(lw[t].z), bfhi(lw[t].z), bflo(lw[t].w), bfhi(lw[t].w)};
                const float bb[8] = {bflo(bw[t].x), bfhi(bw[t].x), bflo(bw[t].y), bfhi(bw[t].y), bflo(bw[t].z), bfhi(bw[t].z), bflo(bw[t].w), bfhi(bw[t].w)};
#pragma unroll
                for (int i = 0; i < 8; ++i) { const float a = __builtin_amdgcn_exp2f(la[i]); const float b = SCAN_SQRT ? __builtin_amdgcn_sqrtf(fmaxf(__builtin_fmaf(-a, a, 1.0f), 0.f)) * bb[i] : bb[i]; h[i] = a * h[i] + b; P[i] *= a; }
            }
            const size_t k = (size_t)bc * DRNN + ch;
            *(f32x4*)(CA + k) = (f32x4){P[0], P[1], P[2], P[3]}; *(f32x4*)(CA + k + 4) = (f32x4){P[4], P[5], P[6], P[7]};
            *(f32x4*)(CBv + k) = (f32x4){h[0], h[1], h[2], h[3]}; *(f32x4*)(CBv + k + 4) = (f32x4){h[4], h[5], h[6], h[7]};
        }
    }
    SEAM(11);
    PHASE(12) {
        for (int it = gw; it < 2 * (DRNN / 4); it += NGW) {
            const int b = it / (DRNN / 4), c4 = it - b * (DRNN / 4);
            const size_t k0 = ((size_t)b * NCHK + 16 * F.lane) * DRNN + 4 * c4;
            f32x4 a4[16], b4[16];
#pragma unroll
            for (int q = 0; q < 16; ++q) { a4[q] = *(const f32x4*)(CA + k0 + (size_t)q * DRNN); b4[q] = *(const f32x4*)(CBv + k0 + (size_t)q * DRNN); }
            f32x4 A = a4[0], B = b4[0];
#pragma unroll
            for (int q = 1; q < 16; ++q) { B = a4[q] * B + b4[q]; A = A * a4[q]; }
#pragma unroll
            for (int o = 1; o < 64; o <<= 1) {
                f32x4 Ap, Bp;
#pragma unroll
                for (int c = 0; c < 4; ++c) { Ap[c] = __shfl_up(A[c], o); Bp[c] = __shfl_up(B[c], o); }
                if (F.lane >= o) { B = A * Bp + B; A = A * Ap; }
            }
            f32x4 hin;
#pragma unroll
            for (int c = 0; c < 4; ++c) hin[c] = __shfl_up(B[c], 1);
            if (F.lane == 0) hin = (f32x4){0.f, 0.f, 0.f, 0.f};
#pragma unroll
            for (int q = 0; q < 16; ++q) { *(f32x4*)(HIN + k0 + (size_t)q * DRNN) = hin; hin = a4[q] * hin + b4[q]; }
        }
    }
    SEAM(12);
    PHASE(13) {
        bf16* Gb = (bf16*)(ws + WS_G);
        for (int it = gt; it < 2 * NCHK * (DRNN / 8); it += NGT) {
            const int cg = it % (DRNN / 8), bc = it / (DRNN / 8), ch = cg * 8;
            const size_t base = (size_t)bc * SCL * DRNN + ch;
            const size_t k = (size_t)bc * DRNN + ch;
            const f32x4 h0 = *(const f32x4*)(HIN + k), h1 = *(const f32x4*)(HIN + k + 4);
            float h[8] = {h0.x, h0.y, h0.z, h0.w, h1.x, h1.y, h1.z, h1.w};
#pragma unroll 8
            for (int t = 0; t < SCL; ++t) {
                const size_t o = base + (size_t)t * DRNN;
                const u32x4 lw = *(const u32x4*)(LA + o), bw = *(const u32x4*)(BT + o), gwv = *(const u32x4*)(Gb + o);
                const float la[8] = {bflo(lw.x), bfhi(lw.x), bflo(lw.y), bfhi(lw.y), bflo(lw.z), bfhi(lw.z), bflo(lw.w), bfhi(lw.w)};
                const float bb[8] = {bflo(bw.x), bfhi(bw.x), bflo(bw.y), bfhi(bw.y), bflo(bw.z), bfhi(bw.z), bflo(bw.w), bfhi(bw.w)};
                const float gg[8] = {bflo(gwv.x), bfhi(gwv.x), bflo(gwv.y), bfhi(gwv.y), bflo(gwv.z), bfhi(gwv.z), bflo(gwv.w), bfhi(gwv.w)};
                float y[8];
#pragma unroll
                for (int i = 0; i < 8; ++i) { const float a = __builtin_amdgcn_exp2f(la[i]); const float b = SCAN_SQRT ? __builtin_amdgcn_sqrtf(fmaxf(__builtin_fmaf(-a, a, 1.0f), 0.f)) * bb[i] : bb[i]; h[i] = a * h[i] + b; y[i] = gg[i] * h[i]; }
                u32x4 ow; ow.x = pk2(y[0], y[1]); ow.y = pk2(y[2], y[3]); ow.z = pk2(y[4], y[5]); ow.w = pk2(y[6], y[7]);
                *(u32x4*)(Gb + o) = ow;
            }
        }
    }
    SEAM(13);
    PHASE(14) {
        EpiResid<false> E{nullptr, XB, SSQ3, 1.0f};
        dense_gemm_phase<6>(F, (const bf16*)(ws + WS_G), DRNN, (const bf16*)(ws + WS_W_ODOUT), DRNN, DRNN, D / 256, (M / 256) * (D / 256), E, PROBE_PTR(6), (REPEAT_NOEPI ? args.noepi : 0));
    }
    SEAM(14);
    int* TOPE = (int*)(ws + WS_TOPE); float* TOPG = (float*)(ws + WS_TOPG); int* CNT = (int*)(ws + WS_CNT); int* EOFF = (int*)(ws + WS_EOFF);
    int* TOK = (int*)(ws + WS_TOK); float* GWv = (float*)(ws + WS_GW); int* DEST = (int*)(ws + WS_DEST);
    unsigned char* X8 = ws + WS_X8;
    float* RS3 = (float*)(ws + WS_SSQ0);
    float* RSR = (float*)(ws + WS_CA);
    const int TPW = (M + F.G - 1) / F.G;
    PHASE(15) {
        const float* Wr = args.in[I_OD_ROUTER]; const float* gn = args.in[I_OD_NORM_FFN];
        LAS int* cnt8 = (LAS int*)F.lds;
        if (F.tid < 8) cnt8[F.tid] = 0;
        __syncthreads();
        int myc[8];
#pragma unroll
        for (int e = 0; e < 8; ++e) myc[e] = 0;
        for (int tg = F.wave; 4 * tg < TPW; tg += NWAVES) {
            const int t0 = F.bid * TPW + 4 * tg; if (t0 >= M) break;
            float a[4][8];
#pragma unroll
            for (int q = 0; q < 4; ++q)
#pragma unroll
                for (int e = 0; e < 8; ++e) a[q][e] = 0.f;
#pragma unroll 2
            for (int j = 0; j < 8; ++j) { const int k0 = 4 * F.lane + 256 * j; const f32x4 gv = *(const f32x4*)(gn + k0);
                f32x4 xv[4];
#pragma unroll
                for (int q = 0; q < 4; ++q) { const int tq = (t0 + q < M) ? t0 + q : M - 1; const u32x2 xw = *((const u32x2*)(XB + (size_t)tq * D) + F.lane + 64 * j);
                    const f32x4 xr4 = (f32x4){bflo(xw.x), bfhi(xw.x), bflo(xw.y), bfhi(xw.y)};
                    *((unsigned*)(X8 + (size_t)tq * D) + F.lane + 64 * j) = pk4_f8(xr4.x * F8_SX, xr4.y * F8_SX, xr4.z * F8_SX, xr4.w * F8_SX);
                    xv[q] = xr4 * gv; }
#pragma unroll
                for (int kk = 0; kk < 4; ++kk) { const f32x4 w0 = *(const f32x4*)(Wr + (size_t)(k0 + kk) * 8), w1 = *(const f32x4*)(Wr + (size_t)(k0 + kk) * 8 + 4);
#pragma unroll
                    for (int q = 0; q < 4; ++q) { const float xg = xv[q][kk];
                        a[q][0] += xg * w0.x; a[q][1] += xg * w0.y; a[q][2] += xg * w0.z; a[q][3] += xg * w0.w; a[q][4] += xg * w1.x; a[q][5] += xg * w1.y; a[q][6] += xg * w1.z; a[q][7] += xg * w1.w; } } }
#pragma unroll
            for (int q = 0; q < 4; ++q) {
                const int t = t0 + q; if (t >= M) break;
#pragma unroll
                for (int e = 0; e < 8; ++e) a[q][e] = wave_sum(a[q][e]);
                const float sq = (F.lane < 32) ? SSQ3[(size_t)t * 32 + F.lane] : 0.f; const float rs = rsq_mean(wave_sum(sq));
                int e1 = 0; float l1 = a[q][0];
#pragma unroll
                for (int e = 1; e < 8; ++e) if (a[q][e] > l1) { l1 = a[q][e]; e1 = e; }
                int e2 = -1; float l2 = -INFINITY;
#pragma unroll
                for (int e = 0; e < 8; ++e) if (e != e1 && a[q][e] > l2) { l2 = a[q][e]; e2 = e; }
                const float g1 = 1.0f / (1.0f + expf((l2 - l1) * rs)), g2 = 1.0f - g1;
                if (F.lane == 0) { TOPE[2 * t] = e1; TOPE[2 * t + 1] = e2; TOPG[2 * t] = g1; TOPG[2 * t + 1] = g2; RS3[t] = rs; }
#pragma unroll
                for (int e = 0; e < 8; ++e) myc[e] += (e == e1) + (e == e2);
            }
        }
        if (F.lane == 0) {
#pragma unroll
            for (int e = 0; e < 8; ++e) atomicAdd((int*)(lds_raw) + e, myc[e]);
        }
        __syncthreads();
        if (F.tid < 8) CNT[F.bid * 8 + F.tid] = cnt8[F.tid];
    }
    SEAM(15);
    PHASE(16) {
        LAS int* tot = (LAS int*)F.lds;
        LAS int* bef = tot + 8;
        LAS int* eoff = tot + 16;
        LAS int* cntc = tot + 32;
        LAS int* run = tot + 32 + 8 * 64;
        { LAS int* pt = tot + 1024; LAS int* pb = pt + 512;
          const int e = F.tid & 7, wc0 = F.tid >> 3; int t = 0, b = 0;
          for (int w = wc0; w < F.G; w += 64) { const int c = CNT[w * 8 + e]; t += c; if (w < F.bid) b += c; }
          pt[F.tid] = t; pb[F.tid] = b;
          __syncthreads();
          if (F.tid < 8) { int tt = 0, bb = 0; for (int q = 0; q < 64; ++q) { tt += pt[q * 8 + F.tid]; bb += pb[q * 8 + F.tid]; } tot[F.tid] = tt; bef[F.tid] = bb; } }
        __syncthreads();
        if (F.tid == 0) { int o = 0; for (int e = 0; e < 8; ++e) { eoff[e] = o; o += (tot[e] + 255) & ~255; } eoff[8] = o; }
        __syncthreads();
        if (F.bid == 0 && F.tid < 9) EOFF[F.tid] = eoff[F.tid];
        const int nslots = 2 * TPW, nchunk = (nslots + 63) / 64;
        for (int c = F.wave; c < nchunk; c += NWAVES) {
            const int sl = c * 64 + F.lane; const int t = F.bid * TPW + (sl >> 1); const int e = (sl < nslots && t < M) ? TOPE[2 * t + (sl & 1)] : -1;
#pragma unroll
            for (int x = 0; x < 8; ++x) { const unsigned long long mk = __ballot(e == x); if (F.lane == 0) cntc[c * 8 + x] = __popcll(mk); }
        }
        __syncthreads();
        if (F.tid < 8) { int r = 0; for (int c = 0; c < nchunk; ++c) { const int v = cntc[c * 8 + F.tid]; cntc[c * 8 + F.tid] = r; r += v; } }
        __syncthreads();
        for (int c = F.wave; c < nchunk; c += NWAVES) {
            const int sl = c * 64 + F.lane; const int t = F.bid * TPW + (sl >> 1); const bool ok = (sl < nslots && t < M); const int e = ok ? TOPE[2 * t + (sl & 1)] : -1;
            int posn = -1;
#pragma unroll
            for (int x = 0; x < 8; ++x) { const unsigned long long mk = __ballot(e == x); if (e == x) posn = eoff[x] + bef[x] + cntc[c * 8 + x] + __popcll(mk & ((1ull << F.lane) - 1ull)); }
            if (ok) { TOK[posn] = t; GWv[posn] = TOPG[2 * t + (sl & 1)]; DEST[posn] = (sl & 1) * M + t; RSR[posn] = RS3[t]; }
        }
        if (F.bid < 8) { const int e = F.bid; for (int p = eoff[e] + tot[e] + F.tid; p < eoff[e + 1]; p += NTHR) { TOK[p] = 0; GWv[p] = 0.f; DEST[p] = -1; RSR[p] = 0.f; } }
        (void)run;
    }
    SEAM(16);
    PHASE(17) {
        EpiGateUp<true> E{nullptr, (bf16*)(ws + WS_HM), DFE, RSR, GWv, nullptr};
        const int wr = F.wave >> 2, wc = F.wave & 3, fr = F.lane & 15, fq = F.lane >> 4;
        int eo[9];
#pragma unroll
        for (int e = 0; e < 9; ++e) eo[e] = EOFF[e];
        const int NT = eo[8] / 256;
        if constexpr ((MFMA_MASK >> 7) & 1) {
            pg8::SchedMoe Sm; Sm.so.init(NT, 22, F.G, F.bid); Sm.A = (const char*)X8; Sm.B = (const char*)(ws + WS_W_EGU); Sm.tstepA = 0; Sm.tstepB = (size_t)256 * D; Sm.estrideB = (size_t)2 * DFE * D;
#pragma unroll
            for (int e = 0; e < 9; ++e) Sm.eo[e] = eo[e];
            Sm.tok = TOK; Sm.gather = true;
            pg8::gemm_phase<EpiGateUp<true>, pg8::SchedMoe, true, true, true>(F.lds, Sm, E, D / 2, D / 2, D / 2, nullptr, (REPEAT_NOEPI ? args.noepi : 0));
        } else {
        ARowGather ar{XB, D, TOK};
        for (int i = F.bid; i < NT * 22; i += F.G) { Unit u; u.pm = i / 22; u.pn = i % 22; int e = 0;
#pragma unroll
            for (int x = 1; x < 8; ++x) e += (u.pm * 256 >= eo[x]);
            naive_gemm_unit(ar, (const bf16*)(ws + WS_W_EGU) + (size_t)e * 2 * DFE * D + (size_t)u.pn * 256 * D, D, D, u, E, wr, wc, fr, fq); }
        }
    }
    SEAM(17);
    PHASE(18) {
        EpiMoeDown E{DEST, (bf16*)(ws + WS_Y0), (bf16*)(ws + WS_Y1)};
        const int wr = F.wave >> 2, wc = F.wave & 3, fr = F.lane & 15, fq = F.lane >> 4;
        int eo[9];
#pragma unroll
        for (int e = 0; e < 9; ++e) eo[e] = EOFF[e];
        const int NT = eo[8] / 256;
        if constexpr ((MFMA_MASK >> 8) & 1) {
            pg8::SchedMoe Sm; Sm.so.init(NT, 8, F.G, F.bid); Sm.A = (const char*)(ws + WS_HM); Sm.B = (const char*)(ws + WS_W_EDN); Sm.tstepA = (size_t)256 * DFE; Sm.tstepB = (size_t)256 * DFE; Sm.estrideB = (size_t)D * DFE;
#pragma unroll
            for (int e = 0; e < 9; ++e) Sm.eo[e] = eo[e];
            Sm.tok = nullptr; Sm.gather = false;
            pg8::gemm_phase<EpiMoeDown, pg8::SchedMoe, false, true, true>(F.lds, Sm, E, DFE / 2, DFE / 2, DFE / 2, nullptr, (REPEAT_NOEPI ? args.noepi : 0));
        } else {
        ARowDense ar{(const bf16*)(ws + WS_HM), DFE};
        for (int i = F.bid; i < NT * 8; i += F.G) { Unit u; u.pm = i / 8; u.pn = i % 8; int e = 0;
#pragma unroll
            for (int x = 1; x < 8; ++x) e += (u.pm * 256 >= eo[x]);
            naive_gemm_unit(ar, (const bf16*)(ws + WS_W_EDN) + (size_t)e * D * DFE + (size_t)u.pn * 256 * DFE, DFE, DFE, u, E, wr, wc, fr, fq); }
        }
    }
    SEAM(18);
    PHASE(19) {
        const bf16* Y0 = (const bf16*)(ws + WS_Y0); const bf16* Y1 = (const bf16*)(ws + WS_Y1); const float* gf = args.in[I_FINAL_NORM];
        for (int m = gw; m < M; m += NGW) {
            f32x4* orow = (f32x4*)(xres + (size_t)m * D) + F.lane; const u32x2* xb = (const u32x2*)(XB + (size_t)m * D) + F.lane;
            const u32x2* y0 = (const u32x2*)(Y0 + (size_t)m * D) + F.lane; const u32x2* y1 = (const u32x2*)(Y1 + (size_t)m * D) + F.lane;
            f32x4 v[8]; float s = 0.f;
#pragma unroll
            for (int j = 0; j < 8; ++j) { const u32x2 x = xb[64 * j]; const u32x2 a = y0[64 * j], b = y1[64 * j];
                v[j] = (f32x4){bflo(x.x) + bflo(a.x) + bflo(b.x), bfhi(x.x) + bfhi(a.x) + bfhi(b.x), bflo(x.y) + bflo(a.y) + bflo(b.y), bfhi(x.y) + bfhi(a.y) + bfhi(b.y)};
                s += (v[j].x * v[j].x + v[j].y * v[j].y) + (v[j].z * v[j].z + v[j].w * v[j].w); }
            float rs = 1.0f / sqrtf(wave_sum(s) * (1.0f / D) + RMS_EPS);
            if (PROBE_ID >= 0) rs *= 1.0f + (float)((const unsigned long long*)(ws + WS_CTL))[512 + PROBE_IDX] * (1.0f / PROBE_DIV);
#pragma unroll
            for (int j = 0; j < 8; ++j) { const f32x4 g = *((const f32x4*)gf + F.lane + 64 * j); orow[64 * j] = v[j] * rs * g; }
        }
    }
#undef IN
#undef SEAM
#undef PHASE
}

extern "C" void kernel_launch(void* const* d_in, const int* in_sizes, int n_in, void* d_out, int out_size, void* d_ws, size_t ws_size, hipStream_t stream) {
    static int grid = 0;
    if (grid == 0) {
        if (n_in != 28 || in_sizes[0] != M * D || out_size != M * D || ws_size < WS_END) { fprintf(stderr, "kernel_launch: unexpected shapes (n_in %d, in0 %d, out %d, ws %zu); nothing launched\n", n_in, n_in > 0 ? in_sizes[0] : -1, out_size, ws_size); grid = -1; return; }
        int dev = 0, cus = 0;
        if (hipGetDevice(&dev) != hipSuccess || hipDeviceGetAttribute(&cus, hipDeviceAttributeMultiprocessorCount, dev) != hipSuccess) { grid = -1; return; }
        if (hipFuncSetAttribute((const void*)fwd, hipFuncAttributeMaxDynamicSharedMemorySize, LDS_BYTES) != hipSuccess) { grid = -1; return; }
        int per_cu = 0;
        if (hipOccupancyMaxActiveBlocksPerMultiprocessor(&per_cu, (const void*)fwd, NTHR, LDS_BYTES) != hipSuccess || per_cu < 1) { fprintf(stderr, "kernel_launch: occupancy query says %d blocks per CU\n", per_cu); (void)hipGetLastError(); }
        grid = cus;
    }
    if (grid < 0) return;
    (void)hipMemsetAsync((char*)d_ws + WS_CTL, 0, CTL_ZERO_BYTES, stream);
    Args a{};
    for (int i = 0; i < 28; ++i) a.in[i] = (const float*)d_in[i];
    a.out = (float*)d_out; a.ws = (unsigned char*)d_ws;
#if defined(MK_PER_PHASE)
    for (int ph = 0; ph < N_PHASES; ++ph) { a.ph_lo = ph; a.ph_hi = ph + 1; a.li = ph; hipLaunchKernelGGL(fwd, dim3(grid), dim3(NTHR), LDS_BYTES, stream, a); }
#else
    if (REPEAT_MASK == 0) {
        a.ph_lo = 0; a.ph_hi = N_PHASES;
        hipLaunchKernelGGL(fwd, dim3(grid), dim3(NTHR), LDS_BYTES, stream, a);
    } else {
        int lo = 0, li = 0;
        for (int k = 0; k < N_PHASES; ++k) if ((REPEAT_MASK >> k) & 1) {
            a.ph_lo = lo; a.ph_hi = k + 1; a.li = li++; hipLaunchKernelGGL(fwd, dim3(grid), dim3(NTHR), LDS_BYTES, stream, a);
            a.ph_lo = k; a.ph_hi = k + 1; a.li = li++; a.noepi = REPEAT_NOEPI; hipLaunchKernelGGL(fwd, dim3(grid), dim3(NTHR), LDS_BYTES, stream, a); a.noepi = 0;
            lo = k + 1; }
        if (lo < N_PHASES) { a.ph_lo = lo; a.ph_hi = N_PHASES; a.li = li++; hipLaunchKernelGGL(fwd, dim3(grid), dim3(NTHR), LDS_BYTES, stream, a); }
    }
#endif
}
```
